# Optimizing an MI355X kernel written in HIP

```python
import math
import jax, jax.numpy as jnp
from jax import lax
import numpy as np

D_MODEL = 1024
BATCH = 2
SEQ = 8192
DEPTH = 1
DEC_BATCH = 128
DEC_SEQ = 4
PAST_LEN = 2048
PAGE_SIZE = 128

D_ATTN = D_MODEL // 2
D_SSM = D_MODEL - D_ATTN
QK_DIM = 64
V_DIM = 2 * QK_DIM
N_HEADS = D_ATTN // V_DIM
N_BUCKETS = 32
MAX_DISTANCE = 128
SSM_GROUP = 16
N_SSM_GROUPS = D_SSM // SSM_GROUP
SSM_STATE = 64
Q_BLOCK = 128
EPS = 1e-6
NEG_INF = -1e30
QK_W = N_HEADS * 2 * QK_DIM
SPLITS = (QK_W, 2 * QK_W, 2 * QK_W + N_HEADS * V_DIM,
          2 * QK_W + N_HEADS * V_DIM + D_ATTN,
          2 * QK_W + N_HEADS * V_DIM + D_ATTN + D_SSM)
D_IN_PROJ = 2 * QK_W + N_HEADS * V_DIM + D_ATTN + 2 * D_SSM

kernel_name = "hymba_diffattn_s5_step"


def _rmsnorm(x, g):
    xf = x.astype(jnp.float32)
    return xf * lax.rsqrt(jnp.mean(xf * xf, axis=-1, keepdims=True) + EPS) * g.astype(jnp.float32)


def _lambda_init(layer):
    return 0.8 - 0.6 * math.exp(-0.3 * layer)


def _rel_bucket(q_pos, k_pos):
    n = jnp.maximum(q_pos[:, None] - k_pos[None, :], 0)
    max_exact = N_BUCKETS // 2
    nf = jnp.maximum(n, 1).astype(jnp.float32)
    large = max_exact + (jnp.log(nf / max_exact) / math.log(MAX_DISTANCE / max_exact)
                         * (N_BUCKETS - max_exact)).astype(jnp.int32)
    large = jnp.minimum(large, N_BUCKETS - 1)
    return jnp.where(n < max_exact, n, large)


def _diff_attend(q, k, v, q_pos, k_pos, rel_bias, lam):
    s = jnp.einsum('bqhcd,bkhcd->bhcqk', q, k) * (QK_DIM ** -0.5)
    bias = rel_bias.astype(jnp.float32)[_rel_bucket(q_pos, k_pos)]
    s = s + jnp.transpose(bias, (2, 0, 1))[None, :, None]
    mask = k_pos[None, :] <= q_pos[:, None]
    s = jnp.where(mask, s, NEG_INF)
    p = jax.nn.softmax(s, axis=-1)
    w = p[:, :, 0] - lam * p[:, :, 1]
    return jnp.einsum('bhqk,bkhe->bqhe', w, v)


def _in_proj(xn, w_in, q_g, k_g):
    b, L, _ = xn.shape
    h = xn @ w_in.astype(jnp.float32)
    q, k, v, ga, u, gs = jnp.split(h, SPLITS, axis=-1)
    q = _rmsnorm(q.reshape(b, L, N_HEADS, 2, QK_DIM), q_g)
    k = _rmsnorm(k.reshape(b, L, N_HEADS, 2, QK_DIM), k_g)
    v = v.reshape(b, L, N_HEADS, V_DIM)
    return q, k, v, ga, u, gs


def _attn_out(o, ga, subln_g, lam_init):
    b, L = o.shape[:2]
    o = _rmsnorm(o, subln_g) * (1.0 - lam_init)
    return o.reshape(b, L, D_ATTN) * jax.nn.silu(ga)


def _cplx_combine(e1, e2):
    a1r, a1i, b1r, b1i = e1
    a2r, a2i, b2r, b2i = e2
    return (a2r * a1r - a2i * a1i,
            a2r * a1i + a2i * a1r,
            a2r * b1r - a2i * b1i + b2r,
            a2r * b1i + a2i * b1r + b2i)


def _s5_branch(u, gs, h0_re, h0_im, a_re, a_im, log_dt, b_re, b_im, c_re, c_im,
               d_skip, w_glu, b_glu):
    bsz, L, _ = u.shape
    f32 = jnp.float32
    ug = u.reshape(bsz, L, N_SSM_GROUPS, SSM_GROUP)
    a_re = a_re.astype(f32); a_im = a_im.astype(f32)
    dt = jnp.exp(log_dt.astype(f32))[:, None]
    mag = jnp.exp(a_re * dt)
    abar_re = mag * jnp.cos(a_im * dt)
    abar_im = mag * jnp.sin(a_im * dt)
    nr = abar_re - 1.0
    den = a_re * a_re + a_im * a_im
    coef_re = (nr * a_re + abar_im * a_im) / den
    coef_im = (abar_im * a_re - nr * a_im) / den
    b_re = b_re.astype(f32); b_im = b_im.astype(f32)
    bbar_re = coef_re[..., None] * b_re - coef_im[..., None] * b_im
    bbar_im = coef_re[..., None] * b_im + coef_im[..., None] * b_re
    bu_re = jnp.einsum('blgc,gpc->blgp', ug, bbar_re)
    bu_im = jnp.einsum('blgc,gpc->blgp', ug, bbar_im)
    h0_re = h0_re.astype(f32); h0_im = h0_im.astype(f32)
    bu_re = bu_re.at[:, 0].add(abar_re * h0_re - abar_im * h0_im)
    bu_im = bu_im.at[:, 0].add(abar_re * h0_im + abar_im * h0_re)
    A_re = jnp.broadcast_to(abar_re, bu_re.shape)
    A_im = jnp.broadcast_to(abar_im, bu_im.shape)
    _, _, h_re, h_im = lax.associative_scan(_cplx_combine, (A_re, A_im, bu_re, bu_im), axis=1)
    y = (jnp.einsum('blgp,gcp->blgc', h_re, c_re.astype(f32))
         - jnp.einsum('blgp,gcp->blgc', h_im, c_im.astype(f32)))
    y = y.reshape(bsz, L, D_SSM) + d_skip.astype(f32) * u
    z = jax.nn.gelu(y)
    z = z * jax.nn.sigmoid(z @ w_glu.astype(f32) + b_glu.astype(f32))
    return z * jax.nn.silu(gs), h_re[:, -1], h_im[:, -1]


def setup_inputs(seed: int = 0) -> dict:
    key = jax.random.key(seed)
    ks = jax.random.split(key, 32)
    f32 = jnp.float32
    n_pages = PAST_LEN // PAGE_SIZE
    used = DEC_BATCH * n_pages
    n_pool = used + max(used // 4, 1)
    perm = jax.random.permutation(ks[0], n_pool)
    page_table = perm[:used].reshape(DEC_BATCH, n_pages).astype(jnp.int32)
    nrm = lambda k, s, sc: jax.random.normal(k, s, f32) * sc
    n_idx = jnp.arange(SSM_STATE, dtype=f32)
    a_re = -0.5 * jnp.exp(nrm(ks[1], (DEPTH, N_SSM_GROUPS, SSM_STATE), 0.01))
    a_im = math.pi * n_idx[None, None, :] + nrm(ks[2], (DEPTH, N_SSM_GROUPS, SSM_STATE), 0.01)
    log_dt = jax.random.uniform(ks[3], (DEPTH, N_SSM_GROUPS), f32, math.log(1e-3), math.log(1e-1))
    return {
        "x_prompt": nrm(ks[4], (BATCH, SEQ, D_MODEL), 1.0),
        "x_sample": nrm(ks[5], (DEC_BATCH, DEC_SEQ, D_MODEL), 1.0),
        "cache_k": nrm(ks[6], (DEPTH, n_pool, PAGE_SIZE, N_HEADS, 2 * QK_DIM), 1.0),
        "cache_v": nrm(ks[7], (DEPTH, n_pool, PAGE_SIZE, N_HEADS, V_DIM), 1.0),
        "state_ssm_re": nrm(ks[8], (DEPTH, DEC_BATCH, N_SSM_GROUPS, SSM_STATE), 0.1),
        "state_ssm_im": nrm(ks[9], (DEPTH, DEC_BATCH, N_SSM_GROUPS, SSM_STATE), 0.1),
        "page_table": page_table,
        "norm_g": 1.0 + nrm(ks[10], (DEPTH, D_MODEL), 0.01),
        "w_in": nrm(ks[11], (DEPTH, D_MODEL, D_IN_PROJ), D_MODEL ** -0.5),
        "q_norm_g": 1.0 + nrm(ks[12], (DEPTH, QK_DIM), 0.01),
        "k_norm_g": 1.0 + nrm(ks[13], (DEPTH, QK_DIM), 0.01),
        "lambda_q1": nrm(ks[14], (DEPTH, QK_DIM), 0.1),
        "lambda_k1": nrm(ks[15], (DEPTH, QK_DIM), 0.1),
        "lambda_q2": nrm(ks[16], (DEPTH, QK_DIM), 0.1),
        "lambda_k2": nrm(ks[17], (DEPTH, QK_DIM), 0.1),
        "subln_g": 1.0 + nrm(ks[18], (DEPTH, V_DIM), 0.01),
        "rel_bias": nrm(ks[19], (N_BUCKETS, N_HEADS), 0.5),
        "ssm_a_re": a_re,
        "ssm_a_im": a_im,
        "ssm_log_dt": log_dt,
        "ssm_b_re": nrm(ks[20], (DEPTH, N_SSM_GROUPS, SSM_STATE, SSM_GROUP), (2 * SSM_GROUP) ** -0.5),
        "ssm_b_im": nrm(ks[21], (DEPTH, N_SSM_GROUPS, SSM_STATE, SSM_GROUP), (2 * SSM_GROUP) ** -0.5),
        "ssm_c_re": nrm(ks[22], (DEPTH, N_SSM_GROUPS, SSM_GROUP, SSM_STATE), SSM_STATE ** -0.5),
        "ssm_c_im": nrm(ks[23], (DEPTH, N_SSM_GROUPS, SSM_GROUP, SSM_STATE), SSM_STATE ** -0.5),
        "ssm_d": nrm(ks[24], (DEPTH, D_SSM), 1.0),
        "w_glu": nrm(ks[25], (DEPTH, D_SSM, D_SSM), D_SSM ** -0.5),
        "b_glu": nrm(ks[26], (DEPTH, D_SSM), 0.01),
        "w_out": nrm(ks[27], (DEPTH, D_MODEL, D_MODEL), D_MODEL ** -0.5),
    }


def reference(x_prompt, x_sample, cache_k, cache_v, state_ssm_re, state_ssm_im, page_table,
              norm_g, w_in, q_norm_g, k_norm_g, lambda_q1, lambda_k1, lambda_q2, lambda_k2,
              subln_g, rel_bias, ssm_a_re, ssm_a_im, ssm_log_dt, ssm_b_re, ssm_b_im,
              ssm_c_re, ssm_c_im, ssm_d, w_glu, b_glu, w_out):
    f32 = jnp.float32
    n_pages = PAST_LEN // PAGE_SIZE
    n_blocks = SEQ // Q_BLOCK
    hp, hs = x_prompt, x_sample
    kp_l, vp_l, ks_l, vs_l = [], [], [], []
    srp_l, sip_l, srs_l, sis_l = [], [], [], []
    for l in range(DEPTH):
        lam_init = _lambda_init(l)
        lam = (jnp.exp(jnp.sum(lambda_q1[l].astype(f32) * lambda_k1[l].astype(f32)))
               - jnp.exp(jnp.sum(lambda_q2[l].astype(f32) * lambda_k2[l].astype(f32))) + lam_init)
        ssm_params = (ssm_a_re[l], ssm_a_im[l], ssm_log_dt[l], ssm_b_re[l], ssm_b_im[l],
                      ssm_c_re[l], ssm_c_im[l], ssm_d[l], w_glu[l], b_glu[l])

        xn = _rmsnorm(hp, norm_g[l])
        q, k, v, ga, u, gs = _in_proj(xn, w_in[l], q_norm_g[l], k_norm_g[l])
        k_pos = jnp.arange(SEQ)
        qb = jnp.moveaxis(q.reshape(BATCH, n_blocks, Q_BLOCK, N_HEADS, 2, QK_DIM), 1, 0)

        def _block(args, k=k, v=v, k_pos=k_pos, lam=lam):
            q_blk, bi = args
            q_pos = bi * Q_BLOCK + jnp.arange(Q_BLOCK)
            return _diff_attend(q_blk, k, v, q_pos, k_pos, rel_bias, lam)

        o = lax.map(_block, (qb, jnp.arange(n_blocks)))
        o = jnp.moveaxis(o, 0, 1).reshape(BATCH, SEQ, N_HEADS, V_DIM)
        o_a = _attn_out(o, ga, subln_g[l], lam_init)
        zero_h = jnp.zeros((BATCH, N_SSM_GROUPS, SSM_STATE), f32)
        o_s, hr_p, hi_p = _s5_branch(u, gs, zero_h, zero_h, *ssm_params)
        hp = (hp.astype(f32) + jnp.concatenate([o_a, o_s], axis=-1) @ w_out[l].astype(f32)).astype(x_prompt.dtype)
        kp_l.append(k.reshape(BATCH, SEQ, N_HEADS, 2 * QK_DIM).astype(cache_k.dtype))
        vp_l.append(v.astype(cache_v.dtype))
        srp_l.append(hr_p.astype(state_ssm_re.dtype)); sip_l.append(hi_p.astype(state_ssm_im.dtype))

        xn = _rmsnorm(hs, norm_g[l])
        q, k, v, ga, u, gs = _in_proj(xn, w_in[l], q_norm_g[l], k_norm_g[l])
        k_past = cache_k[l][page_table].reshape(DEC_BATCH, n_pages * PAGE_SIZE, N_HEADS, 2, QK_DIM).astype(f32)
        v_past = cache_v[l][page_table].reshape(DEC_BATCH, n_pages * PAGE_SIZE, N_HEADS, V_DIM).astype(f32)
        k_all = jnp.concatenate([k_past, k], axis=1)
        v_all = jnp.concatenate([v_past, v], axis=1)
        q_pos = PAST_LEN + jnp.arange(DEC_SEQ)
        k_pos_s = jnp.arange(PAST_LEN + DEC_SEQ)
        o = _diff_attend(q, k_all, v_all, q_pos, k_pos_s, rel_bias, lam)
        o_a = _attn_out(o, ga, subln_g[l], lam_init)
        o_s, hr_s, hi_s = _s5_branch(u, gs, state_ssm_re[l], state_ssm_im[l], *ssm_params)
        hs = (hs.astype(f32) + jnp.concatenate([o_a, o_s], axis=-1) @ w_out[l].astype(f32)).astype(x_sample.dtype)
        ks_l.append(k.reshape(DEC_BATCH, DEC_SEQ, N_HEADS, 2 * QK_DIM).astype(cache_k.dtype))
        vs_l.append(v.astype(cache_v.dtype))
        srs_l.append(hr_s.astype(state_ssm_re.dtype)); sis_l.append(hi_s.astype(state_ssm_im.dtype))

    y_prompt, y_sample = hp, hs
    k_prompt = jnp.stack(kp_l); v_prompt = jnp.stack(vp_l)
    k_sample = jnp.stack(ks_l); v_sample = jnp.stack(vs_l)
    ssm_re_prompt = jnp.stack(srp_l); ssm_im_prompt = jnp.stack(sip_l)
    ssm_re_sample = jnp.stack(srs_l); ssm_im_sample = jnp.stack(sis_l)
    return (y_prompt, y_sample, k_prompt, v_prompt, k_sample, v_sample,
            ssm_re_prompt, ssm_im_prompt, ssm_re_sample, ssm_im_sample)
```

```cpp
#include <hip/hip_runtime.h>
#include <hip/hip_bf16.h>
#include <cstdio>
#include <cstdint>
#include <cmath>

constexpr int DM = 1024, SEQ = 8192, NB = 2, MP = NB * SEQ, MS = 512, MT = MP + MS;
constexpr int NIN = 3072, DH = 512;
constexpr int NPAGES = 16, PAGE = 128, PAST = 2048;
constexpr float EPS = 1e-6f, LOG2E = 1.4426950408889634f;
constexpr float C2 = 0.125f * LOG2E;
constexpr size_t O_YP = 0, O_YS = 16777216, O_KP = 17301504, O_VP = 25690112, O_KS = 34078720, O_VS = 34340864,
                 O_SRP = 34603008, O_SIP = 34607104, O_SRS = 34611200, O_SIS = 34873344, O_END = 35135488;

namespace pg8 {
#define PG8_LAS __attribute__((address_space(3)))
typedef unsigned short bf16_t;
typedef short bf16x8 __attribute__((ext_vector_type(8)));
typedef float f32x4 __attribute__((ext_vector_type(4)));
typedef unsigned u32x4 __attribute__((ext_vector_type(4)));
constexpr int BM = 256, BK = 64, HALF = 128, HTB = HALF * BK * 2  , STAGE_BYTES = 8 * HTB, NXCD = 8, WGM = 8;

__host__ __device__ __forceinline__ int lds_byte(int r, int c) { const int st = (r >> 4) * 2 + (c >> 5), rr = r & 15, cc = c & 31, ob = rr * 64 + cc * 2; return st * 1024 + (ob ^ (((ob >> 9) & 1) << 5)); }
__host__ __device__ __forceinline__ void stage_rc(int b, int& R, int& C) { const int st = b / 1024, sb = b % 1024, swz = sb ^ (((sb >> 9) & 1) << 5); R = (st >> 1) * 16 + swz / 64; C = (st & 1) * 32 + (swz % 64) / 2; }
__host__ __device__ __forceinline__ int perm32(int rho) { const int n = rho >> 4, i = rho & 15; return 8 * (i >> 2) + 4 * n + (i & 3); }

struct Unit { int pm, pn; };
struct Gemm { const bf16_t* A; const bf16_t* Bt; int M, N, K; };

struct StaticOrder {
    int nM, nN, nwg, G, c;
    __host__ __device__ void init(int M, int N, int G_, int c_) { nM = M / BM; nN = N / BM; nwg = nM * nN; G = G_; c = c_; }
    __host__ __device__ bool next(int i, Unit& u) const {
        const long L = (long)i * G + c; if (L >= nwg) return false;
        int wgid = (int)L; { const int q = nwg / NXCD, r = nwg % NXCD, xcd = wgid % NXCD, off = wgid / NXCD; wgid = (xcd < r ? xcd * (q + 1) : r * (q + 1) + (xcd - r) * q) + off; }
        const int nig = WGM * nN, gid = wgid / nig, fm = gid * WGM, gsz = (nM - fm) < WGM ? (nM - fm) : WGM;
        u.pm = fm + ((wgid % nig) % gsz); u.pn = (wgid % nig) / gsz; return true;
    }
    __device__ __forceinline__ void a_ready(const Unit&) const {}
    __device__ __forceinline__ void done(const Unit&) const {}
};
__device__ __forceinline__ unsigned cvt_pk_bf16(float lo, float hi) { unsigned r; asm volatile("v_cvt_pk_bf16_f32 %0, %1, %2" : "=v"(r) : "v"(lo), "v"(hi)); return r; }
typedef float f32x2 __attribute__((ext_vector_type(2)));

__device__ __forceinline__ float silu_f(float x) { return x * __builtin_amdgcn_rcpf(1.0f + __expf(-x)); }
__device__ __forceinline__ float sigmoid_f(float x) { return __builtin_amdgcn_rcpf(1.0f + __expf(-x)); }
__device__ __forceinline__ u32x4 pack8(const f32x4 a, const f32x4 b) { u32x4 w; w.x = cvt_pk_bf16(a[0], a[1]); w.y = cvt_pk_bf16(a[2], a[3]); w.z = cvt_pk_bf16(b[0], b[1]); w.w = cvt_pk_bf16(b[2], b[3]); return w; }

struct EpiInProj {
    static constexpr bool PERM = true, AFTER_DRAIN = false;
    float* out; bf16_t *Qp, *Kp, *Vp, *GA, *U, *GS; float* QS; const float *qg, *kg;
    __device__ __forceinline__ void operator()(const f32x4 (&acc)[2][2][4][2], const Unit& u, int wr, int wc, int fr, int fq) const {
        const int kind = u.pn >> 1, half = u.pn & 1;
        const int rowb = u.pm * BM + wr * 64 + fr;
        const int cc = 64 * wc + 8 * fq;
        if (kind <= 1) {
            const float* gsrc = kind == 0 ? qg : kg;
            f32x4 g[2][2];
#pragma unroll
            for (int bj = 0; bj < 2; ++bj)
#pragma unroll
                for (int n = 0; n < 2; ++n) { g[bj][n] = *(const f32x4*)(gsrc + 32 * bj + 8 * fq + 4 * n); if (kind == 0) g[bj][n] = g[bj][n] * C2; }
            const int j64 = 4 * half + wc;
#pragma unroll
            for (int ai = 0; ai < 2; ++ai)
#pragma unroll
                for (int m = 0; m < 4; ++m) {
                    const int row = rowb + ai * HALF + m * 16;
                    float ss = 0.f;
#pragma unroll
                    for (int bj = 0; bj < 2; ++bj)
#pragma unroll
                        for (int n = 0; n < 2; ++n) { const f32x4 x = acc[ai][bj][m][n]; ss += (x[0] * x[0] + x[1] * x[1]) + (x[2] * x[2] + x[3] * x[3]); }
                    ss += __shfl_xor(ss, 16); ss += __shfl_xor(ss, 32);
                    const float rs = rsqrtf(ss * (1.0f / 64.0f) + EPS);
#pragma unroll
                    for (int bj = 0; bj < 2; ++bj) {
                        const f32x4 v0 = acc[ai][bj][m][0] * rs * g[bj][0], v1 = acc[ai][bj][m][1] * rs * g[bj][1];
                        const int d = 32 * bj + 8 * fq;
                        if (kind == 0) {
                            if (row < MP) { const u32x4 w = pack8(v0, v1); bf16_t* p = Qp + (size_t)row * DM + 128 * j64 + d; *(u32x4*)p = w; *(u32x4*)(p + 64) = w; }
                            else { float* p = QS + (size_t)(row - MP) * DH + 64 * j64 + d; *(f32x4*)p = v0; *(f32x4*)(p + 4) = v1; }
                        } else {
                            float* p = row < MP ? out + O_KP + (size_t)row * DH + 64 * j64 + d : out + O_KS + (size_t)(row - MP) * DH + 64 * j64 + d;
                            *(f32x4*)p = v0; *(f32x4*)(p + 4) = v1;
                            if (row < MP) { const u32x4 w = pack8(v0, v1); bf16_t* q = Kp + (size_t)row * DM + 128 * j64 + d; *(u32x4*)q = w; *(u32x4*)(q + 64) = w; }
                        }
                    }
                }
        } else {
#pragma unroll
            for (int ai = 0; ai < 2; ++ai)
#pragma unroll
                for (int m = 0; m < 4; ++m) {
                    const int row = rowb + ai * HALF + m * 16;
#pragma unroll
                    for (int bj = 0; bj < 2; ++bj) {
                        f32x4 v0 = acc[ai][bj][m][0], v1 = acc[ai][bj][m][1];
                        const int col = 256 * half + cc + 32 * bj;
                        if (kind == 2) {
                            float* p = row < MP ? out + O_VP + (size_t)row * DH + col : out + O_VS + (size_t)(row - MP) * DH + col;
                            *(f32x4*)p = v0; *(f32x4*)(p + 4) = v1;
                            if (row < MP) { const u32x4 w = pack8(v0, v1); bf16_t* q = Vp + (size_t)row * DM + (col >> 7) * 256 + (col & 127); *(u32x4*)q = w; *(u32x4*)(q + 128) = w; }
                        } else {
                            bf16_t* dst = kind == 3 ? GA : (kind == 4 ? U : GS);
                            if (kind != 4) {
#pragma unroll
                                for (int e = 0; e < 4; ++e) { v0[e] = silu_f(v0[e]); v1[e] = silu_f(v1[e]); }
                            }
                            *(u32x4*)(dst + (size_t)row * DH + col) = pack8(v0, v1);
                        }
                    }
                }
        }
    }
};

template <class Epi, class Sched, bool ALIGN_EPI = false, bool SP2 = false>
__device__ __forceinline__ void gemm_phase(PG8_LAS unsigned char* lds, const Gemm g, const Sched& S, const Epi& E) {
    const int tid = threadIdx.x, wid = __builtin_amdgcn_readfirstlane(tid >> 6), lane = tid & 63, wr = wid >> 2, wc = wid & 3, fr = lane & 15, fq = lane >> 4;
    const int K = g.K, nt = K / BK;
    unsigned voffA[2], voffB[2];
#pragma unroll
    for (int i = 0; i < 2; ++i) { int R, C; stage_rc(tid * 16 + i * 8192, R, C); const int Rb = Epi::PERM ? ((R & ~31) + perm32(R & 31)) : R;
        voffA[i] = (unsigned)(R * K + C) * 2u; voffB[i] = (unsigned)(Rb * K + C) * 2u; }
    const size_t kstep = (size_t)(BK * 2);
    const size_t hstep = (size_t)HALF * K * 2;
    const size_t tstep = 2 * hstep;
    const unsigned ldsw = (unsigned)wid * 1024u;
    const int aoff = lds_byte(wr * 64 + fr, fq * 8), boff = lds_byte(wc * 32 + fr, fq * 8);
#define PG8_SA(b, h) (((b) * 2 + (h)) * HTB)
#define PG8_SB(b, h) ((4 + (b) * 2 + (h)) * HTB)
#define PG8_STAGE(bufoff, gbase, voff) do { _Pragma("unroll") for (int _i = 0; _i < 2; ++_i) \
        __builtin_amdgcn_global_load_lds((const unsigned*)((const char*)(gbase) + (voff)[_i]), (PG8_LAS unsigned*)(lds + (bufoff) + ldsw + _i * 8192), 16, 0, 0); } while (0)
#define PG8_LDA(dst, b, h) do { _Pragma("unroll") for (int m = 0; m < 4; ++m) _Pragma("unroll") for (int k = 0; k < 2; ++k) dst[m][k] = *(const PG8_LAS bf16x8*)(lds + PG8_SA(b, h) + aoff + m * 2048 + k * 1024); } while (0)
#define PG8_LDB(dst, b, h) do { _Pragma("unroll") for (int n = 0; n < 2; ++n) _Pragma("unroll") for (int k = 0; k < 2; ++k) dst[n][k] = *(const PG8_LAS bf16x8*)(lds + PG8_SB(b, h) + boff + n * 2048 + k * 1024); } while (0)
#define PG8_MMA(ai, bj, At, Bt) do { __builtin_amdgcn_s_setprio(1); _Pragma("unroll") for (int m = 0; m < 4; ++m) _Pragma("unroll") for (int n = 0; n < 2; ++n) _Pragma("unroll") for (int k = 0; k < 2; ++k) \
        acc[ai][bj][m][n] = __builtin_amdgcn_mfma_f32_16x16x32_bf16(Bt[n][k], At[m][k], acc[ai][bj][m][n], 0, 0, 0); __builtin_amdgcn_s_setprio(0); } while (0)
#define PG8_WAIT_V(n) asm volatile("s_waitcnt vmcnt(" #n ")" ::: "memory")
#define PG8_WAIT_L(n) asm volatile("s_waitcnt lgkmcnt(" #n ")" ::: "memory")
#define PG8_BAR __builtin_amdgcn_s_barrier()
#define PG8_SCHED __builtin_amdgcn_sched_barrier(0)
    Unit cur, nxt; int ui = 0;
    if (!S.next(0, cur)) return;
    f32x4 acc[2][2][4][2];
#pragma unroll
    for (int a = 0; a < 2; ++a)
#pragma unroll
        for (int b = 0; b < 2; ++b)
#pragma unroll
            for (int m = 0; m < 4; ++m)
#pragma unroll
                for (int n = 0; n < 2; ++n) acc[a][b][m][n] = (f32x4){0.f, 0.f, 0.f, 0.f};
    bf16x8 At[4][2], B0[2][2], B1[2][2];
    const char* cA = (const char*)g.A + (size_t)cur.pm * tstep; const char* cB = (const char*)g.Bt + (size_t)cur.pn * tstep;
    S.a_ready(cur);
    if constexpr (SP2) {
        PG8_STAGE(PG8_SB(0, 0), cB, voffB); PG8_STAGE(PG8_SB(0, 1), cB + hstep, voffB); PG8_STAGE(PG8_SA(0, 0), cA, voffA); PG8_STAGE(PG8_SA(0, 1), cA + hstep, voffA);
        if (wr == 1) PG8_BAR;
        PG8_WAIT_V(2); PG8_BAR;
        PG8_STAGE(PG8_SB(1, 0), cB + kstep, voffB); PG8_STAGE(PG8_SA(1, 0), cA + kstep, voffA); PG8_STAGE(PG8_SB(1, 1), cB + hstep + kstep, voffB);
        PG8_WAIT_V(6); PG8_BAR;
    } else {
        PG8_STAGE(PG8_SB(0, 0), cB, voffB); PG8_STAGE(PG8_SA(0, 0), cA, voffA); PG8_STAGE(PG8_SB(0, 1), cB + hstep, voffB); PG8_STAGE(PG8_SA(0, 1), cA + hstep, voffA);
        if (wr == 1) PG8_BAR;
        PG8_WAIT_V(4); PG8_BAR;
        PG8_STAGE(PG8_SB(1, 0), cB + kstep, voffB); PG8_STAGE(PG8_SA(1, 0), cA + kstep, voffA); PG8_STAGE(PG8_SB(1, 1), cB + hstep + kstep, voffB);
        PG8_WAIT_V(6); PG8_BAR;
    }
    for (;;) {
        const bool has_next = S.next(ui + 1, nxt);
        const char* nA = has_next ? (const char*)g.A + (size_t)nxt.pm * tstep : cA; const char* nB = has_next ? (const char*)g.Bt + (size_t)nxt.pn * tstep : cB;
        for (int t = 0; t < nt; t += 2) {
            const bool last = (t == nt - 2);
            const char* a1 = cA + (size_t)(t + 1) * kstep;
            const char* a2 = last ? nA : cA + (size_t)(t + 2) * kstep; const char* b2 = last ? nB : cB + (size_t)(t + 2) * kstep;
            const char* a3 = a2 + kstep; const char* b3 = b2 + kstep;
            if (last && has_next) S.a_ready(nxt);
            if constexpr (SP2) {
            PG8_LDB(B0, 0, 0); PG8_LDB(B1, 0, 1); PG8_SCHED; PG8_LDA(At, 0, 0); PG8_STAGE(PG8_SA(1, 1), a1 + hstep, voffA);
            PG8_WAIT_V(8); PG8_WAIT_L(0); PG8_BAR; PG8_MMA(0, 0, At, B0); PG8_MMA(0, 1, At, B1); PG8_BAR; PG8_SCHED;
            PG8_LDA(At, 0, 1); PG8_STAGE(PG8_SB(0, 0), b2, voffB); PG8_STAGE(PG8_SB(0, 1), b2 + hstep, voffB); PG8_STAGE(PG8_SA(0, 0), a2, voffA);
            PG8_WAIT_V(8); PG8_WAIT_L(0); PG8_BAR; PG8_MMA(1, 0, At, B0); PG8_MMA(1, 1, At, B1); PG8_BAR; PG8_SCHED;
            PG8_LDB(B0, 1, 0); PG8_LDB(B1, 1, 1); PG8_SCHED; PG8_LDA(At, 1, 0); PG8_STAGE(PG8_SA(0, 1), a2 + hstep, voffA);
            PG8_WAIT_V(8); PG8_WAIT_L(0); PG8_BAR; PG8_MMA(0, 0, At, B0); PG8_MMA(0, 1, At, B1); PG8_BAR; PG8_SCHED;
            PG8_LDA(At, 1, 1); PG8_STAGE(PG8_SB(1, 0), b3, voffB); PG8_STAGE(PG8_SB(1, 1), b3 + hstep, voffB); PG8_STAGE(PG8_SA(1, 0), a3, voffA);
            PG8_WAIT_V(8); PG8_WAIT_L(0); PG8_BAR; PG8_MMA(1, 0, At, B0); PG8_MMA(1, 1, At, B1); PG8_BAR; PG8_SCHED;
            } else {
            PG8_LDB(B0, 0, 0); PG8_SCHED; PG8_LDA(At, 0, 0); PG8_STAGE(PG8_SA(1, 1), a1 + hstep, voffA);
            PG8_WAIT_L(8); PG8_BAR; PG8_WAIT_L(0); PG8_MMA(0, 0, At, B0); PG8_BAR; PG8_SCHED;
            PG8_LDB(B1, 0, 1); PG8_STAGE(PG8_SB(0, 0), b2, voffB);
            PG8_BAR; PG8_WAIT_L(0); PG8_MMA(0, 1, At, B1); PG8_BAR;
            PG8_LDA(At, 0, 1); PG8_STAGE(PG8_SA(0, 0), a2, voffA);
            PG8_BAR; PG8_WAIT_L(0); PG8_MMA(1, 0, At, B0); PG8_BAR; PG8_SCHED;
            PG8_STAGE(PG8_SB(0, 1), b2 + hstep, voffB);
            PG8_WAIT_V(6); PG8_BAR; PG8_MMA(1, 1, At, B1); PG8_BAR;
            PG8_LDB(B0, 1, 0); PG8_SCHED; PG8_LDA(At, 1, 0); PG8_STAGE(PG8_SA(0, 1), a2 + hstep, voffA);
            PG8_WAIT_L(8); PG8_BAR; PG8_WAIT_L(0); PG8_MMA(0, 0, At, B0); PG8_BAR; PG8_SCHED;
            PG8_LDB(B1, 1, 1); PG8_STAGE(PG8_SB(1, 0), b3, voffB);
            PG8_BAR; PG8_WAIT_L(0); PG8_MMA(0, 1, At, B1); PG8_BAR;
            PG8_LDA(At, 1, 1); PG8_STAGE(PG8_SA(1, 0), a3, voffA);
            PG8_BAR; PG8_WAIT_L(0); PG8_MMA(1, 0, At, B0); PG8_BAR; PG8_SCHED;
            PG8_STAGE(PG8_SB(1, 1), b3 + hstep, voffB);
            PG8_WAIT_V(6); PG8_BAR; PG8_MMA(1, 1, At, B1); PG8_BAR;
            }
        }
        if constexpr (ALIGN_EPI) { if (wr == 0) PG8_BAR; }
        if constexpr (!Epi::AFTER_DRAIN) { E(acc, cur, wr, wc, fr, fq); S.done(cur); }
        if (!has_next) break;
#pragma unroll
        for (int a = 0; a < 2; ++a)
#pragma unroll
            for (int b = 0; b < 2; ++b)
#pragma unroll
                for (int m = 0; m < 4; ++m)
#pragma unroll
                    for (int n = 0; n < 2; ++n) acc[a][b][m][n] = (f32x4){0.f, 0.f, 0.f, 0.f};
        cur = nxt; cA = nA; cB = nB; ++ui;
        if constexpr (ALIGN_EPI) { if (wr == 1) PG8_BAR; }
    }
    PG8_WAIT_V(0);
    if constexpr (!ALIGN_EPI) { if (wr == 0) PG8_BAR; }
    PG8_BAR;
    if constexpr (Epi::AFTER_DRAIN) { E.fused(acc, cur, wr, wc, fr, fq, lds, wid, lane); S.done(cur); }
#undef PG8_SA
#undef PG8_SB
#undef PG8_STAGE
#undef PG8_LDA
#undef PG8_LDB
#undef PG8_MMA
#undef PG8_WAIT_V
#undef PG8_WAIT_L
#undef PG8_BAR
#undef PG8_SCHED
}
}

constexpr int NWAVES = 8;
constexpr size_t MiB = 1u << 20;
constexpr size_t WS_CTL = 0, CTL_ZERO_BYTES = 1 * MiB;
constexpr size_t WS_WIN = 2 * MiB, WS_WOUT = 8 * MiB, WS_WGLU = 10 * MiB, WS_TAB = 11 * MiB, WS_E = 12 * MiB, WS_QS = 14 * MiB, WS_PART = 16 * MiB;
constexpr size_t WS_XN = 32 * MiB, WS_Q = 66 * MiB, WS_K = 98 * MiB, WS_V = 130 * MiB, WS_GA = 162 * MiB, WS_U = 179 * MiB, WS_GS = 196 * MiB, WS_Z = 213 * MiB, WS_A2 = 230 * MiB, WS_END = 264 * MiB;
constexpr int TB_LAM = 0, TB_BIAS = 64  , TB_END = 64 + 512;
constexpr int CW_BAR = 4096;

constexpr int RING_OFF = 0, RING_BYTES = 131072;
constexpr int LDSCTL_OFF = RING_BYTES, MISC_OFF = LDSCTL_OFF + 320;
constexpr int LDS_BYTES = 147456;

#define GAS __attribute__((address_space(1)))
#define LAS __attribute__((address_space(3)))
typedef unsigned short bf16;
typedef unsigned v4u __attribute__((ext_vector_type(4)));
typedef float f32x4 __attribute__((ext_vector_type(4)));
typedef short bf16x8 __attribute__((ext_vector_type(8)));
typedef GAS unsigned gu32;
typedef GAS unsigned long long gu64;
#define RLX_AGENT __ATOMIC_RELAXED, __HIP_MEMORY_SCOPE_AGENT
#define LDS_WAIT() asm volatile("s_waitcnt lgkmcnt(0)" ::: "memory")
#define VM_WAIT() asm volatile("s_waitcnt vmcnt(0)" ::: "memory")
__device__ __forceinline__ unsigned long long rt() { return __builtin_amdgcn_s_memrealtime(); }
__device__ __forceinline__ unsigned f2bf(float f) { unsigned u = __builtin_bit_cast(unsigned, f); return (u + 0x7fffu + ((u >> 16) & 1u)) >> 16; }
__device__ __forceinline__ unsigned pk2(float lo, float hi) { return f2bf(lo) | (f2bf(hi) << 16); }

#define XB_TMO      128
#define XB_XCNT(j)  (256  + 64 * (j))
#define XB_XSUB(j)  (1280 + 64 * (j))
#define XB_XGEN(j)  (2304 + 64 * (j))
#define XB_TOP      3328
#define XB_TOPGEN   3392
#define XCD_BAR_WORDS 3456
#define XB_SPIN_CAP (1u << 18)

__device__ __forceinline__ unsigned xb_ld(unsigned* p)              { return __hip_atomic_load(p, __ATOMIC_RELAXED, __HIP_MEMORY_SCOPE_AGENT); }
__device__ __forceinline__ unsigned xb_add(unsigned* p, unsigned v) { return __hip_atomic_fetch_add(p, v, __ATOMIC_RELAXED, __HIP_MEMORY_SCOPE_AGENT); }
__device__ __forceinline__ unsigned xb_xcc_id() { return (unsigned)__builtin_amdgcn_s_getreg((3 << 11) | 20) & 0xFu; }
#define XB_SPIN(cond, bar) do { unsigned _sp = 0; while (cond) { __builtin_amdgcn_s_sleep(1); \
    if ((++_sp & 255u) == 0u) { if (xb_ld(&(bar)[XB_TMO])) break; if (_sp > XB_SPIN_CAP) { atomicAdd(&(bar)[XB_TMO], 1u); break; } } } } while (0)

struct XcdBarrier {
    unsigned* bar; unsigned x;
    volatile LAS unsigned* st;
};

__device__ __forceinline__ XcdBarrier xcd_barrier_post(unsigned* bar, volatile LAS unsigned* st) {
    XcdBarrier b; b.bar = bar; b.x = xb_xcc_id(); b.st = st;
    if (threadIdx.x == 0) (void)xb_add(&bar[XB_XCNT(b.x)], 1u);
    return b;
}
__device__ __forceinline__ void xcd_barrier_complete(unsigned* bar, unsigned x, unsigned& nloc, unsigned& nx) {
    const unsigned G = gridDim.x * gridDim.y * gridDim.z;
    unsigned sum, cnt, mine, sp = 0u;
    for (;;) {
        sum = 0u; cnt = 0u; mine = 0u;
#pragma unroll
        for (unsigned j = 0; j < 16; ++j) { const unsigned c = xb_ld(&bar[XB_XCNT(j)]); sum += c; cnt += (c > 0u) ? 1u : 0u; mine = (j == x) ? c : mine; }
        if (sum == G) break;
        __builtin_amdgcn_s_sleep(1);
        if ((++sp & 255u) == 0u) { if (xb_ld(&bar[XB_TMO])) break; if (sp > XB_SPIN_CAP) { atomicAdd(&bar[XB_TMO], 1u); break; } }
    }
    nloc = mine > 0u ? mine : 1u; nx = cnt > 0u ? cnt : 1u;
}

__device__ __forceinline__ void xcd_barrier(const XcdBarrier& b) {
    asm volatile("s_waitcnt vmcnt(0)" ::: "memory");
    __syncthreads();
    if (threadIdx.x == 0) {
        unsigned* bar = b.bar;
        __builtin_amdgcn_s_waitcnt(0);
        unsigned nloc = b.st[0], nx = b.st[1];
        if (nloc == 0u) { xcd_barrier_complete(bar, b.x, nloc, nx); b.st[0] = nloc; b.st[1] = nx; }
        const unsigned old = xb_add(&bar[XB_XSUB(b.x)], 1u);
        const unsigned gen = old / nloc;
        if (old + 1u == (gen + 1u) * nloc) {
            __builtin_amdgcn_fence(__ATOMIC_RELEASE, "agent");
            asm volatile("s_waitcnt vmcnt(0)" ::: "memory");
            const unsigned og = xb_add(&bar[XB_TOP], 1u);
            const unsigned tg = og / nx;
            if (og + 1u == (tg + 1u) * nx) xb_add(&bar[XB_TOPGEN], 1u);
            else XB_SPIN(xb_ld(&bar[XB_TOPGEN]) == tg, bar);
            __builtin_amdgcn_fence(__ATOMIC_ACQUIRE, "agent");
            xb_add(&bar[XB_XGEN(b.x)], 1u);
            asm volatile("s_waitcnt vmcnt(0)" ::: "memory");
        } else {
            XB_SPIN(xb_ld(&bar[XB_XGEN(b.x)]) == gen, bar);
            __builtin_amdgcn_fence(__ATOMIC_ACQUIRE, "agent");
            asm volatile("s_waitcnt vmcnt(0)" ::: "memory");
        }
    }
    __syncthreads();
}

__device__ __forceinline__ float wave_sum(float v) {
#pragma unroll
    for (int o = 1; o < 64; o <<= 1) v += __shfl_xor(v, o);
    return v;
}
__device__ __forceinline__ void p0_transpose_item(const float* W, int K, int N, bf16* WT, bool permute, LAS float* scr, int item, int lane) {
    const int nblk = N / 32, kb = item / nblk, nb = item % nblk, k0 = 64 * kb, n0 = 32 * nb;
    int d0 = n0; if (permute) { const int a = n0 & 255; d0 = (n0 & ~255) + 128 * ((a >> 5) & 1) + 32 * (a >> 6); }
#pragma unroll 8
    for (int i = 0; i < 32; ++i) { const int kk = 2 * i + (lane >> 5); scr[kk * 33 + (lane & 31)] = W[(size_t)(k0 + kk) * N + n0 + (lane & 31)]; }
    LDS_WAIT(); asm volatile("" ::: "memory");
    const int c = lane & 7;
#pragma unroll
    for (int j = 0; j < 4; ++j) { const int n = (lane >> 3) + 8 * j; const LAS float* s = scr + (8 * c) * 33 + n;
        v4u o; o.x = pk2(s[0 * 33], s[1 * 33]); o.y = pk2(s[2 * 33], s[3 * 33]); o.z = pk2(s[4 * 33], s[5 * 33]); o.w = pk2(s[6 * 33], s[7 * 33]);
        *(GAS v4u*)(WT + (size_t)(d0 + n) * K + k0 + 8 * c) = o; }
    LDS_WAIT(); asm volatile("" ::: "memory");
}
__device__ __forceinline__ void rms_row_to_bf16(const float* xrow, const float* g, bf16* orow, int lane) {
    const GAS f32x4* xr = (const GAS f32x4*)xrow + lane; const GAS f32x4* gr = (const GAS f32x4*)g + lane;
    f32x4 v[4]; float s = 0.f;
#pragma unroll
    for (int j = 0; j < 4; ++j) { v[j] = xr[64 * j]; s += (v[j].x * v[j].x + v[j].y * v[j].y) + (v[j].z * v[j].z + v[j].w * v[j].w); }
    const float rs = rsqrtf(wave_sum(s) * (1.f / DM) + EPS);
    GAS unsigned long long* o8 = (GAS unsigned long long*)orow + lane;
#pragma unroll
    for (int j = 0; j < 4; ++j) { const f32x4 gg = gr[64 * j]; const f32x4 y = v[j] * rs * gg;
        o8[64 * j] = (unsigned long long)pk2(y.x, y.y) | ((unsigned long long)pk2(y.z, y.w) << 32); }
}
__device__ __forceinline__ int t5_bucket(int n) {
    if (n < 16) return n;
    int b = 16;
    b += (n >= 19); b += (n >= 21); b += (n >= 24); b += (n >= 27); b += (n >= 31); b += (n >= 35); b += (n >= 40); b += (n >= 46);
    b += (n >= 52); b += (n >= 59); b += (n >= 67); b += (n >= 77); b += (n >= 87); b += (n >= 99); b += (n >= 113);
    return b;
}

struct Args { const void* in[28]; float* out; unsigned char* ws; };

__global__ void __launch_bounds__(NWAVES * 64, 2) hymba_fwd(Args args) {
    extern __shared__ __attribute__((aligned(16))) unsigned char lds[];
    LAS unsigned char* const L = (LAS unsigned char*)lds;
    volatile LAS unsigned* const MISC = (volatile LAS unsigned*)(L + MISC_OFF);
    const int tid = threadIdx.x, lane = tid & 63, wave = __builtin_amdgcn_readfirstlane(tid >> 6);
    const int G = gridDim.x; const int bx = blockIdx.x; const int vcu = (G % 8 == 0) ? (bx % 8) * (G / 8) + bx / 8 : bx;
    unsigned char* const ws = args.ws; float* const out = args.out;
    gu32* const ctl = (gu32*)(ws + WS_CTL);
    const float* x_prompt = (const float*)args.in[0]; const float* x_sample = (const float*)args.in[1];
    const float* norm_g = (const float*)args.in[7]; const float* w_in = (const float*)args.in[8];
    const float* q_norm_g = (const float*)args.in[9]; const float* k_norm_g = (const float*)args.in[10];
    const float* lq1 = (const float*)args.in[11]; const float* lk1 = (const float*)args.in[12]; const float* lq2 = (const float*)args.in[13]; const float* lk2 = (const float*)args.in[14];
    const float* rel_bias = (const float*)args.in[16];
    const float* w_glu = (const float*)args.in[25]; const float* w_out = (const float*)args.in[27];
    bf16* const WinT = (bf16*)(ws + WS_WIN); bf16* const WoutT = (bf16*)(ws + WS_WOUT); bf16* const WgluT = (bf16*)(ws + WS_WGLU);
    float* const TAB = (float*)(ws + WS_TAB);
    bf16* const XN = (bf16*)(ws + WS_XN); bf16* const Qp = (bf16*)(ws + WS_Q); bf16* const Kp = (bf16*)(ws + WS_K); bf16* const Vp = (bf16*)(ws + WS_V);
    bf16* const GA = (bf16*)(ws + WS_GA); bf16* const U = (bf16*)(ws + WS_U); bf16* const GS = (bf16*)(ws + WS_GS);
    float* const QS = (float*)(ws + WS_QS);

    for (int u = tid; u < (LDS_BYTES - LDSCTL_OFF) / 4; u += NWAVES * 64) ((LAS unsigned*)(L + LDSCTL_OFF))[u] = 0u;
    __syncthreads();
    XcdBarrier bar = xcd_barrier_post((unsigned*)(ctl + CW_BAR), MISC + 8);

    {
        LAS float* scr = (LAS float*)(L + RING_OFF + wave * 16384);
        const int gw = vcu * NWAVES + wave, NGW = G * NWAVES;
        constexpr int I_IN = (DM / 64) * (NIN / 32), I_OUT = (DM / 64) * (DM / 32), I_GLU = (DH / 64) * (DH / 32);
        constexpr int I_T = I_IN + I_OUT + I_GLU, I_ROWS = I_T + MT, I_ALL = I_ROWS + 2;
        for (int it = gw; it < I_ALL; it += NGW) {
            int r = it;
            if (r < I_IN) { p0_transpose_item(w_in, DM, NIN, WinT, true, scr, r, lane); continue; } r -= I_IN;
            if (r < I_OUT) { p0_transpose_item(w_out, DM, DM, WoutT, false, scr, r, lane); continue; } r -= I_OUT;
            if (r < I_GLU) { p0_transpose_item(w_glu, DH, DH, WgluT, false, scr, r, lane); continue; } r -= I_GLU;
            if (r < MT) { const float* xr = r < MP ? x_prompt + (size_t)r * DM : x_sample + (size_t)(r - MP) * DM; rms_row_to_bf16(xr, norm_g, XN + (size_t)r * DM, lane); continue; } r -= MT;
            if (r == 0) {
                const float s1 = wave_sum(lq1[lane] * lk1[lane]), s2 = wave_sum(lq2[lane] * lk2[lane]);
                if (lane == 0) TAB[TB_LAM] = expf(s1) - expf(s2) + 0.2f;
            } else {
                for (int i = lane; i < 512; i += 64) { const int h = i >> 7, d = i & 127; TAB[TB_BIAS + i] = (rel_bias[t5_bucket(d) * 4 + h] - rel_bias[31 * 4 + h]) * LOG2E; }
            }
        }
    }
    xcd_barrier(bar);

    {
        pg8::Gemm g{XN, WinT, MT, NIN, DM}; pg8::StaticOrder S; S.init(MT, NIN, G, bx);
        pg8::EpiInProj E{out, Qp, Kp, Vp, GA, U, GS, QS, q_norm_g, k_norm_g};
        pg8::gemm_phase<pg8::EpiInProj, pg8::StaticOrder, true, true>(L + RING_OFF, g, S, E);
    }
    xcd_barrier(bar);
    xcd_barrier(bar);
    xcd_barrier(bar);
    xcd_barrier(bar);
    {
        const size_t gt = (size_t)bx * 512 + tid, NT = (size_t)G * 512;
        for (size_t i = gt; i < (size_t)MP * DM / 4; i += NT) ((f32x4*)(out + O_YP))[i] = ((const f32x4*)x_prompt)[i];
        for (size_t i = gt; i < (size_t)MS * DM / 4; i += NT) ((f32x4*)(out + O_YS))[i] = ((const f32x4*)x_sample)[i];
        for (size_t i = gt; i < (O_END - O_SRP); i += NT) out[O_SRP + i] = 0.f;
    }
}

#ifndef MODE
#define MODE 0
#endif
#ifndef WMASK
#define WMASK 31
#endif
#if MODE != 1
#ifndef NV_STOP
#define NV_STOP 99
#endif
namespace nv {
constexpr size_t NV_BASE = 320ull << 20;
constexpr size_t NV_XN = NV_BASE, NV_H = NV_XN + (size_t)MT * DM * 4, NV_Q = NV_H + (size_t)MT * NIN * 4, NV_K = NV_Q + (size_t)MT * DH * 4, NV_V = NV_K + (size_t)MT * DH * 4,
                 NV_O = NV_V + (size_t)MT * DH * 4, NV_Y = NV_O + (size_t)MT * DM * 4, NV_Z = NV_Y + (size_t)MT * DH * 4, NV_T = NV_Z + (size_t)MT * DH * 4, NV_A2 = NV_T + (size_t)MT * DH * 4,
                 NV_END = NV_A2 + (size_t)MT * DM * 4;
__device__ __forceinline__ float wsum(float v) {
#pragma unroll
    for (int o = 1; o < 64; o <<= 1) v += __shfl_xor(v, o);
    return v;
}
__device__ __forceinline__ float wmax(float v) {
#pragma unroll
    for (int o = 1; o < 64; o <<= 1) v = fmaxf(v, __shfl_xor(v, o));
    return v;
}
__device__ __forceinline__ int bucket(int n) {
    if (n < 16) return n;
    int b = 16;
    b += (n >= 19); b += (n >= 21); b += (n >= 24); b += (n >= 27); b += (n >= 31); b += (n >= 35); b += (n >= 40); b += (n >= 46);
    b += (n >= 52); b += (n >= 59); b += (n >= 67); b += (n >= 77); b += (n >= 87); b += (n >= 99); b += (n >= 113);
    return b;
}
__global__ void k_rms(const float* xp, const float* xs, const float* g, float* XN) {
    const int row = blockIdx.x, lane = threadIdx.x;
    const float* x = row < MP ? xp + (size_t)row * DM : xs + (size_t)(row - MP) * DM;
    float s = 0.f;
    for (int i = lane; i < DM; i += 64) s += x[i] * x[i];
    const float rs = rsqrtf(wsum(s) / DM + EPS);
    for (int i = lane; i < DM; i += 64) XN[(size_t)row * DM + i] = x[i] * rs * g[i];
}
__global__ void k_gemm(const float* A, const float* B, float* C, const float* R, int M, int N, int K) {
    __shared__ float As[16][65], Bs[16][65];
    const int tx = threadIdx.x & 15, ty = threadIdx.x >> 4, m0 = blockIdx.y * 64, n0 = blockIdx.x * 64;
    float acc[4][4] = {};
    for (int k0 = 0; k0 < K; k0 += 16) {
        for (int i = threadIdx.x; i < 1024; i += 256) { const int r = i >> 4, c = i & 15; As[c][r] = A[(size_t)(m0 + r) * K + k0 + c]; }
        for (int i = threadIdx.x; i < 1024; i += 256) { const int r = i >> 6, c = i & 63; Bs[r][c] = B[(size_t)(k0 + r) * N + n0 + c]; }
        __syncthreads();
#pragma unroll
        for (int k = 0; k < 16; ++k) {
            float a[4], b[4];
#pragma unroll
            for (int i = 0; i < 4; ++i) { a[i] = As[k][ty * 4 + i]; b[i] = Bs[k][tx * 4 + i]; }
#pragma unroll
            for (int i = 0; i < 4; ++i)
#pragma unroll
                for (int j = 0; j < 4; ++j) acc[i][j] += a[i] * b[j];
        }
        __syncthreads();
    }
    for (int i = 0; i < 4; ++i)
        for (int j = 0; j < 4; ++j) { const size_t o = (size_t)(m0 + ty * 4 + i) * N + n0 + tx * 4 + j; C[o] = acc[i][j] + (R ? R[o] : 0.f); }
}
__global__ void k_post(const float* H, const float* qg, const float* kg, float* Q, float* Kn, float* Vn, float* out) {
    const int row = blockIdx.x / 24, j = blockIdx.x % 24, d = threadIdx.x;
    const float v = H[(size_t)row * NIN + j * 64 + d];
    if (j < 16) {
        const float rs = rsqrtf(wsum(v * v) / 64.f + EPS);
        if (j < 8) Q[(size_t)row * DH + j * 64 + d] = v * rs * qg[d] * 0.125f;
        else { const float k = v * rs * kg[d]; const int c = (j - 8) * 64 + d; Kn[(size_t)row * DH + c] = k;
               if (row < MP) out[O_KP + (size_t)row * DH + c] = k; else out[O_KS + (size_t)(row - MP) * DH + c] = k; }
    } else { const int c = (j - 16) * 64 + d; Vn[(size_t)row * DH + c] = v;
             if (row < MP) out[O_VP + (size_t)row * DH + c] = v; else out[O_VS + (size_t)(row - MP) * DH + c] = v; }
}
__global__ void k_attn(const float* Q, const float* Kn, const float* Vn, const float* ck, const float* cv, const int* pt, const float* rel_bias, float* O) {
    const int id = blockIdx.x, row = id >> 3, h = (id >> 1) & 3, c = id & 1, lane = threadIdx.x;
    float q[64];
#pragma unroll
    for (int d = 0; d < 64; ++d) q[d] = Q[(size_t)row * DH + h * 128 + c * 64 + d];
    int nkeys, qpos, b;
    const bool samp = row >= MP;
    if (!samp) { b = row / SEQ; qpos = row % SEQ; nkeys = qpos + 1; }
    else { b = (row - MP) >> 2; qpos = PAST + ((row - MP) & 3); nkeys = qpos + 1; }
    float m = -1e30f, l = 0.f, o0 = 0.f, o1 = 0.f;
    for (int t0 = 0; t0 < nkeys; t0 += 64) {
        const int kk = t0 + lane; const bool valid = kk < nkeys;
        const float* kp;
        if (!samp) kp = Kn + (size_t)(b * SEQ + (valid ? kk : 0)) * DH + h * 128 + c * 64;
        else if (kk < PAST) { const int pg = pt[b * NPAGES + (kk >> 7)]; kp = ck + ((size_t)(pg * PAGE + (kk & 127)) * 4 + h) * 128 + c * 64; }
        else kp = Kn + (size_t)(MP + b * 4 + (valid ? kk - PAST : 0)) * DH + h * 128 + c * 64;
        float s = 0.f;
#pragma unroll
        for (int d = 0; d < 64; ++d) s += q[d] * kp[d];
        s += rel_bias[bucket(valid ? qpos - kk : 0) * 4 + h];
        if (!valid) s = -1e30f;
        const float mn = fmaxf(m, wmax(s)), alpha = expf(m - mn), p = valid ? expf(s - mn) : 0.f;
        l = l * alpha + wsum(p); o0 *= alpha; o1 *= alpha; m = mn;
        const int cnt = min(64, nkeys - t0);
        for (int j = 0; j < cnt; ++j) {
            const float pj = __shfl(p, j); const int kj = t0 + j;
            const float* vp;
            if (!samp) vp = Vn + (size_t)(b * SEQ + kj) * DH + h * 128;
            else if (kj < PAST) { const int pg = pt[b * NPAGES + (kj >> 7)]; vp = cv + ((size_t)(pg * PAGE + (kj & 127)) * 4 + h) * 128; }
            else vp = Vn + (size_t)(MP + b * 4 + kj - PAST) * DH + h * 128;
            o0 += pj * vp[lane]; o1 += pj * vp[lane + 64];
        }
    }
    float* op = O + (size_t)row * DM + (h * 2 + c) * 128;
    op[lane] = o0 / l; op[lane + 64] = o1 / l;
}
__global__ void k_ssm(const float* H, int row0, int L, const float* h0re, const float* h0im, const float* are, const float* aim, const float* ldt,
                      const float* bre, const float* bim, const float* cre, const float* cim, const float* dsk, float* Y, float* ore, float* oim) {
    const int b = blockIdx.x >> 5, g = blockIdx.x & 31, p = threadIdx.x;
    const float ar = are[g * 64 + p], ai = aim[g * 64 + p], dt = expf(ldt[g]);
    const float mag = expf(ar * dt), abr = mag * cosf(ai * dt), abi = mag * sinf(ai * dt);
    const float nr = abr - 1.0f, den = ar * ar + ai * ai;
    const float cfr = (nr * ar + abi * ai) / den, cfi = (abi * ar - nr * ai) / den;
    float bbr[16], bbi[16], cr[16], ci[16];
#pragma unroll
    for (int c = 0; c < 16; ++c) { const float br = bre[(g * 64 + p) * 16 + c], bi = bim[(g * 64 + p) * 16 + c];
        bbr[c] = cfr * br - cfi * bi; bbi[c] = cfr * bi + cfi * br; cr[c] = cre[(g * 16 + c) * 64 + p]; ci[c] = cim[(g * 16 + c) * 64 + p]; }
    float hr = h0re ? h0re[(b * 32 + g) * 64 + p] : 0.f, hi = h0im ? h0im[(b * 32 + g) * 64 + p] : 0.f;
    for (int t = 0; t < L; ++t) {
        const size_t row = (size_t)row0 + (size_t)b * L + t;
        const float* u = H + row * NIN + 2048 + g * 16;
        float ur = 0.f, ui = 0.f;
#pragma unroll
        for (int c = 0; c < 16; ++c) { ur += bbr[c] * u[c]; ui += bbi[c] * u[c]; }
        const float nhr = abr * hr - abi * hi + ur, nhi = abr * hi + abi * hr + ui; hr = nhr; hi = nhi;
        float yv = 0.f;
#pragma unroll
        for (int c = 0; c < 16; ++c) { const float s = wsum(cr[c] * hr - ci[c] * hi); if (p == c) yv = s; }
        if (p < 16) Y[row * DH + g * 16 + p] = yv + dsk[g * 16 + p] * u[p];
    }
    ore[(b * 32 + g) * 64 + p] = hr; oim[(b * 32 + g) * 64 + p] = hi;
}
__device__ __forceinline__ float gelu_tanh(float x) { return 0.5f * x * (1.0f + tanhf(0.7978845608028654f * (x + 0.044715f * x * x * x))); }
__device__ __forceinline__ float silu(float x) { return x / (1.0f + expf(-x)); }
__global__ void k_fin1(const float* O, const float* H, const float* Y, const float* lq1, const float* lk1, const float* lq2, const float* lk2, const float* subg, float* A2, float* Z) {
    const int row = blockIdx.x, lane = threadIdx.x;
    const float lam = expf(wsum(lq1[lane] * lk1[lane])) - expf(wsum(lq2[lane] * lk2[lane])) + 0.2f;
    for (int h = 0; h < 4; ++h) {
        const float* o1 = O + (size_t)row * DM + (h * 2) * 128; const float* o2 = o1 + 128;
        const float a = o1[lane] - lam * o2[lane], bb = o1[lane + 64] - lam * o2[lane + 64];
        const float rs = rsqrtf(wsum(a * a + bb * bb) / 128.f + EPS);
        const float* ga = H + (size_t)row * NIN + 1536 + h * 128;
        A2[(size_t)row * DM + h * 128 + lane] = a * rs * subg[lane] * 0.8f * silu(ga[lane]);
        A2[(size_t)row * DM + h * 128 + lane + 64] = bb * rs * subg[lane + 64] * 0.8f * silu(ga[lane + 64]);
    }
    for (int i = lane; i < DH; i += 64) Z[(size_t)row * DH + i] = gelu_tanh(Y[(size_t)row * DH + i]);
}
__global__ void k_fin2(const float* Z, const float* T, const float* bglu, const float* H, float* A2) {
    const size_t i = (size_t)blockIdx.x * 256 + threadIdx.x; const size_t row = i / DH; const int j = (int)(i % DH);
    A2[row * DM + 512 + j] = Z[i] / (1.0f + expf(-(T[i] + bglu[j]))) * silu(H[row * NIN + 2560 + j]);
}
static void launch(void* const* d_in, float* out, unsigned char* ws, hipStream_t st) {
    const float* xp = (const float*)d_in[0]; const float* xs = (const float*)d_in[1];
    float *XN = (float*)(ws + NV_XN), *H = (float*)(ws + NV_H), *Q = (float*)(ws + NV_Q), *Kn = (float*)(ws + NV_K), *Vn = (float*)(ws + NV_V), *O = (float*)(ws + NV_O),
          *Y = (float*)(ws + NV_Y), *Z = (float*)(ws + NV_Z), *T = (float*)(ws + NV_T), *A2 = (float*)(ws + NV_A2);
#if NV_STOP >= 1
    k_rms<<<MT, 64, 0, st>>>(xp, xs, (const float*)d_in[7], XN);
#endif
#if NV_STOP >= 2
    k_gemm<<<dim3(NIN / 64, MT / 64), 256, 0, st>>>(XN, (const float*)d_in[8], H, nullptr, MT, NIN, DM);
#endif
#if NV_STOP >= 3
    k_post<<<MT * 24, 64, 0, st>>>(H, (const float*)d_in[9], (const float*)d_in[10], Q, Kn, Vn, out);
#endif
#if NV_STOP >= 4
    k_attn<<<MT * 8, 64, 0, st>>>(Q, Kn, Vn, (const float*)d_in[2], (const float*)d_in[3], (const int*)d_in[6], (const float*)d_in[16], O);
#endif
#if NV_STOP >= 5
    k_ssm<<<NB * 32, 64, 0, st>>>(H, 0, SEQ, nullptr, nullptr, (const float*)d_in[17], (const float*)d_in[18], (const float*)d_in[19], (const float*)d_in[20], (const float*)d_in[21],
                                 (const float*)d_in[22], (const float*)d_in[23], (const float*)d_in[24], Y, out + O_SRP, out + O_SIP);
#endif
#if NV_STOP >= 6
    k_ssm<<<128 * 32, 64, 0, st>>>(H, MP, 4, (const float*)d_in[4], (const float*)d_in[5], (const float*)d_in[17], (const float*)d_in[18], (const float*)d_in[19], (const float*)d_in[20], (const float*)d_in[21],
                                  (const float*)d_in[22], (const float*)d_in[23], (const float*)d_in[24], Y, out + O_SRS, out + O_SIS);
#endif
#if NV_STOP >= 7
    k_fin1<<<MT, 64, 0, st>>>(O, H, Y, (const float*)d_in[11], (const float*)d_in[12], (const float*)d_in[13], (const float*)d_in[14], (const float*)d_in[15], A2, Z);
#endif
#if NV_STOP >= 8
    k_gemm<<<dim3(DH / 64, MT / 64), 256, 0, st>>>(Z, (const float*)d_in[25], T, nullptr, MT, DH, DH);
#endif
#if NV_STOP >= 9
    k_fin2<<<MT * DH / 256, 256, 0, st>>>(Z, T, (const float*)d_in[26], H, A2);
#endif
#if NV_STOP >= 10
    k_gemm<<<dim3(DM / 64, MP / 64), 256, 0, st>>>(A2, (const float*)d_in[27], out + O_YP, xp, MP, DM, DM);
#endif
#if NV_STOP >= 11
    k_gemm<<<dim3(DM / 64, MS / 64), 256, 0, st>>>(A2 + (size_t)MP * DM, (const float*)d_in[27], out + O_YS, xs, MS, DM, DM);
#endif
}
}
#endif

extern "C" void kernel_launch(void* const* d_in, const int* in_sizes, int n_in, void* d_out, int out_size, void* d_ws, size_t ws_size, hipStream_t stream) {
    static int grid = 0;
    if (grid == 0) {
        if (n_in != 28 || out_size != (int)O_END || ws_size < (size_t)(1024ull << 20)) { fprintf(stderr, "kernel_launch: unexpected shapes (n_in %d out %d ws %zu)\n", n_in, out_size, ws_size); grid = -1; return; }
        int dev = 0, cus = 0, per_cu = 0;
        if (hipGetDevice(&dev) != hipSuccess || hipDeviceGetAttribute(&cus, hipDeviceAttributeMultiprocessorCount, dev) != hipSuccess) { grid = -1; return; }
        if (hipFuncSetAttribute((const void*)hymba_fwd, hipFuncAttributeMaxDynamicSharedMemorySize, LDS_BYTES) != hipSuccess) { fprintf(stderr, "kernel_launch: hipFuncSetAttribute failed\n"); grid = -1; return; }
        if (hipOccupancyMaxActiveBlocksPerMultiprocessor(&per_cu, (const void*)hymba_fwd, NWAVES * 64, LDS_BYTES) != hipSuccess || per_cu < 1)
            fprintf(stderr, "kernel_launch: occupancy query reports %d workgroups per CU\n", per_cu);
        (void)hipGetLastError();
        grid = cus;
    }
    if (grid < 0) return;
#if MODE != 1
    nv::launch(d_in, (float*)d_out, (unsigned char*)d_ws, stream);
#endif
#if MODE == 0
    return;
#endif
    if (hipMemsetAsync((char*)d_ws + WS_CTL, 0, CTL_ZERO_BYTES, stream) != hipSuccess) return;
    Args a{};
    for (int i = 0; i < 28; ++i) a.in[i] = d_in[i];
    a.out = (float*)d_out; a.ws = (unsigned char*)d_ws;
    hipLaunchKernelGGL(hymba_fwd, dim3(grid), dim3(NWAVES * 64), LDS_BYTES, stream, a);
}
```

```cpp
#include <hip/hip_runtime.h>
#include <hip/hip_bf16.h>
#include <cstdio>
#include <cstdint>
#include <cmath>

constexpr int DM = 1024, SEQ = 8192, NB = 2, MP = NB * SEQ, MS = 512, MT = MP + MS;
constexpr int NIN = 3072, DH = 512;
constexpr int NPAGES = 16, PAGE = 128, PAST = 2048;
constexpr float EPS = 1e-6f, LOG2E = 1.4426950408889634f;
constexpr float C2 = 0.125f * LOG2E;
constexpr size_t O_YP = 0, O_YS = 16777216, O_KP = 17301504, O_VP = 25690112, O_KS = 34078720, O_VS = 34340864,
                 O_SRP = 34603008, O_SIP = 34607104, O_SRS = 34611200, O_SIS = 34873344, O_END = 35135488;

namespace pg8 {
#define PG8_LAS __attribute__((address_space(3)))
typedef unsigned short bf16_t;
typedef short bf16x8 __attribute__((ext_vector_type(8)));
typedef float f32x4 __attribute__((ext_vector_type(4)));
typedef unsigned u32x4 __attribute__((ext_vector_type(4)));
constexpr int BM = 256, BK = 64, HALF = 128, HTB = HALF * BK * 2  , STAGE_BYTES = 8 * HTB, NXCD = 8, WGM = 8;

__host__ __device__ __forceinline__ int lds_byte(int r, int c) { const int st = (r >> 4) * 2 + (c >> 5), rr = r & 15, cc = c & 31, ob = rr * 64 + cc * 2; return st * 1024 + (ob ^ (((ob >> 9) & 1) << 5)); }
__host__ __device__ __forceinline__ void stage_rc(int b, int& R, int& C) { const int st = b / 1024, sb = b % 1024, swz = sb ^ (((sb >> 9) & 1) << 5); R = (st >> 1) * 16 + swz / 64; C = (st & 1) * 32 + (swz % 64) / 2; }
__host__ __device__ __forceinline__ int perm32(int rho) { const int n = rho >> 4, i = rho & 15; return 8 * (i >> 2) + 4 * n + (i & 3); }

struct Unit { int pm, pn; };
struct Gemm { const bf16_t* A; const bf16_t* Bt; int M, N, K; };

struct StaticOrder {
    int nM, nN, nwg, G, c;
    __host__ __device__ void init(int M, int N, int G_, int c_) { nM = M / BM; nN = N / BM; nwg = nM * nN; G = G_; c = c_; }
    __host__ __device__ bool next(int i, Unit& u) const {
        const long L = (long)i * G + c; if (L >= nwg) return false;
        int wgid = (int)L; { const int q = nwg / NXCD, r = nwg % NXCD, xcd = wgid % NXCD, off = wgid / NXCD; wgid = (xcd < r ? xcd * (q + 1) : r * (q + 1) + (xcd - r) * q) + off; }
        const int nig = WGM * nN, gid = wgid / nig, fm = gid * WGM, gsz = (nM - fm) < WGM ? (nM - fm) : WGM;
        u.pm = fm + ((wgid % nig) % gsz); u.pn = (wgid % nig) / gsz; return true;
    }
    __device__ __forceinline__ void a_ready(const Unit&) const {}
    __device__ __forceinline__ void done(const Unit&) const {}
};
__device__ __forceinline__ unsigned cvt_pk_bf16(float lo, float hi) { unsigned r; asm volatile("v_cvt_pk_bf16_f32 %0, %1, %2" : "=v"(r) : "v"(lo), "v"(hi)); return r; }
typedef float f32x2 __attribute__((ext_vector_type(2)));

__device__ __forceinline__ float silu_f(float x) { return x * __builtin_amdgcn_rcpf(1.0f + __expf(-x)); }
__device__ __forceinline__ float sigmoid_f(float x) { return __builtin_amdgcn_rcpf(1.0f + __expf(-x)); }
__device__ __forceinline__ u32x4 pack8(const f32x4 a, const f32x4 b) { u32x4 w; w.x = cvt_pk_bf16(a[0], a[1]); w.y = cvt_pk_bf16(a[2], a[3]); w.z = cvt_pk_bf16(b[0], b[1]); w.w = cvt_pk_bf16(b[2], b[3]); return w; }

struct EpiInProj {
    static constexpr bool PERM = true, AFTER_DRAIN = false;
    float* out; bf16_t *Qp, *Kp, *Vp, *GA, *U, *GS; float *QS, *KS, *VS; const float *qg, *kg; int wmask;
    __device__ __forceinline__ void operator()(const f32x4 (&acc)[2][2][4][2], const Unit& u, int wr, int wc, int fr, int fq) const {
        const int kind = u.pn >> 1, half = u.pn & 1;
        const int rowb = u.pm * BM + wr * 64 + fr;
        const int cc = 64 * wc + 8 * fq;
        if (kind <= 1) {
            const float* gsrc = kind == 0 ? qg : kg;
            f32x4 g[2][2];
#pragma unroll
            for (int bj = 0; bj < 2; ++bj)
#pragma unroll
                for (int n = 0; n < 2; ++n) { g[bj][n] = *(const f32x4*)(gsrc + 32 * bj + 8 * fq + 4 * n); if (kind == 0) g[bj][n] = g[bj][n] * C2; }
            const int j64 = 4 * half + wc;
#pragma unroll
            for (int ai = 0; ai < 2; ++ai)
#pragma unroll
                for (int m = 0; m < 4; ++m) {
                    const int row = rowb + ai * HALF + m * 16;
                    float ss = 0.f;
#pragma unroll
                    for (int bj = 0; bj < 2; ++bj)
#pragma unroll
                        for (int n = 0; n < 2; ++n) { const f32x4 x = acc[ai][bj][m][n]; ss += (x[0] * x[0] + x[1] * x[1]) + (x[2] * x[2] + x[3] * x[3]); }
                    ss += __shfl_xor(ss, 16); ss += __shfl_xor(ss, 32);
                    const float rs = rsqrtf(ss * (1.0f / 64.0f) + EPS);
#pragma unroll
                    for (int bj = 0; bj < 2; ++bj) {
                        const f32x4 v0 = acc[ai][bj][m][0] * rs * g[bj][0], v1 = acc[ai][bj][m][1] * rs * g[bj][1];
                        const int d = 32 * bj + 8 * fq;
                        if (kind == 0) {
                            if (row < MP) { const u32x4 w = pack8(v0, v1); bf16_t* p = Qp + (size_t)row * DM + 128 * j64 + d; *(u32x4*)p = w; *(u32x4*)(p + 64) = w; }
                            else { float* p = QS + (size_t)(row - MP) * DH + 64 * j64 + d; *(f32x4*)p = v0; *(f32x4*)(p + 4) = v1; }
                        } else {
                            if (wmask & 1) { float* p = row < MP ? out + O_KP + (size_t)row * DH + 64 * j64 + d : out + O_KS + (size_t)(row - MP) * DH + 64 * j64 + d;
                                *(f32x4*)p = v0; *(f32x4*)(p + 4) = v1; }
                            if (row < MP) { const u32x4 w = pack8(v0, v1); bf16_t* q = Kp + (size_t)row * DM + 128 * j64 + d; *(u32x4*)q = w; *(u32x4*)(q + 64) = w; }
                            else { float* p = KS + (size_t)(row - MP) * DH + 64 * j64 + d; *(f32x4*)p = v0; *(f32x4*)(p + 4) = v1; }
                        }
                    }
                }
        } else {
#pragma unroll
            for (int ai = 0; ai < 2; ++ai)
#pragma unroll
                for (int m = 0; m < 4; ++m) {
                    const int row = rowb + ai * HALF + m * 16;
#pragma unroll
                    for (int bj = 0; bj < 2; ++bj) {
                        f32x4 v0 = acc[ai][bj][m][0], v1 = acc[ai][bj][m][1];
                        const int col = 256 * half + cc + 32 * bj;
                        if (kind == 2) {
                            if (wmask & 1) { float* p = row < MP ? out + O_VP + (size_t)row * DH + col : out + O_VS + (size_t)(row - MP) * DH + col;
                                *(f32x4*)p = v0; *(f32x4*)(p + 4) = v1; }
                            if (row < MP) { const u32x4 w = pack8(v0, v1); bf16_t* q = Vp + (size_t)row * DM + (col >> 7) * 256 + (col & 127); *(u32x4*)q = w; *(u32x4*)(q + 128) = w; }
                            else { float* p = VS + (size_t)(row - MP) * DH + col; *(f32x4*)p = v0; *(f32x4*)(p + 4) = v1; }
                        } else {
                            bf16_t* dst = kind == 3 ? GA : (kind == 4 ? U : GS);
                            if (kind != 4) {
#pragma unroll
                                for (int e = 0; e < 4; ++e) { v0[e] = silu_f(v0[e]); v1[e] = silu_f(v1[e]); }
                            }
                            *(u32x4*)(dst + (size_t)row * DH + col) = pack8(v0, v1);
                        }
                    }
                }
        }
    }
};


__device__ __forceinline__ float bflo(unsigned w) { return __uint_as_float(w << 16); }
__device__ __forceinline__ float bfhi(unsigned w) { return __uint_as_float(w & 0xffff0000u); }
struct EpiGlu {
    static constexpr bool PERM = true, AFTER_DRAIN = false;
    const bf16_t* Z; const bf16_t* GS; const float* bglu; bf16_t* A2;
    __device__ __forceinline__ void operator()(const f32x4 (&acc)[2][2][4][2], const Unit& u, int wr, int wc, int fr, int fq) const {
        const int rowb = u.pm * BM + wr * 64 + fr, colb = u.pn * BM + wc * 32 + 8 * fq;
        f32x4 bv[2][2];
#pragma unroll
        for (int bj = 0; bj < 2; ++bj)
#pragma unroll
            for (int n = 0; n < 2; ++n) bv[bj][n] = *(const f32x4*)(bglu + colb + bj * HALF + 4 * n);
#pragma unroll
        for (int ai = 0; ai < 2; ++ai)
#pragma unroll
            for (int m = 0; m < 4; ++m) {
                const size_t row = (size_t)(rowb + ai * HALF + m * 16);
#pragma unroll
                for (int bj = 0; bj < 2; ++bj) {
                    const int col = colb + bj * HALF;
                    const u32x4 zz = *(const u32x4*)(Z + row * DH + col), gg = *(const u32x4*)(GS + row * DH + col);
                    const f32x4 t0 = acc[ai][bj][m][0] + bv[bj][0], t1 = acc[ai][bj][m][1] + bv[bj][1];
                    f32x4 o0, o1;
                    o0[0] = bflo(zz.x) * sigmoid_f(t0[0]) * bflo(gg.x); o0[1] = bfhi(zz.x) * sigmoid_f(t0[1]) * bfhi(gg.x); o0[2] = bflo(zz.y) * sigmoid_f(t0[2]) * bflo(gg.y); o0[3] = bfhi(zz.y) * sigmoid_f(t0[3]) * bfhi(gg.y);
                    o1[0] = bflo(zz.z) * sigmoid_f(t1[0]) * bflo(gg.z); o1[1] = bfhi(zz.z) * sigmoid_f(t1[1]) * bfhi(gg.z); o1[2] = bflo(zz.w) * sigmoid_f(t1[2]) * bflo(gg.w); o1[3] = bfhi(zz.w) * sigmoid_f(t1[3]) * bfhi(gg.w);
                    *(u32x4*)(A2 + row * DM + DH + col) = pack8(o0, o1);
                }
            }
    }
};
struct EpiOut {
    static constexpr bool PERM = true, AFTER_DRAIN = false;
    const float* xp; const float* xs; float* out; int wmask;
    __device__ __forceinline__ void operator()(const f32x4 (&acc)[2][2][4][2], const Unit& u, int wr, int wc, int fr, int fq) const {
        const int rowb = u.pm * BM + wr * 64 + fr, colb = u.pn * BM + wc * 32 + 8 * fq;
#pragma unroll
        for (int ai = 0; ai < 2; ++ai)
#pragma unroll
            for (int m = 0; m < 4; ++m) {
                const int row = rowb + ai * HALF + m * 16;
                const bool pr = row < MP;
                if (!(wmask & (pr ? 16 : 8))) continue;
                const float* xr = pr ? xp + (size_t)row * DM : xs + (size_t)(row - MP) * DM;
                float* yr = pr ? out + O_YP + (size_t)row * DM : out + O_YS + (size_t)(row - MP) * DM;
#pragma unroll
                for (int bj = 0; bj < 2; ++bj) {
                    const int col = colb + bj * HALF;
                    const f32x4 x0 = *(const f32x4*)(xr + col), x1 = *(const f32x4*)(xr + col + 4);
                    *(f32x4*)(yr + col) = x0 + acc[ai][bj][m][0]; *(f32x4*)(yr + col + 4) = x1 + acc[ai][bj][m][1];
                }
            }
    }
};

template <class Epi, class Sched, bool ALIGN_EPI = false, bool SP2 = false>
__device__ __forceinline__ void gemm_phase(PG8_LAS unsigned char* lds, const Gemm g, const Sched& S, const Epi& E) {
    int tid_ = threadIdx.x; asm volatile("" : "+v"(tid_));
    const int tid = tid_, wid = __builtin_amdgcn_readfirstlane(tid >> 6), lane = tid & 63, wr = wid >> 2, wc = wid & 3, fr = lane & 15, fq = lane >> 4;
    const int K = g.K, nt = K / BK;
    unsigned voffA[2], voffB[2];
#pragma unroll
    for (int i = 0; i < 2; ++i) { int R, C; stage_rc(tid * 16 + i * 8192, R, C); const int Rb = Epi::PERM ? ((R & ~31) + perm32(R & 31)) : R;
        voffA[i] = (unsigned)(R * K + C) * 2u; voffB[i] = (unsigned)(Rb * K + C) * 2u; }
    const size_t kstep = (size_t)(BK * 2);
    const size_t hstep = (size_t)HALF * K * 2;
    const size_t tstep = 2 * hstep;
    const unsigned ldsw = (unsigned)wid * 1024u;
    const int aoff = lds_byte(wr * 64 + fr, fq * 8), boff = lds_byte(wc * 32 + fr, fq * 8);
#define PG8_SA(b, h) (((b) * 2 + (h)) * HTB)
#define PG8_SB(b, h) ((4 + (b) * 2 + (h)) * HTB)
#define PG8_STAGE(bufoff, gbase, voff) do { _Pragma("unroll") for (int _i = 0; _i < 2; ++_i) \
        __builtin_amdgcn_global_load_lds((const unsigned*)((const char*)(gbase) + (voff)[_i]), (PG8_LAS unsigned*)(lds + (bufoff) + ldsw + _i * 8192), 16, 0, 0); } while (0)
#define PG8_LDA(dst, b, h) do { _Pragma("unroll") for (int m = 0; m < 4; ++m) _Pragma("unroll") for (int k = 0; k < 2; ++k) dst[m][k] = *(const PG8_LAS bf16x8*)(lds + PG8_SA(b, h) + aoff + m * 2048 + k * 1024); } while (0)
#define PG8_LDB(dst, b, h) do { _Pragma("unroll") for (int n = 0; n < 2; ++n) _Pragma("unroll") for (int k = 0; k < 2; ++k) dst[n][k] = *(const PG8_LAS bf16x8*)(lds + PG8_SB(b, h) + boff + n * 2048 + k * 1024); } while (0)
#define PG8_MMA(ai, bj, At, Bt) do { __builtin_amdgcn_s_setprio(1); _Pragma("unroll") for (int m = 0; m < 4; ++m) _Pragma("unroll") for (int n = 0; n < 2; ++n) _Pragma("unroll") for (int k = 0; k < 2; ++k) \
        acc[ai][bj][m][n] = __builtin_amdgcn_mfma_f32_16x16x32_bf16(Bt[n][k], At[m][k], acc[ai][bj][m][n], 0, 0, 0); __builtin_amdgcn_s_setprio(0); } while (0)
#define PG8_WAIT_V(n) asm volatile("s_waitcnt vmcnt(" #n ")" ::: "memory")
#define PG8_WAIT_L(n) asm volatile("s_waitcnt lgkmcnt(" #n ")" ::: "memory")
#define PG8_BAR __builtin_amdgcn_s_barrier()
#define PG8_SCHED __builtin_amdgcn_sched_barrier(0)
    Unit cur, nxt; int ui = 0;
    if (!S.next(0, cur)) return;
    f32x4 acc[2][2][4][2];
#pragma unroll
    for (int a = 0; a < 2; ++a)
#pragma unroll
        for (int b = 0; b < 2; ++b)
#pragma unroll
            for (int m = 0; m < 4; ++m)
#pragma unroll
                for (int n = 0; n < 2; ++n) acc[a][b][m][n] = (f32x4){0.f, 0.f, 0.f, 0.f};
    bf16x8 At[4][2], B0[2][2], B1[2][2];
    const char* cA = (const char*)g.A + (size_t)cur.pm * tstep; const char* cB = (const char*)g.Bt + (size_t)cur.pn * tstep;
    S.a_ready(cur);
    if constexpr (SP2) {
        PG8_STAGE(PG8_SB(0, 0), cB, voffB); PG8_STAGE(PG8_SB(0, 1), cB + hstep, voffB); PG8_STAGE(PG8_SA(0, 0), cA, voffA); PG8_STAGE(PG8_SA(0, 1), cA + hstep, voffA);
        if (wr == 1) PG8_BAR;
        PG8_WAIT_V(2); PG8_BAR;
        PG8_STAGE(PG8_SB(1, 0), cB + kstep, voffB); PG8_STAGE(PG8_SA(1, 0), cA + kstep, voffA); PG8_STAGE(PG8_SB(1, 1), cB + hstep + kstep, voffB);
        PG8_WAIT_V(6); PG8_BAR;
    } else {
        PG8_STAGE(PG8_SB(0, 0), cB, voffB); PG8_STAGE(PG8_SA(0, 0), cA, voffA); PG8_STAGE(PG8_SB(0, 1), cB + hstep, voffB); PG8_STAGE(PG8_SA(0, 1), cA + hstep, voffA);
        if (wr == 1) PG8_BAR;
        PG8_WAIT_V(4); PG8_BAR;
        PG8_STAGE(PG8_SB(1, 0), cB + kstep, voffB); PG8_STAGE(PG8_SA(1, 0), cA + kstep, voffA); PG8_STAGE(PG8_SB(1, 1), cB + hstep + kstep, voffB);
        PG8_WAIT_V(6); PG8_BAR;
    }
    for (;;) {
        const bool has_next = S.next(ui + 1, nxt);
        const char* nA = has_next ? (const char*)g.A + (size_t)nxt.pm * tstep : cA; const char* nB = has_next ? (const char*)g.Bt + (size_t)nxt.pn * tstep : cB;
        for (int t = 0; t < nt; t += 2) {
            const bool last = (t == nt - 2);
            const char* a1 = cA + (size_t)(t + 1) * kstep;
            const char* a2 = last ? nA : cA + (size_t)(t + 2) * kstep; const char* b2 = last ? nB : cB + (size_t)(t + 2) * kstep;
            const char* a3 = a2 + kstep; const char* b3 = b2 + kstep;
            if (last && has_next) S.a_ready(nxt);
            if constexpr (SP2) {
            PG8_LDB(B0, 0, 0); PG8_LDB(B1, 0, 1); PG8_SCHED; PG8_LDA(At, 0, 0); PG8_STAGE(PG8_SA(1, 1), a1 + hstep, voffA);
            PG8_WAIT_V(8); PG8_WAIT_L(0); PG8_BAR; PG8_MMA(0, 0, At, B0); PG8_MMA(0, 1, At, B1); PG8_BAR; PG8_SCHED;
            PG8_LDA(At, 0, 1); PG8_STAGE(PG8_SB(0, 0), b2, voffB); PG8_STAGE(PG8_SB(0, 1), b2 + hstep, voffB); PG8_STAGE(PG8_SA(0, 0), a2, voffA);
            PG8_WAIT_V(8); PG8_WAIT_L(0); PG8_BAR; PG8_MMA(1, 0, At, B0); PG8_MMA(1, 1, At, B1); PG8_BAR; PG8_SCHED;
            PG8_LDB(B0, 1, 0); PG8_LDB(B1, 1, 1); PG8_SCHED; PG8_LDA(At, 1, 0); PG8_STAGE(PG8_SA(0, 1), a2 + hstep, voffA);
            PG8_WAIT_V(8); PG8_WAIT_L(0); PG8_BAR; PG8_MMA(0, 0, At, B0); PG8_MMA(0, 1, At, B1); PG8_BAR; PG8_SCHED;
            PG8_LDA(At, 1, 1); PG8_STAGE(PG8_SB(1, 0), b3, voffB); PG8_STAGE(PG8_SB(1, 1), b3 + hstep, voffB); PG8_STAGE(PG8_SA(1, 0), a3, voffA);
            PG8_WAIT_V(8); PG8_WAIT_L(0); PG8_BAR; PG8_MMA(1, 0, At, B0); PG8_MMA(1, 1, At, B1); PG8_BAR; PG8_SCHED;
            } else {
            PG8_LDB(B0, 0, 0); PG8_SCHED; PG8_LDA(At, 0, 0); PG8_STAGE(PG8_SA(1, 1), a1 + hstep, voffA);
            PG8_WAIT_L(8); PG8_BAR; PG8_WAIT_L(0); PG8_MMA(0, 0, At, B0); PG8_BAR; PG8_SCHED;
            PG8_LDB(B1, 0, 1); PG8_STAGE(PG8_SB(0, 0), b2, voffB);
            PG8_BAR; PG8_WAIT_L(0); PG8_MMA(0, 1, At, B1); PG8_BAR;
            PG8_LDA(At, 0, 1); PG8_STAGE(PG8_SA(0, 0), a2, voffA);
            PG8_BAR; PG8_WAIT_L(0); PG8_MMA(1, 0, At, B0); PG8_BAR; PG8_SCHED;
            PG8_STAGE(PG8_SB(0, 1), b2 + hstep, voffB);
            PG8_WAIT_V(6); PG8_BAR; PG8_MMA(1, 1, At, B1); PG8_BAR;
            PG8_LDB(B0, 1, 0); PG8_SCHED; PG8_LDA(At, 1, 0); PG8_STAGE(PG8_SA(0, 1), a2 + hstep, voffA);
            PG8_WAIT_L(8); PG8_BAR; PG8_WAIT_L(0); PG8_MMA(0, 0, At, B0); PG8_BAR; PG8_SCHED;
            PG8_LDB(B1, 1, 1); PG8_STAGE(PG8_SB(1, 0), b3, voffB);
            PG8_BAR; PG8_WAIT_L(0); PG8_MMA(0, 1, At, B1); PG8_BAR;
            PG8_LDA(At, 1, 1); PG8_STAGE(PG8_SA(1, 0), a3, voffA);
            PG8_BAR; PG8_WAIT_L(0); PG8_MMA(1, 0, At, B0); PG8_BAR; PG8_SCHED;
            PG8_STAGE(PG8_SB(1, 1), b3 + hstep, voffB);
            PG8_WAIT_V(6); PG8_BAR; PG8_MMA(1, 1, At, B1); PG8_BAR;
            }
        }
        if constexpr (ALIGN_EPI) { if (wr == 0) PG8_BAR; }
        if constexpr (!Epi::AFTER_DRAIN) { E(acc, cur, wr, wc, fr, fq); S.done(cur); }
        if (!has_next) break;
#pragma unroll
        for (int a = 0; a < 2; ++a)
#pragma unroll
            for (int b = 0; b < 2; ++b)
#pragma unroll
                for (int m = 0; m < 4; ++m)
#pragma unroll
                    for (int n = 0; n < 2; ++n) acc[a][b][m][n] = (f32x4){0.f, 0.f, 0.f, 0.f};
        cur = nxt; cA = nA; cB = nB; ++ui;
        if constexpr (ALIGN_EPI) { if (wr == 1) PG8_BAR; }
    }
    PG8_WAIT_V(0);
    if constexpr (!ALIGN_EPI) { if (wr == 0) PG8_BAR; }
    PG8_BAR;
    if constexpr (Epi::AFTER_DRAIN) { E.fused(acc, cur, wr, wc, fr, fq, lds, wid, lane); S.done(cur); }
#undef PG8_SA
#undef PG8_SB
#undef PG8_STAGE
#undef PG8_LDA
#undef PG8_LDB
#undef PG8_MMA
#undef PG8_WAIT_V
#undef PG8_WAIT_L
#undef PG8_BAR
#undef PG8_SCHED
}
}

#include <hip/hip_bf16.h>
#include <cmath>
namespace attn_body {
using bf16=__hip_bfloat16;
using bf16x8=__attribute__((ext_vector_type(8)))short;
using s16x4=__attribute__((ext_vector_type(4)))short;
using f32x16=__attribute__((ext_vector_type(16)))float;
using u32x4=__attribute__((ext_vector_type(4)))unsigned;
constexpr int BATCH=2,NHEAD=16,SEQ=8192,D=64,DM=NHEAD*D;
constexpr int NW=8,QBLK=32,QB=QBLK*NW,KVBLK=64,NQB=SEQ/QB;
constexpr int ATTN_PITCH=DM, ATTN_UNIT_ROWS=QB;
__device__ __forceinline__ int crow(int r,int hi){return (r&3)+8*(r>>2)+4*hi;}
#define SBAR() __builtin_amdgcn_sched_barrier(0)
typedef const __attribute__((address_space(3))) float* lds_cfp;
__device__ __forceinline__ void cmask(f32x16&p0,f32x16&p1,int jb,int qrel,int hi,lds_cfp bt){
  const float NEG=-INFINITY; const int kb=64*jb+4*hi;
  #pragma unroll
  for(int r=0;r<16;++r){const int d0=qrel-(kb+(r&3)+8*(r>>2)), d1=d0-32;
    const float b0=bt[d0<0?0:(d0>127?127:d0)], b1=bt[d1<0?0:(d1>127?127:d1)];
    p0[r]=d0<0?NEG:p0[r]+b0; p1[r]=d1<0?NEG:p1[r]+b1;}
}

constexpr int NSLOT=3, SLOTB=8192;
constexpr int LDS_K=0, LDS_V=NSLOT*SLOTB, LDS_WS=2*NSLOT*SLOTB, LDS_OST=LDS_WS+NW*64*4, LDS_BYTES=LDS_OST+NW*4096;
constexpr float C2_=0.125f*1.4426950408889634f;
__device__ __forceinline__ void glds16(const void*gsrc,unsigned lds_dst){unsigned keep;
  asm volatile("s_mov_b32 %0, m0\n\ts_mov_b32 m0, %2\n\ts_nop 0\n\tglobal_load_lds_dwordx4 %1, off\n\ts_mov_b32 m0, %0":"=&s"(keep):"v"(gsrc),"s"(lds_dst):"memory");}
__device__ __forceinline__ float max3f(float a,float b,float c){float r;asm("v_max3_f32 %0, %1, %2, %3":"=v"(r):"v"(a),"v"(b),"v"(c));return r;}
__device__ __forceinline__ float max2f(float a,float b){float r;asm("v_max_f32_e32 %0, %1, %2":"=v"(r):"v"(a),"v"(b));return r;}
__device__ __forceinline__ float fadd_s(float a,float b){float r;asm("v_add_f32_e32 %0, %1, %2":"=v"(r):"v"(a),"v"(b));return r;}
__device__ __forceinline__ float fsub_s(float a,float b){float r;asm("v_sub_f32_e32 %0, %1, %2":"=v"(r):"v"(a),"v"(b));return r;}
typedef float f32x2_t __attribute__((ext_vector_type(2))); typedef __bf16 bf16x2_t __attribute__((ext_vector_type(2)));
__device__ __forceinline__ unsigned cvtpk_s(float lo,float hi){f32x2_t v={lo,hi};bf16x2_t b=__builtin_convertvector(v,bf16x2_t);return __builtin_bit_cast(unsigned,b);}
#define WAIT_BAR(N) asm volatile("s_waitcnt vmcnt(" #N ") lgkmcnt(0)\n\ts_barrier":::"memory")

__device__ __forceinline__ void qkt(f32x16&p0,f32x16&p1,const char*Kslot,const bf16x8*qr,const f32x16&negm,int r32,int hi){
  const char*kb=Kslot+hi*1024+r32*16;
  #pragma unroll
  for(int d0=0;d0<4;++d0){
    const bf16x8 b0=*reinterpret_cast<const bf16x8*>(kb+d0*2048);
    const bf16x8 b1=*reinterpret_cast<const bf16x8*>(kb+d0*2048+512);
    if(d0==0){p0=__builtin_amdgcn_mfma_f32_32x32x16_bf16(b0,qr[0],negm,0,0,0);p1=__builtin_amdgcn_mfma_f32_32x32x16_bf16(b1,qr[0],negm,0,0,0);}
    else{p0=__builtin_amdgcn_mfma_f32_32x32x16_bf16(b0,qr[d0],p0,0,0,0);p1=__builtin_amdgcn_mfma_f32_32x32x16_bf16(b1,qr[d0],p1,0,0,0);}}
}
typedef __attribute__((address_space(3))) const char* lds_cptr;
typedef short v4i16_t __attribute__((ext_vector_type(4)));
__device__ __forceinline__ void kload8(bf16x8*kf,lds_cptr kp){
  kf[0]=*(const __attribute__((address_space(3))) bf16x8*)(kp);      kf[1]=*(const __attribute__((address_space(3))) bf16x8*)(kp+512);
  kf[2]=*(const __attribute__((address_space(3))) bf16x8*)(kp+2048); kf[3]=*(const __attribute__((address_space(3))) bf16x8*)(kp+2560);
  kf[4]=*(const __attribute__((address_space(3))) bf16x8*)(kp+4096); kf[5]=*(const __attribute__((address_space(3))) bf16x8*)(kp+4608);
  kf[6]=*(const __attribute__((address_space(3))) bf16x8*)(kp+6144); kf[7]=*(const __attribute__((address_space(3))) bf16x8*)(kp+6656);
}
__device__ __forceinline__ void kload2(bf16x8*kf,lds_cptr kp,int j){ kf[2*j]=*(const __attribute__((address_space(3))) bf16x8*)(kp+j*2048); kf[2*j+1]=*(const __attribute__((address_space(3))) bf16x8*)(kp+j*2048+512); }
__device__ __forceinline__ s16x4 vtr(lds_cptr p){ return __builtin_bit_cast(s16x4,__builtin_amdgcn_ds_read_tr16_b64_v4i16((__attribute__((address_space(3))) v4i16_t*)p)); }
__device__ __forceinline__ float rowmax(const f32x16&p0,const f32x16&p1){
  float a=max3f(p0[0],p0[1],p1[0]),b=max3f(p0[2],p0[3],p1[1]);a=max3f(a,p1[2],p1[3]);
  #pragma unroll
  for(int r=4;r<16;r+=4){a=max3f(a,p0[r],p0[r+1]);b=max3f(b,p0[r+2],p0[r+3]);a=max3f(a,p1[r],p1[r+1]);b=max3f(b,p1[r+2],p1[r+3]);}
  const float m=max2f(a,b);
  auto rr=__builtin_amdgcn_permlane32_swap(__float_as_uint(m),__float_as_uint(m),false,false);
  return max2f(__uint_as_float(rr[0]),__uint_as_float(rr[1]));
}
__device__ __forceinline__ void pv(f32x16*o,int vb,bf16x8 pa0,bf16x8 pa1,bf16x8 pa2,bf16x8 pa3){
  #pragma unroll
  for(int d0=0;d0<2;++d0){s16x4 lo[4],hi[4];
    #pragma unroll
    for(int ks=0;ks<4;++ks){
      asm volatile("ds_read_b64_tr_b16 %0,%1 offset:%c2":"=&v"(lo[ks]):"v"(vb),"i"(d0*4096+ks*1024):"memory");
      asm volatile("ds_read_b64_tr_b16 %0,%1 offset:%c2":"=&v"(hi[ks]):"v"(vb),"i"(d0*4096+ks*1024+512):"memory");}
    asm volatile("s_waitcnt lgkmcnt(0)":::"memory");SBAR();
    #define PK(k) (bf16x8){lo[k][0],lo[k][1],lo[k][2],lo[k][3],hi[k][0],hi[k][1],hi[k][2],hi[k][3]}
    o[d0]=__builtin_amdgcn_mfma_f32_32x32x16_bf16(pa0,PK(0),o[d0],0,0,0);
    o[d0]=__builtin_amdgcn_mfma_f32_32x32x16_bf16(pa1,PK(1),o[d0],0,0,0);
    o[d0]=__builtin_amdgcn_mfma_f32_32x32x16_bf16(pa2,PK(2),o[d0],0,0,0);
    o[d0]=__builtin_amdgcn_mfma_f32_32x32x16_bf16(pa3,PK(3),o[d0],0,0,0);
    #undef PK
  }
}

#ifndef ATTN_STORE16
#define ATTN_STORE16(p,v) (*(u32x4*)(p)=(v))
#endif
template<int THRL> __device__ __forceinline__ void attn_unit(int b,int h,int qb,const bf16*Q,const bf16*__restrict__ K,const bf16*__restrict__ V,bf16*O,char*shm,lds_cfp btab){
  const lds_cfp bt=btab+(h>>2)*128;
  int tid_=threadIdx.x; asm volatile("":"+v"(tid_));
  const int tid=tid_,lane=tid&63,r32=lane&31,hi=lane>>5; const int wid=__builtin_amdgcn_readfirstlane(tid>>6);
  const long rowbase=(long)b*SEQ; const int q0=qb*QB;
  const bf16*Qw=Q+(rowbase+q0+wid*QBLK)*DM+h*D;
  const bf16*Kh=K+rowbase*DM+h*D,*Vh=V+rowbase*DM+h*D;
  const unsigned lds0=(unsigned)(uintptr_t)shm;
  float*wsf=(float*)(shm+LDS_WS)+wid*64;
  const bf16*ksrc=Kh+(long)lane*DM+wid*8;
  const bf16*vsrc=Vh+(long)(16*(wid&3)+(lane>>2))*DM+(wid>>2)*32+(lane&3)*8;
  const unsigned kdst=lds0+LDS_K+wid*1024, vdst=lds0+LDS_V+wid*1024;
  #define DMA_K(t,slot) glds16(ksrc+(long)(t)*KVBLK*DM,(unsigned)__builtin_amdgcn_readfirstlane(kdst+(slot)))
  #define DMA_V(t,slot) glds16(vsrc+(long)(t)*KVBLK*DM,(unsigned)__builtin_amdgcn_readfirstlane(vdst+(slot)))
  const int vb0=(int)(lds0+LDS_V)+((lane>>4)&1)*32+(lane&3)*8+(4*hi+((lane&15)>>2))*64;
  const char*Kbase=shm+LDS_K; bf16x8 kf[8];
  const lds_cptr shm3=(lds_cptr)shm; const lds_cptr kp0=shm3+LDS_K+hi*1024+r32*16; const lds_cptr vp0=shm3+LDS_V+((lane>>4)&1)*32+(lane&3)*8+(4*hi+((lane&15)>>2))*64;
  const int NT=(q0+QB)/KVBLK;
  DMA_K(0,0);DMA_V(0,0);DMA_K(1,SLOTB);
  bf16x8 qr[4];
  #pragma unroll
  for(int d0=0;d0<4;++d0)qr[d0]=*reinterpret_cast<const bf16x8*>(&Qw[(long)r32*DM+d0*16+hi*8]);
  float mhat=0.f,l_reg=0.f;f32x16 o[2];o[0]=f32x16{};o[1]=f32x16{};f32x16 negm=f32x16{};asm volatile("":"+v"(negm));
  const int qrel=wid*QBLK+r32;
  #define CMASK(P0,P1,t) do{int jb_=(t)-(NT-4); if(jb_>=-2)cmask(P0,P1,jb_,qrel,hi,bt);}while(0)
  bool resc=false;
  #define START(P0,P1) do{ const float rm=rowmax(P0,P1); resc=false; \
    { const float dl=rm; mhat=fadd_s(mhat,dl); \
      _Pragma("unroll") for(int r=0;r<16;++r){P0[r]=fsub_s(P0[r],dl);P1[r]=fsub_s(P1[r],dl);} \
      _Pragma("unroll") for(int r=0;r<16;++r)negm[r]=-mhat; asm volatile("":"+v"(negm)); } \
    _Pragma("unroll") for(int r=0;r<16;++r)P0[r]=__builtin_amdgcn_exp2f(P0[r]); }while(0)
  #define RESC() do{ if(resc){ asm volatile("s_waitcnt lgkmcnt(0)":::"memory"); \
      _Pragma("unroll") for(int d_=0;d_<2;++d_) _Pragma("unroll") for(int r=0;r<16;++r)o[d_][r]*=wsf[crow(r,hi)]; } }while(0)
  f32x16 pA0,pA1,pB0,pB1;
  int sl_prev=0,sl_cur=0,sl_next=SLOTB;
  #define ROT() do{sl_prev=sl_cur;sl_cur=sl_next;sl_next=(sl_next==(NSLOT-1)*SLOTB)?0:sl_next+SLOTB;}while(0)
  DMA_K(2,2*SLOTB);
  WAIT_BAR(3);
  qkt(pA0,pA1,Kbase,qr,negm,r32,hi);asm volatile("s_nop 15\n\ts_nop 7":"+v"(pA0),"+v"(pA1));CMASK(pA0,pA1,0);
  START(pA0,pA1);
  _Pragma("unroll") for(int r=0;r<16;++r)pA1[r]=__builtin_amdgcn_exp2f(pA1[r]);
  WAIT_BAR(0);
  DMA_K(3,0);DMA_V(1,SLOTB);
  ROT();
  kload8(kf,kp0+sl_cur);
  WAIT_BAR(2);
  s16x4 vlo[8],vhi[8]; u32x4 pw0,pw1,pw2,pw3;
  #define PKW(P,B) cvtpk_s(P[B],P[B+1])
  #define PAF(k) __builtin_bit_cast(bf16x8,pw##k)
  #define VFR(i) (bf16x8){vlo[i][0],vlo[i][1],vlo[i][2],vlo[i][3],vhi[i][0],vhi[i][1],vhi[i][2],vhi[i][3]}
  #define PIN(x) asm volatile("":"+v"(x))
  #define MX3(a,b,c) __builtin_fmaxf(__builtin_fmaxf((a),(b)),(c))
  #define GAPA(MF,A0,A1,A2,A3,W0,W1,PW) do{ MF; sacc+=A0; sacc+=A1; sacc+=A2; sacc+=A3; PIN(sacc); W0; W1; PIN(PW); SBAR(); }while(0)
  #define EX(v) __builtin_amdgcn_exp2f(v)
  #define GAPB(MF,X,B) do{ MF; X[B]=EX(X[B]); X[B+1]=EX(X[B+1]); X[B+2]=EX(X[B+2]); X[B+3]=EX(X[B+3]); PIN(X); SBAR(); }while(0)
  #define VRD(i) do{ vlo[i]=vtr(vp_+(((i)>>2)*4096+((i)&3)*1024)); vhi[i]=vtr(vp_+(((i)>>2)*4096+((i)&3)*1024+512)); }while(0)
  #define KRD(G,j) do{ if(G){ kload2(kf,kp0+sl_next,j); SBAR(); } }while(0)
  #define STEP(C0,C1,P0,P1,t,GK,GV,GL) do{ SBAR(); \
    const lds_cptr vp_=vp0+sl_prev; \
    VRD(0); SBAR(); float sacc=(P0[0]+P0[1]); \
    GAPA(C0=__builtin_amdgcn_mfma_f32_32x32x16_bf16(kf[0],qr[0],negm,0,0,0), P0[2],P0[3],P0[4],P0[5],     pw0[0]=PKW(P0,0), pw0[1]=PKW(P0,2), pw0); \
    VRD(4); SBAR(); GAPA(C1=__builtin_amdgcn_mfma_f32_32x32x16_bf16(kf[1],qr[0],negm,0,0,0), P0[6],P0[7],P0[8],P0[9],     pw0[2]=PKW(P0,4), pw0[3]=PKW(P0,6), pw0); \
    VRD(1); SBAR(); GAPA(C0=__builtin_amdgcn_mfma_f32_32x32x16_bf16(kf[2],qr[1],C0,0,0,0),   P0[10],P0[11],P0[12],P0[13], pw1[0]=PKW(P0,8), pw1[1]=PKW(P0,10), pw1); \
    VRD(5); SBAR(); GAPA(C1=__builtin_amdgcn_mfma_f32_32x32x16_bf16(kf[3],qr[1],C1,0,0,0),   P0[14],P0[15],P1[0],P1[1],   pw1[2]=PKW(P0,12),pw1[3]=PKW(P0,14), pw1); \
    VRD(2); SBAR(); GAPA(C0=__builtin_amdgcn_mfma_f32_32x32x16_bf16(kf[4],qr[2],C0,0,0,0),   P1[2],P1[3],P1[4],P1[5],     pw2[0]=PKW(P1,0), pw2[1]=PKW(P1,2), pw2); \
    VRD(6); SBAR(); GAPA(C1=__builtin_amdgcn_mfma_f32_32x32x16_bf16(kf[5],qr[2],C1,0,0,0),   P1[6],P1[7],P1[8],P1[9],     pw2[2]=PKW(P1,4), pw2[3]=PKW(P1,6), pw2); \
    VRD(3); SBAR(); GAPA(C0=__builtin_amdgcn_mfma_f32_32x32x16_bf16(kf[6],qr[3],C0,0,0,0),   P1[10],P1[11],P1[12],P1[13], pw3[0]=PKW(P1,8), pw3[1]=PKW(P1,10), pw3); \
    VRD(7); SBAR(); GAPA(C1=__builtin_amdgcn_mfma_f32_32x32x16_bf16(kf[7],qr[3],C1,0,0,0),   P1[14],P1[15],0.f,0.f,       pw3[2]=PKW(P1,12),pw3[3]=PKW(P1,14), pw3); \
    l_reg+=sacc; \
    if(GK){DMA_K((t)+3,sl_cur);} if(GV){DMA_V((t)+1,sl_next);} \
    CMASK(C0,C1,t); \
    { float a=MX3(C0[0],C0[1],C1[0]),b=MX3(C0[2],C0[3],C1[1]); a=MX3(a,C1[2],C1[3]); \
      _Pragma("unroll") for(int r=4;r<16;r+=4){a=MX3(a,C0[r],C0[r+1]);b=MX3(b,C0[r+2],C0[r+3]);a=MX3(a,C1[r],C1[r+1]);b=MX3(b,C1[r+2],C1[r+3]);} \
      float rm=__builtin_fmaxf(a,b); { auto rr=__builtin_amdgcn_permlane32_swap(__float_as_uint(rm),__float_as_uint(rm),false,false); rm=__builtin_fmaxf(__uint_as_float(rr[0]),__uint_as_float(rr[1])); } \
      resc=false; \
      if(__builtin_expect(__any(rm>(float)THRL),0)){ const float dl=__builtin_fmaxf(rm,0.f); mhat+=dl; \
        _Pragma("unroll") for(int r=0;r<16;++r){C0[r]-=dl;C1[r]-=dl;} \
        _Pragma("unroll") for(int r=0;r<16;++r)negm[r]=-mhat; asm volatile("":"+v"(negm)); \
        const float f=__builtin_amdgcn_exp2f(-dl); l_reg*=f; if(hi==0)wsf[r32]=f; resc=true; } } \
    SBAR(); \
    GAPB(o[0]=__builtin_amdgcn_mfma_f32_32x32x16_bf16(PAF(0),VFR(0),o[0],0,0,0), C0,0); \
    GAPB(o[1]=__builtin_amdgcn_mfma_f32_32x32x16_bf16(PAF(0),VFR(4),o[1],0,0,0), C0,4); \
    KRD(GL,0); GAPB(o[0]=__builtin_amdgcn_mfma_f32_32x32x16_bf16(PAF(1),VFR(1),o[0],0,0,0), C0,8); \
    KRD(GL,1); GAPB(o[1]=__builtin_amdgcn_mfma_f32_32x32x16_bf16(PAF(1),VFR(5),o[1],0,0,0), C0,12); \
    KRD(GL,2); GAPB(o[0]=__builtin_amdgcn_mfma_f32_32x32x16_bf16(PAF(2),VFR(2),o[0],0,0,0), C1,0); \
    KRD(GL,3); GAPB(o[1]=__builtin_amdgcn_mfma_f32_32x32x16_bf16(PAF(2),VFR(6),o[1],0,0,0), C1,4); \
    GAPB(o[0]=__builtin_amdgcn_mfma_f32_32x32x16_bf16(PAF(3),VFR(3),o[0],0,0,0), C1,8); \
    GAPB(o[1]=__builtin_amdgcn_mfma_f32_32x32x16_bf16(PAF(3),VFR(7),o[1],0,0,0), C1,12); \
    }while(0)
  int t=1;
  #undef CMASK
  #define CMASK(P0,P1,t) do{}while(0)
  for(;t+7<NT;t+=2){
    STEP(pB0,pB1,pA0,pA1,t,true,true,true);     WAIT_BAR(2); RESC(); ROT();
    STEP(pA0,pA1,pB0,pB1,t+1,true,true,true);   WAIT_BAR(2); RESC(); ROT();
  }
  #undef CMASK
  #define CMASK(P0,P1,t) do{int jb_=(t)-(NT-4); if(jb_>=-2)cmask(P0,P1,jb_,qrel,hi,bt);}while(0)
  #define ENDW(tt) do{ if((tt)+3<NT){WAIT_BAR(2);} else if((tt)+2<NT){WAIT_BAR(1);} else {WAIT_BAR(0);} }while(0)
  for(;t+1<NT;t+=2){
    STEP(pB0,pB1,pA0,pA1,t,(t+3<NT),(t+1<NT),(t+1<NT));       ENDW(t);   RESC(); ROT();
    STEP(pA0,pA1,pB0,pB1,t+1,(t+4<NT),(t+2<NT),(t+2<NT));     ENDW(t+1); RESC(); ROT();
  }
  STEP(pB0,pB1,pA0,pA1,NT-1,false,false,false); RESC();
  { float sacc=pB0[0]+pB0[1]; _Pragma("unroll") for(int r=2;r<16;++r)sacc+=pB0[r]; _Pragma("unroll") for(int r=0;r<16;++r)sacc+=pB1[r]; l_reg+=sacc;
    pw0=(u32x4){PKW(pB0,0),PKW(pB0,2),PKW(pB0,4),PKW(pB0,6)};pw1=(u32x4){PKW(pB0,8),PKW(pB0,10),PKW(pB0,12),PKW(pB0,14)};pw2=(u32x4){PKW(pB1,0),PKW(pB1,2),PKW(pB1,4),PKW(pB1,6)};pw3=(u32x4){PKW(pB1,8),PKW(pB1,10),PKW(pB1,12),PKW(pB1,14)};
    SBAR(); pv(o,vb0+sl_cur,PAF(0),PAF(1),PAF(2),PAF(3)); }
  #undef PKW
  #undef PAF
  #undef VFR
  #undef PIN
  #undef MX3
  #undef GAPA
  #undef GAPB
  #undef EX
  #undef VRD
  #undef KRD
  #undef STEP
  #undef ENDW
  {auto rr=__builtin_amdgcn_permlane32_swap(__float_as_uint(l_reg),__float_as_uint(l_reg),false,false);l_reg=__uint_as_float(rr[0])+__uint_as_float(rr[1]);}
  if(hi==0)wsf[32+r32]=l_reg;asm volatile("s_waitcnt lgkmcnt(0)":::"memory");
  float rli[16];
  #pragma unroll
  for(int r=0;r<16;++r)rli[r]=__builtin_amdgcn_rcpf(wsf[32+crow(r,hi)]);
  bf16*Ow=O+(rowbase+q0+wid*QBLK)*DM+h*D;
  { bf16*stg=(bf16*)(shm+LDS_OST)+wid*2048;
    #pragma unroll
    for(int r=0;r<16;++r){const int orow=crow(r,hi);
      #pragma unroll
      for(int d0=0;d0<2;++d0)stg[orow*64+d0*32+r32]=__float2bfloat16(o[d0][r]*rli[r]);}
    asm volatile("s_waitcnt lgkmcnt(0)":::"memory");
    #pragma unroll
    for(int i=0;i<4;++i){const int row=i*8+(lane>>3),ch=lane&7; const u32x4 v=*(const u32x4*)(stg+row*64+ch*8); ATTN_STORE16(Ow+(long)row*DM+ch*8,v);} }
  asm volatile("s_waitcnt lgkmcnt(0)\n\ts_barrier":::"memory");
  #undef DMA_K
  #undef DMA_V
  #undef CMASK
  #undef START
  #undef RESC
  #undef ROT
}
constexpr int ATTN_LDS_BYTES=LDS_BYTES;
struct AttnTensors { const bf16* Q; const bf16* K; const bf16* V; bf16* O; };
struct AttnUnit { int bh; int qb; };
struct StaticOrder {
  int vcu;
  __device__ __forceinline__ explicit StaticOrder(int grid,int block):vcu((block%8)*(grid/8)+block/8){}
  __device__ __forceinline__ bool next(int i,AttnUnit&u)const{ if(i>=4)return false; const int s=vcu&7; u.bh=vcu>>3; u.qb=(i==0)?s:(i==1)?15-s:(i==2)?16+s:31-s; return true; }
  __device__ __forceinline__ void a_ready(const AttnUnit&)const{}
  __device__ __forceinline__ void done(const AttnUnit&)const{}
};
template<class Sched,int THRL=8> __device__ __forceinline__ void attn_phase(char*lds,const AttnTensors&T,const Sched&S,lds_cfp btab){
  AttnUnit u;
  for(int i=0;S.next(i,u);++i){ S.a_ready(u); attn_unit<THRL>(u.bh/NHEAD,u.bh%NHEAD,u.qb,T.Q,T.K,T.V,T.O,lds,btab); S.done(u); }
}
#undef SBAR
#undef WAIT_BAR
}

constexpr int NWAVES = 8;
constexpr size_t MiB = 1u << 20;
constexpr size_t WS_CTL = 0, CTL_ZERO_BYTES = 1 * MiB;
constexpr size_t WS_WIN = 2 * MiB, WS_WOUT = 8 * MiB, WS_WGLU = 10 * MiB, WS_TAB = 11 * MiB, WS_E = 12 * MiB, WS_QS = 14 * MiB, WS_PART = 16 * MiB;
constexpr size_t WS_XN = 32 * MiB, WS_Q = 66 * MiB, WS_K = 98 * MiB, WS_V = 130 * MiB, WS_GA = 162 * MiB, WS_U = 179 * MiB, WS_GS = 196 * MiB, WS_Z = 213 * MiB, WS_A2 = 230 * MiB, WS_END = 264 * MiB;
constexpr int TB_LAM = 0, TB_BIAS = 64  , TB_END = 64 + 512;
constexpr int CW_BAR = 4096;

constexpr int RING_OFF = 0, RING_BYTES = 131072;
constexpr int LDSCTL_OFF = RING_BYTES, MISC_OFF = LDSCTL_OFF + 320;
constexpr int LDS_BYTES = 147456;

#define GAS __attribute__((address_space(1)))
#define LAS __attribute__((address_space(3)))
typedef unsigned short bf16;
typedef unsigned v4u __attribute__((ext_vector_type(4)));
typedef float f32x4 __attribute__((ext_vector_type(4)));
typedef short bf16x8 __attribute__((ext_vector_type(8)));
typedef GAS unsigned gu32;
typedef GAS unsigned long long gu64;
#define RLX_AGENT __ATOMIC_RELAXED, __HIP_MEMORY_SCOPE_AGENT
#define LDS_WAIT() asm volatile("s_waitcnt lgkmcnt(0)" ::: "memory")
#define VM_WAIT() asm volatile("s_waitcnt vmcnt(0)" ::: "memory")
__device__ __forceinline__ unsigned long long rt() { return __builtin_amdgcn_s_memrealtime(); }
__device__ __forceinline__ unsigned f2bf(float f) { unsigned u = __builtin_bit_cast(unsigned, f); return (u + 0x7fffu + ((u >> 16) & 1u)) >> 16; }
__device__ __forceinline__ unsigned pk2(float lo, float hi) { return f2bf(lo) | (f2bf(hi) << 16); }

#define XB_TMO      128
#define XB_XCNT(j)  (256  + 64 * (j))
#define XB_XSUB(j)  (1280 + 64 * (j))
#define XB_XGEN(j)  (2304 + 64 * (j))
#define XB_TOP      3328
#define XB_TOPGEN   3392
#define XCD_BAR_WORDS 3456
#define XB_SPIN_CAP (1u << 18)

__device__ __forceinline__ unsigned xb_ld(unsigned* p)              { return __hip_atomic_load(p, __ATOMIC_RELAXED, __HIP_MEMORY_SCOPE_AGENT); }
__device__ __forceinline__ unsigned xb_add(unsigned* p, unsigned v) { return __hip_atomic_fetch_add(p, v, __ATOMIC_RELAXED, __HIP_MEMORY_SCOPE_AGENT); }
__device__ __forceinline__ unsigned xb_xcc_id() { return (unsigned)__builtin_amdgcn_s_getreg((3 << 11) | 20) & 0xFu; }
#define XB_SPIN(cond, bar) do { unsigned _sp = 0; while (cond) { __builtin_amdgcn_s_sleep(1); \
    if ((++_sp & 255u) == 0u) { if (xb_ld(&(bar)[XB_TMO])) break; if (_sp > XB_SPIN_CAP) { atomicAdd(&(bar)[XB_TMO], 1u); break; } } } } while (0)

struct XcdBarrier {
    unsigned* bar; unsigned x;
    volatile LAS unsigned* st;
};

__device__ __forceinline__ XcdBarrier xcd_barrier_post(unsigned* bar, volatile LAS unsigned* st) {
    XcdBarrier b; b.bar = bar; b.x = xb_xcc_id(); b.st = st;
    if (threadIdx.x == 0) (void)xb_add(&bar[XB_XCNT(b.x)], 1u);
    return b;
}
__device__ __forceinline__ void xcd_barrier_complete(unsigned* bar, unsigned x, unsigned& nloc, unsigned& nx) {
    const unsigned G = gridDim.x * gridDim.y * gridDim.z;
    unsigned sum, cnt, mine, sp = 0u;
    for (;;) {
        sum = 0u; cnt = 0u; mine = 0u;
#pragma unroll
        for (unsigned j = 0; j < 16; ++j) { const unsigned c = xb_ld(&bar[XB_XCNT(j)]); sum += c; cnt += (c > 0u) ? 1u : 0u; mine = (j == x) ? c : mine; }
        if (sum == G) break;
        __builtin_amdgcn_s_sleep(1);
        if ((++sp & 255u) == 0u) { if (xb_ld(&bar[XB_TMO])) break; if (sp > XB_SPIN_CAP) { atomicAdd(&bar[XB_TMO], 1u); break; } }
    }
    nloc = mine > 0u ? mine : 1u; nx = cnt > 0u ? cnt : 1u;
}

__device__ __forceinline__ void xcd_barrier(const XcdBarrier& b) {
    asm volatile("s_waitcnt vmcnt(0)" ::: "memory");
    __syncthreads();
    if (threadIdx.x == 0) {
        unsigned* bar = b.bar;
        __builtin_amdgcn_s_waitcnt(0);
        unsigned nloc = b.st[0], nx = b.st[1];
        if (nloc == 0u) { xcd_barrier_complete(bar, b.x, nloc, nx); b.st[0] = nloc; b.st[1] = nx; }
        const unsigned old = xb_add(&bar[XB_XSUB(b.x)], 1u);
        const unsigned gen = old / nloc;
        if (old + 1u == (gen + 1u) * nloc) {
            __builtin_amdgcn_fence(__ATOMIC_RELEASE, "agent");
            asm volatile("s_waitcnt vmcnt(0)" ::: "memory");
            const unsigned og = xb_add(&bar[XB_TOP], 1u);
            const unsigned tg = og / nx;
            if (og + 1u == (tg + 1u) * nx) xb_add(&bar[XB_TOPGEN], 1u);
            else XB_SPIN(xb_ld(&bar[XB_TOPGEN]) == tg, bar);
            __builtin_amdgcn_fence(__ATOMIC_ACQUIRE, "agent");
            xb_add(&bar[XB_XGEN(b.x)], 1u);
            asm volatile("s_waitcnt vmcnt(0)" ::: "memory");
        } else {
            XB_SPIN(xb_ld(&bar[XB_XGEN(b.x)]) == gen, bar);
            __builtin_amdgcn_fence(__ATOMIC_ACQUIRE, "agent");
            asm volatile("s_waitcnt vmcnt(0)" ::: "memory");
        }
    }
    __syncthreads();
}

__device__ __forceinline__ float wave_sum(float v) {
#pragma unroll
    for (int o = 1; o < 64; o <<= 1) v += __shfl_xor(v, o);
    return v;
}
__device__ __forceinline__ void p0_transpose_item(const float* W, int K, int N, bf16* WT, bool permute, LAS float* scr, int item, int lane) {
    const int nblk = N / 32, kb = item / nblk, nb = item % nblk, k0 = 64 * kb, n0 = 32 * nb;
    int d0 = n0; if (permute) { const int a = n0 & 255; d0 = (n0 & ~255) + 128 * ((a >> 5) & 1) + 32 * (a >> 6); }
#pragma unroll 8
    for (int i = 0; i < 32; ++i) { const int kk = 2 * i + (lane >> 5); scr[kk * 33 + (lane & 31)] = W[(size_t)(k0 + kk) * N + n0 + (lane & 31)]; }
    LDS_WAIT(); asm volatile("" ::: "memory");
    const int c = lane & 7;
#pragma unroll
    for (int j = 0; j < 4; ++j) { const int n = (lane >> 3) + 8 * j; const LAS float* s = scr + (8 * c) * 33 + n;
        v4u o; o.x = pk2(s[0 * 33], s[1 * 33]); o.y = pk2(s[2 * 33], s[3 * 33]); o.z = pk2(s[4 * 33], s[5 * 33]); o.w = pk2(s[6 * 33], s[7 * 33]);
        *(GAS v4u*)(WT + (size_t)(d0 + n) * K + k0 + 8 * c) = o; }
    LDS_WAIT(); asm volatile("" ::: "memory");
}
__device__ __forceinline__ void rms_row_to_bf16(const float* xrow, const float* g, bf16* orow, int lane) {
    const GAS f32x4* xr = (const GAS f32x4*)xrow + lane; const GAS f32x4* gr = (const GAS f32x4*)g + lane;
    f32x4 v[4]; float s = 0.f;
#pragma unroll
    for (int j = 0; j < 4; ++j) { v[j] = xr[64 * j]; s += (v[j].x * v[j].x + v[j].y * v[j].y) + (v[j].z * v[j].z + v[j].w * v[j].w); }
    const float rs = rsqrtf(wave_sum(s) * (1.f / DM) + EPS);
    GAS unsigned long long* o8 = (GAS unsigned long long*)orow + lane;
#pragma unroll
    for (int j = 0; j < 4; ++j) { const f32x4 gg = gr[64 * j]; const f32x4 y = v[j] * rs * gg;
        o8[64 * j] = (unsigned long long)pk2(y.x, y.y) | ((unsigned long long)pk2(y.z, y.w) << 32); }
}
__device__ __forceinline__ int t5_bucket(int n) {
    if (n < 16) return n;
    int b = 16;
    b += (n >= 19); b += (n >= 21); b += (n >= 24); b += (n >= 27); b += (n >= 31); b += (n >= 35); b += (n >= 40); b += (n >= 46);
    b += (n >= 52); b += (n >= 59); b += (n >= 67); b += (n >= 77); b += (n >= 87); b += (n >= 99); b += (n >= 113);
    return b;
}

typedef float f32x16 __attribute__((ext_vector_type(16)));
typedef float f32x2 __attribute__((ext_vector_type(2)));
typedef unsigned u32x2 __attribute__((ext_vector_type(2)));
typedef unsigned u32x4 __attribute__((ext_vector_type(4)));
__device__ __forceinline__ float bf_lo(unsigned w) { return __uint_as_float(w << 16); }
__device__ __forceinline__ float bf_hi(unsigned w) { return __uint_as_float(w & 0xffff0000u); }
__device__ __forceinline__ unsigned pkbf(float lo, float hi) { return pg8::cvt_pk_bf16(lo, hi); }
__device__ __forceinline__ float ex2(float x) { return __builtin_amdgcn_exp2f(x); }
template <int CTRL> __device__ __forceinline__ float dppf(float x) { return __builtin_bit_cast(float, __builtin_amdgcn_mov_dpp(__builtin_bit_cast(int, x), CTRL, 0xf, 0xf, true)); }
__device__ __forceinline__ float sum16(float v) { v += dppf<0xB1>(v); v += dppf<0x4E>(v); v += dppf<0x141>(v); v += dppf<0x128>(v); return v; }
__device__ __forceinline__ float bc_lo(float x) { auto r = __builtin_amdgcn_permlane32_swap(__float_as_uint(x), __float_as_uint(x), false, false); return __uint_as_float(r[0]); }
__device__ __forceinline__ float bc_hi(float x) { auto r = __builtin_amdgcn_permlane32_swap(__float_as_uint(x), __float_as_uint(x), false, false); return __uint_as_float(r[1]); }
__device__ __forceinline__ void cfma(float& xr, float& xi, float ar, float ai, float br, float bi) { xr = fmaf(ar, br, fmaf(-ai, bi, xr)); xi = fmaf(ar, bi, fmaf(ai, br, xi)); }
__device__ __forceinline__ float gelu_tanh_f(float x) { const float t = 1.5957691216057308f * (x + 0.044715f * x * x * x); return x * __builtin_amdgcn_rcpf(1.0f + __expf(-t)); }

constexpr size_t OFF_TP = 4096, OFF_TA256 = OFF_TP + 65536, OFF_TBF = OFF_TA256 + 16384, OFF_TBB = OFF_TBF + 262144, OFF_TCC = OFF_TBB + 131072, OFF_TEND = OFF_TCC + 131072;
static_assert(OFF_TEND <= (1u << 20), "tables fit");
constexpr size_t WS_KS = 15 * MiB, WS_VS = 13 * MiB;
constexpr size_t WS_PML = WS_PART + 8 * MiB;
constexpr int BT_LDS_OFF = 90112;
constexpr int HROW = 68;

template <bool FULL> __device__ __forceinline__ void ssm_scan_state(f32x16& xr, f32x16& xi, const float (&pw)[8], float& cr, float& ci, bool hi_half) {
#pragma unroll
    for (int i = 0; i < 4; ++i)
#pragma unroll
        for (int j = 1; j < 4; ++j) { float a = xr[4 * i + j], b = xi[4 * i + j]; cfma(a, b, pw[0], pw[1], xr[4 * i + j - 1], xi[4 * i + j - 1]); xr[4 * i + j] = a; xi[4 * i + j] = b; }
    float cinr[4], cini[4];
#pragma unroll
    for (int i = 0; i < 4; ++i) {
        float t0r = xr[4 * i + 3], t0i = xi[4 * i + 3]; cfma(t0r, t0i, pw[6], pw[7], cr, ci);
        const float sr = bc_lo(t0r), si = bc_lo(t0i);
        cinr[i] = hi_half ? sr : cr; cini[i] = hi_half ? si : ci;
        float t1r = xr[4 * i + 3], t1i = xi[4 * i + 3]; cfma(t1r, t1i, pw[6], pw[7], sr, si);
        cr = bc_hi(t1r); ci = bc_hi(t1i);
    }
    if (FULL) {
#pragma unroll
        for (int i = 0; i < 4; ++i)
#pragma unroll
            for (int j = 0; j < 4; ++j) { float a = xr[4 * i + j], b = xi[4 * i + j]; cfma(a, b, pw[2 * j], pw[2 * j + 1], cinr[i], cini[i]); xr[4 * i + j] = a; xi[4 * i + j] = b; }
    }
}

template <bool FULL> __device__ __forceinline__ void ssm_chunk(int b, int chunk, int g, const unsigned char* tab, const bf16* U, float* E, const float* dsk, bf16* Z, float* out, int wmask, LAS unsigned* Hs, int lane) {
    const int r = lane & 31, hh = lane >> 5;
    bf16x8 Bf[4];
#pragma unroll
    for (int X = 0; X < 4; ++X) Bf[X] = *(const bf16x8*)(tab + OFF_TBB + ((size_t)(g * 4 + X) * 64 + lane) * 16);
    float pwl[8], pwh[8];
    { const f32x4* p = (const f32x4*)(tab + OFF_TP + (size_t)(g * 64 + r) * 32); const f32x4 a = p[0], c = p[1]; pwl[0] = a.x; pwl[1] = a.y; pwl[2] = a.z; pwl[3] = a.w; pwl[4] = c.x; pwl[5] = c.y; pwl[6] = c.z; pwl[7] = c.w; }
    { const f32x4* p = (const f32x4*)(tab + OFF_TP + (size_t)(g * 64 + 32 + r) * 32); const f32x4 a = p[0], c = p[1]; pwh[0] = a.x; pwh[1] = a.y; pwh[2] = a.z; pwh[3] = a.w; pwh[4] = c.x; pwh[5] = c.y; pwh[6] = c.z; pwh[7] = c.w; }
    float clr = 0.f, cli = 0.f, chr = 0.f, chi = 0.f;
    bf16x8 Cf[4]; f32x4 dv = {0.f, 0.f, 0.f, 0.f};
    if (FULL) {
        const f32x2 al = *(const f32x2*)(tab + OFF_TA256 + (size_t)(g * 64 + r) * 8), ah = *(const f32x2*)(tab + OFF_TA256 + (size_t)(g * 64 + 32 + r) * 8);
        for (int j = 0; j < chunk; ++j) {
            const float* e = E + ((size_t)((b * 32 + j) * 32 + g) * 64) * 2;
            const f32x2 el = *(const f32x2*)(e + 2 * r), eh = *(const f32x2*)(e + 2 * (32 + r));
            float nr = el.x, ni = el.y; cfma(nr, ni, al.x, al.y, clr, cli); clr = nr; cli = ni;
            float mr = eh.x, mi = eh.y; cfma(mr, mi, ah.x, ah.y, chr, chi); chr = mr; chi = mi;
        }
#pragma unroll
        for (int s = 0; s < 4; ++s) Cf[s] = *(const bf16x8*)(tab + OFF_TCC + ((size_t)(g * 4 + s) * 64 + lane) * 16);
        dv = *(const f32x4*)(dsk + g * 16 + 4 * (lane >> 4));
    }
    const size_t row_c = (size_t)b * SEQ + (size_t)chunk * 256;
    for (int tile = 0; tile < 8; ++tile) {
        const size_t row0 = row_c + tile * 32;
        const bf16x8 uf = *(const bf16x8*)(U + (row0 + r) * DH + 16 * g + 8 * hh);
        const f32x16 zero = {};
        f32x16 X0 = __builtin_amdgcn_mfma_f32_32x32x16_bf16(uf, Bf[0], zero, 0, 0, 0);
        f32x16 X1 = __builtin_amdgcn_mfma_f32_32x32x16_bf16(uf, Bf[1], zero, 0, 0, 0);
        f32x16 X2 = __builtin_amdgcn_mfma_f32_32x32x16_bf16(uf, Bf[2], zero, 0, 0, 0);
        f32x16 X3 = __builtin_amdgcn_mfma_f32_32x32x16_bf16(uf, Bf[3], zero, 0, 0, 0);
        ssm_scan_state<FULL>(X0, X2, pwl, clr, cli, hh != 0);
        ssm_scan_state<FULL>(X1, X3, pwh, chr, chi, hh != 0);
        if (FULL) {
#pragma unroll
            for (int q = 0; q < 16; ++q) { const int t = (q & 3) + 8 * (q >> 2) + 4 * hh;
                Hs[t * HROW + r] = pkbf(X0[q], X2[q]); Hs[t * HROW + 32 + r] = pkbf(X1[q], X3[q]); }
            asm volatile("s_waitcnt lgkmcnt(0)" ::: "memory");
#pragma unroll
            for (int nb = 0; nb < 2; ++nb) {
                f32x4 acc = {0.f, 0.f, 0.f, 0.f};
#pragma unroll
                for (int s = 0; s < 4; ++s) { const bf16x8 hf = *(const LAS bf16x8*)(Hs + (16 * nb + (lane & 15)) * HROW + 16 * s + 4 * (lane >> 4));
                    acc = __builtin_amdgcn_mfma_f32_16x16x32_bf16(Cf[s], hf, acc, 0, 0, 0); }
                const size_t row = row0 + 16 * nb + (lane & 15); const int col = 16 * g + 4 * (lane >> 4);
                const u32x2 uw = *(const u32x2*)(U + row * DH + col);
                const float y0 = acc[0] + dv[0] * bf_lo(uw.x), y1 = acc[1] + dv[1] * bf_hi(uw.x), y2 = acc[2] + dv[2] * bf_lo(uw.y), y3 = acc[3] + dv[3] * bf_hi(uw.y);
                u32x2 zw; zw.x = pkbf(gelu_tanh_f(y0), gelu_tanh_f(y1)); zw.y = pkbf(gelu_tanh_f(y2), gelu_tanh_f(y3));
                *(u32x2*)(Z + row * DH + col) = zw;
            }
            asm volatile("s_waitcnt lgkmcnt(0)" ::: "memory");
        }
    }
    if (!FULL) {
        if (hh == 0) { float* e = E + ((size_t)((b * 32 + chunk) * 32 + g) * 64) * 2; *(f32x2*)(e + 2 * r) = (f32x2){clr, cli}; *(f32x2*)(e + 2 * (32 + r)) = (f32x2){chr, chi}; }
    } else if (chunk == 31 && (wmask & 2) && hh == 0) {
        const int o = (b * 32 + g) * 64;
        out[O_SRP + o + r] = clr; out[O_SIP + o + r] = cli; out[O_SRP + o + 32 + r] = chr; out[O_SIP + o + 32 + r] = chi;
    }
}

__device__ __forceinline__ void ssm_sample_item(int b, int g, const unsigned char* tab, const bf16* U, const float* h0re, const float* h0im, const float* cre, const float* cim, const float* dsk,
                                                bf16* Z, float* out, int wmask, int p) {
    const f32x2 a1 = *(const f32x2*)(tab + OFF_TP + (size_t)(g * 64 + p) * 32);
    float bbr[16], bbi[16], cr[16], ci[16];
    { const f32x4* t = (const f32x4*)(tab + OFF_TBF + (size_t)(g * 64 + p) * 128);
#pragma unroll
      for (int k = 0; k < 4; ++k) { const f32x4 x = t[k], y = t[4 + k]; bbr[4 * k] = x.x; bbr[4 * k + 1] = x.y; bbr[4 * k + 2] = x.z; bbr[4 * k + 3] = x.w; bbi[4 * k] = y.x; bbi[4 * k + 1] = y.y; bbi[4 * k + 2] = y.z; bbi[4 * k + 3] = y.w; } }
#pragma unroll
    for (int c = 0; c < 16; ++c) { cr[c] = cre[(g * 16 + c) * 64 + p]; ci[c] = cim[(g * 16 + c) * 64 + p]; }
    float hr = h0re[(b * 32 + g) * 64 + p], hi = h0im[(b * 32 + g) * 64 + p];
    const float dd = dsk[g * 16 + (p & 15)];
    for (int t = 0; t < 4; ++t) {
        const size_t row = (size_t)MP + b * 4 + t;
        const u32x4 w0 = *(const u32x4*)(U + row * DH + 16 * g), w1 = *(const u32x4*)(U + row * DH + 16 * g + 8);
        float u[16];
        u[0] = bf_lo(w0.x); u[1] = bf_hi(w0.x); u[2] = bf_lo(w0.y); u[3] = bf_hi(w0.y); u[4] = bf_lo(w0.z); u[5] = bf_hi(w0.z); u[6] = bf_lo(w0.w); u[7] = bf_hi(w0.w);
        u[8] = bf_lo(w1.x); u[9] = bf_hi(w1.x); u[10] = bf_lo(w1.y); u[11] = bf_hi(w1.y); u[12] = bf_lo(w1.z); u[13] = bf_hi(w1.z); u[14] = bf_lo(w1.w); u[15] = bf_hi(w1.w);
        float ur = 0.f, ui = 0.f;
#pragma unroll
        for (int c = 0; c < 16; ++c) { ur = fmaf(bbr[c], u[c], ur); ui = fmaf(bbi[c], u[c], ui); }
        cfma(ur, ui, a1.x, a1.y, hr, hi); hr = ur; hi = ui;
        float yv = 0.f, uc = 0.f;
#pragma unroll
        for (int c = 0; c < 16; ++c) { const float s = wave_sum(cr[c] * hr - ci[c] * hi); if (p == c) { yv = s; uc = u[c]; } }
        if (p < 16) { const float z = gelu_tanh_f(yv + dd * uc); Z[row * DH + 16 * g + p] = (bf16)(pkbf(z, z) & 0xffffu); }
    }
    if (wmask & 4) { out[O_SRS + (b * 32 + g) * 64 + p] = hr; out[O_SIS + (b * 32 + g) * 64 + p] = hi; }
}

struct DecAcc { float m[4], l[4]; f32x4 o0[4], o1[4]; };
__device__ __forceinline__ void dec_key(DecAcc& A, const f32x4 (&qv)[4], const f32x4 kv, const f32x4 v0, const f32x4 v1, bool near, int key, const float* bt) {
    float s[4];
#pragma unroll
    for (int qi = 0; qi < 4; ++qi) { const f32x4 t = kv * qv[qi]; s[qi] = sum16((t.x + t.y) + (t.z + t.w)); }
    if (near) {
#pragma unroll
        for (int qi = 0; qi < 4; ++qi) { const int d = 128 + qi - key; s[qi] += bt[d > 127 ? 127 : d]; }
    }
    bool need = false;
#pragma unroll
    for (int qi = 0; qi < 4; ++qi) need |= (s[qi] > A.m[qi] + 8.0f);
    if (__any(need)) {
#pragma unroll
        for (int qi = 0; qi < 4; ++qi) { const float mn = fmaxf(A.m[qi], s[qi]), a = ex2(A.m[qi] - mn); A.l[qi] *= a; A.o0[qi] = A.o0[qi] * a; A.o1[qi] = A.o1[qi] * a; A.m[qi] = mn; }
    }
#pragma unroll
    for (int qi = 0; qi < 4; ++qi) { const float p = ex2(s[qi] - A.m[qi]); A.l[qi] += p; A.o0[qi] = A.o0[qi] + v0 * p; A.o1[qi] = A.o1[qi] + v1 * p; }
}
__device__ __forceinline__ void decode_item(int b, int h, int sp, const float* QS, const float* ck, const float* cv, const int* pt, const float* bt, float* PO, float* PML, int lane) {
    const int hh = lane >> 5, cg = (lane >> 4) & 1, i16 = lane & 15;
    f32x4 qv[4];
#pragma unroll
    for (int qi = 0; qi < 4; ++qi) qv[qi] = *(const f32x4*)(QS + (size_t)(b * 4 + qi) * DH + h * 128 + cg * 64 + 4 * i16);
    DecAcc A;
#pragma unroll
    for (int qi = 0; qi < 4; ++qi) { A.m[qi] = -1e30f; A.l[qi] = 0.f; A.o0[qi] = (f32x4){0.f, 0.f, 0.f, 0.f}; A.o1[qi] = (f32x4){0.f, 0.f, 0.f, 0.f}; }
    for (int pgi = 0; pgi < 4; ++pgi) {
        const int pidx = sp * 4 + pgi; const int pg = pt[b * NPAGES + pidx];
        const float* kb = ck + ((size_t)pg * PAGE * 4 + h) * 128 + cg * 64 + 4 * i16 + (size_t)hh * 512;
        const float* vb = cv + ((size_t)pg * PAGE * 4 + h) * 128 + 4 * i16 + (size_t)hh * 512;
        const bool near = pidx == NPAGES - 1;
        for (int it = 0; it < 64; it += 4) {
            f32x4 kq[4], va[4], vc[4];
#pragma unroll
            for (int u = 0; u < 4; ++u) { const size_t off = (size_t)(it + u) * 1024;
                kq[u] = __builtin_nontemporal_load((const f32x4*)(kb + off)); va[u] = __builtin_nontemporal_load((const f32x4*)(vb + off)); vc[u] = __builtin_nontemporal_load((const f32x4*)(vb + off + 64)); }
#pragma unroll
            for (int u = 0; u < 4; ++u) dec_key(A, qv, kq[u], va[u], vc[u], near, 2 * (it + u) + hh, bt);
        }
    }
#pragma unroll
    for (int qi = 0; qi < 4; ++qi) {
        const float mo = __shfl_xor(A.m[qi], 32), lo = __shfl_xor(A.l[qi], 32), mn = fmaxf(A.m[qi], mo), a = ex2(A.m[qi] - mn), ao = ex2(mo - mn);
        A.l[qi] = A.l[qi] * a + lo * ao; A.m[qi] = mn;
#pragma unroll
        for (int e = 0; e < 4; ++e) { A.o0[qi][e] = A.o0[qi][e] * a + __shfl_xor(A.o0[qi][e], 32) * ao; A.o1[qi][e] = A.o1[qi][e] * a + __shfl_xor(A.o1[qi][e], 32) * ao; }
    }
    if (hh == 0) {
#pragma unroll
        for (int qi = 0; qi < 4; ++qi) { const size_t pi = (size_t)((((b * 4 + h) * 4 + sp) * 2 + cg) * 4 + qi);
            *(f32x4*)(PO + pi * 128 + 4 * i16) = A.o0[qi]; *(f32x4*)(PO + pi * 128 + 64 + 4 * i16) = A.o1[qi];
            if (i16 == 0) { PML[2 * pi] = A.m[qi]; PML[2 * pi + 1] = A.l[qi]; } }
    }
}

__device__ __forceinline__ void combine_sample(int sr, int h, const float* QS, const float* KS, const float* VS, const float* PO, const float* PML, const float* bt, float lam, const float* subg,
                                               const bf16* GA, bf16* A2, int lane) {
    const int b = sr >> 2, qi = sr & 3;
    float oc[2][2];
#pragma unroll
    for (int c = 0; c < 2; ++c) {
        const float qd = QS[(size_t)sr * DH + h * 128 + c * 64 + lane];
        float sj[4];
#pragma unroll
        for (int j = 0; j < 4; ++j) { const float kd = KS[(size_t)(b * 4 + j) * DH + h * 128 + c * 64 + lane]; const float s = wave_sum(qd * kd); sj[j] = j <= qi ? s + bt[qi - j] : -1e30f; }
        float mp[4], lp[4]; float M = fmaxf(fmaxf(sj[0], sj[1]), fmaxf(sj[2], sj[3]));
#pragma unroll
        for (int sp = 0; sp < 4; ++sp) { const size_t pi = (size_t)((((b * 4 + h) * 4 + sp) * 2 + c) * 4 + qi); mp[sp] = PML[2 * pi]; lp[sp] = PML[2 * pi + 1]; M = fmaxf(M, mp[sp]); }
        float Lsum = 0.f, o0 = 0.f, o1 = 0.f;
#pragma unroll
        for (int sp = 0; sp < 4; ++sp) { const size_t pi = (size_t)((((b * 4 + h) * 4 + sp) * 2 + c) * 4 + qi); const float w = ex2(mp[sp] - M); Lsum += lp[sp] * w;
            const f32x2 po = *(const f32x2*)(PO + pi * 128 + 2 * lane); o0 += po.x * w; o1 += po.y * w; }
#pragma unroll
        for (int j = 0; j < 4; ++j) { const float w = j <= qi ? ex2(sj[j] - M) : 0.f; Lsum += w; const f32x2 vv = *(const f32x2*)(VS + (size_t)(b * 4 + j) * DH + h * 128 + 2 * lane); o0 += vv.x * w; o1 += vv.y * w; }
        const float inv = 1.0f / Lsum; oc[c][0] = o0 * inv; oc[c][1] = o1 * inv;
    }
    const float d0 = oc[0][0] - lam * oc[1][0], d1 = oc[0][1] - lam * oc[1][1];
    const float rs = rsqrtf(wave_sum(d0 * d0 + d1 * d1) * (1.0f / 128.0f) + EPS);
    const size_t row = (size_t)MP + sr;
    const unsigned gw = *(const unsigned*)(GA + row * DH + h * 128 + 2 * lane);
    const f32x2 sg = *(const f32x2*)(subg + 2 * lane);
    *(unsigned*)(A2 + row * DM + h * 128 + 2 * lane) = pkbf(d0 * rs * sg.x * 0.8f * bf_lo(gw), d1 * rs * sg.y * 0.8f * bf_hi(gw));
}
__device__ __forceinline__ void combine_prompt_row(size_t row, const bf16* Op, const bf16* GA, float lam, const f32x4 sg0, const f32x4 sg1, bf16* A2, int lane) {
    const int h = lane >> 4, e0 = 8 * (lane & 15);
    const u32x4 a = *(const u32x4*)(Op + row * DM + h * 256 + e0), bq = *(const u32x4*)(Op + row * DM + h * 256 + 128 + e0), gq = *(const u32x4*)(GA + row * DH + h * 128 + e0);
    float d[8];
    d[0] = bf_lo(a.x) - lam * bf_lo(bq.x); d[1] = bf_hi(a.x) - lam * bf_hi(bq.x); d[2] = bf_lo(a.y) - lam * bf_lo(bq.y); d[3] = bf_hi(a.y) - lam * bf_hi(bq.y);
    d[4] = bf_lo(a.z) - lam * bf_lo(bq.z); d[5] = bf_hi(a.z) - lam * bf_hi(bq.z); d[6] = bf_lo(a.w) - lam * bf_lo(bq.w); d[7] = bf_hi(a.w) - lam * bf_hi(bq.w);
    float ss = 0.f;
#pragma unroll
    for (int e = 0; e < 8; ++e) ss += d[e] * d[e];
    const float rs = rsqrtf(sum16(ss) * (1.0f / 128.0f) + EPS) * 0.8f;
    u32x4 o;
    o.x = pkbf(d[0] * rs * sg0.x * bf_lo(gq.x), d[1] * rs * sg0.y * bf_hi(gq.x)); o.y = pkbf(d[2] * rs * sg0.z * bf_lo(gq.y), d[3] * rs * sg0.w * bf_hi(gq.y));
    o.z = pkbf(d[4] * rs * sg1.x * bf_lo(gq.z), d[5] * rs * sg1.y * bf_hi(gq.z)); o.w = pkbf(d[6] * rs * sg1.z * bf_lo(gq.w), d[7] * rs * sg1.w * bf_hi(gq.w));
    *(u32x4*)(A2 + row * DM + h * 128 + e0) = o;
}

__device__ __forceinline__ const void* ldsarg(LAS unsigned char* L, int i) {
    const LAS unsigned* p = (const LAS unsigned*)(L + LDSCTL_OFF) + 2 * i;
    const unsigned lo = __builtin_amdgcn_readfirstlane(p[0]), hi = __builtin_amdgcn_readfirstlane(p[1]);
    return (const void*)(((unsigned long long)hi << 32) | lo);
}
__device__ __forceinline__ unsigned char* opaque_ptr(unsigned char* p) { GAS unsigned char* g = (GAS unsigned char*)p; asm volatile("" : "+s"(g)); return (unsigned char*)g; }
struct Args { const void* in[28]; float* out; unsigned char* ws; int wmask; int pad; };

__global__ void __launch_bounds__(NWAVES * 64, 2) hymba_fwd(Args args) {
    extern __shared__ __attribute__((aligned(16))) unsigned char lds[];
    LAS unsigned char* const L = (LAS unsigned char*)lds;
    volatile LAS unsigned* const MISC = (volatile LAS unsigned*)(L + MISC_OFF);
    const int tid = threadIdx.x, lane = tid & 63, wave = __builtin_amdgcn_readfirstlane(tid >> 6);
    const int G = gridDim.x; const int bx = blockIdx.x; const int vcu = (G % 8 == 0) ? (bx % 8) * (G / 8) + bx / 8 : bx;
    const int gw = vcu * NWAVES + wave, NGW = G * NWAVES;
    for (int u = tid; u < (LDS_BYTES - LDSCTL_OFF) / 4; u += NWAVES * 64) ((LAS unsigned*)(L + LDSCTL_OFF))[u] = 0u;
    __syncthreads();
#define LARG(i) (args.in[(i)])
#define IN_F(i) ((const float*)LARG(i))
#define WS_PTR opaque_ptr(args.ws)
#define OUT_PTR (args.out)
    XcdBarrier bar = xcd_barrier_post((unsigned*)((gu32*)(WS_PTR + WS_CTL) + CW_BAR), MISC + 8);

    {
        unsigned char* const ws = WS_PTR; unsigned char* const tab = ws + WS_TAB; float* const TAB = (float*)tab;
        const float* x_prompt = IN_F(0); const float* x_sample = IN_F(1); const float* norm_g = IN_F(7); const float* w_in = IN_F(8);
        const float* lq1 = IN_F(11); const float* lk1 = IN_F(12); const float* lq2 = IN_F(13); const float* lk2 = IN_F(14); const float* rel_bias = IN_F(16);
        const float* a_re = IN_F(17); const float* a_im = IN_F(18); const float* log_dt = IN_F(19); const float* b_re = IN_F(20); const float* b_im = IN_F(21); const float* c_re = IN_F(22); const float* c_im = IN_F(23);
        const float* w_glu = IN_F(25); const float* w_out = IN_F(27);
        bf16* const WinT = (bf16*)(ws + WS_WIN); bf16* const WoutT = (bf16*)(ws + WS_WOUT); bf16* const WgluT = (bf16*)(ws + WS_WGLU); bf16* const XN = (bf16*)(ws + WS_XN);
        LAS float* scr = (LAS float*)(L + RING_OFF + wave * 16384);
        constexpr int I_IN = (DM / 64) * (NIN / 32), I_OUT = (DM / 64) * (DM / 32), I_GLU = (DH / 64) * (DH / 32);
        constexpr int I_T = I_IN + I_OUT + I_GLU, I_ROWS = I_T + MT, I_ALL = I_ROWS + 2 + 32;
        for (int it = gw; it < I_ALL; it += NGW) {
            int r = it;
            if (r < I_IN) { p0_transpose_item(w_in, DM, NIN, WinT, true, scr, r, lane); continue; } r -= I_IN;
            if (r < I_OUT) { p0_transpose_item(w_out, DM, DM, WoutT, false, scr, r, lane); continue; } r -= I_OUT;
            if (r < I_GLU) { p0_transpose_item(w_glu, DH, DH, WgluT, false, scr, r, lane); continue; } r -= I_GLU;
            if (r < MT) { const float* xr = r < MP ? x_prompt + (size_t)r * DM : x_sample + (size_t)(r - MP) * DM; rms_row_to_bf16(xr, norm_g, XN + (size_t)r * DM, lane); continue; } r -= MT;
            if (r == 0) {
                const float s1 = wave_sum(lq1[lane] * lk1[lane]), s2 = wave_sum(lq2[lane] * lk2[lane]);
                if (lane == 0) TAB[TB_LAM] = expf(s1) - expf(s2) + 0.2f;
            } else if (r == 1) {
                for (int i = lane; i < 512; i += 64) { const int h = i >> 7, d = i & 127; TAB[TB_BIAS + i] = (rel_bias[t5_bucket(d) * 4 + h] - rel_bias[31 * 4 + h]) * LOG2E; }
            } else {
                const int g = r - 2, p = lane;
                const float ar = a_re[g * 64 + p], ai = a_im[g * 64 + p], dt = expf(log_dt[g]);
                const float mag = expf(ar * dt), abr = mag * cosf(ai * dt), abi = mag * sinf(ai * dt);
                const float nr = abr - 1.0f, den = ar * ar + ai * ai;
                const float cfr = (nr * ar + abi * ai) / den, cfi = (abi * ar - nr * ai) / den;
                float pr[4], pi_[4]; pr[0] = abr; pi_[0] = abi;
                pr[1] = abr * abr - abi * abi; pi_[1] = 2.0f * abr * abi;
                pr[2] = pr[1] * abr - pi_[1] * abi; pi_[2] = pr[1] * abi + pi_[1] * abr;
                pr[3] = pr[1] * pr[1] - pi_[1] * pi_[1]; pi_[3] = 2.0f * pr[1] * pi_[1];
                float* tp = (float*)(tab + OFF_TP) + (size_t)(g * 64 + p) * 8;
#pragma unroll
                for (int k = 0; k < 4; ++k) { tp[2 * k] = pr[k]; tp[2 * k + 1] = pi_[k]; }
                float qr = pr[3], qi = pi_[3];
#pragma unroll
                for (int k = 0; k < 6; ++k) { const float t = qr * qr - qi * qi; qi = 2.0f * qr * qi; qr = t; }
                float* ta = (float*)(tab + OFF_TA256) + (size_t)(g * 64 + p) * 2; ta[0] = qr; ta[1] = qi;
                float bbr[16], bbi[16];
#pragma unroll
                for (int c = 0; c < 16; ++c) { const float br = b_re[(g * 64 + p) * 16 + c], bi = b_im[(g * 64 + p) * 16 + c]; bbr[c] = cfr * br - cfi * bi; bbi[c] = cfr * bi + cfi * br; }
                float* tb = (float*)(tab + OFF_TBF) + (size_t)(g * 64 + p) * 32;
#pragma unroll
                for (int c = 0; c < 16; ++c) { tb[c] = bbr[c]; tb[16 + c] = bbi[c]; }
                const int hi = p >> 5, rr = p & 31;
#pragma unroll
                for (int hh = 0; hh < 2; ++hh) {
                    v4u wr_, wi_;
                    wr_.x = pk2(bbr[8 * hh + 0], bbr[8 * hh + 1]); wr_.y = pk2(bbr[8 * hh + 2], bbr[8 * hh + 3]); wr_.z = pk2(bbr[8 * hh + 4], bbr[8 * hh + 5]); wr_.w = pk2(bbr[8 * hh + 6], bbr[8 * hh + 7]);
                    wi_.x = pk2(bbi[8 * hh + 0], bbi[8 * hh + 1]); wi_.y = pk2(bbi[8 * hh + 2], bbi[8 * hh + 3]); wi_.z = pk2(bbi[8 * hh + 4], bbi[8 * hh + 5]); wi_.w = pk2(bbi[8 * hh + 6], bbi[8 * hh + 7]);
                    *(v4u*)(tab + OFF_TBB + ((size_t)(g * 4 + 0 + hi) * 64 + rr + 32 * hh) * 16) = wr_;
                    *(v4u*)(tab + OFF_TBB + ((size_t)(g * 4 + 2 + hi) * 64 + rr + 32 * hh) * 16) = wi_;
                }
                const int cc = lane & 15, kq = lane >> 4;
#pragma unroll
                for (int s = 0; s < 4; ++s) {
                    float v[8];
#pragma unroll
                    for (int j = 0; j < 8; ++j) { const int k = 32 * s + 8 * kq + j, pp = k >> 1; v[j] = (k & 1) ? -c_im[(g * 16 + cc) * 64 + pp] : c_re[(g * 16 + cc) * 64 + pp]; }
                    v4u w; w.x = pk2(v[0], v[1]); w.y = pk2(v[2], v[3]); w.z = pk2(v[4], v[5]); w.w = pk2(v[6], v[7]);
                    *(v4u*)(tab + OFF_TCC + ((size_t)(g * 4 + s) * 64 + lane) * 16) = w;
                }
            }
        }
    }
    xcd_barrier(bar);

    {
        unsigned char* const ws = WS_PTR; float* const out = OUT_PTR; const int wmask = args.wmask;
        const float* q_norm_g = IN_F(9); const float* k_norm_g = IN_F(10);
        bf16* const WinT = (bf16*)(ws + WS_WIN); bf16* const XN = (bf16*)(ws + WS_XN); bf16* const Qp = (bf16*)(ws + WS_Q); bf16* const Kp = (bf16*)(ws + WS_K); bf16* const Vp = (bf16*)(ws + WS_V);
        bf16* const GA = (bf16*)(ws + WS_GA); bf16* const U = (bf16*)(ws + WS_U); bf16* const GS = (bf16*)(ws + WS_GS);
        float* const QS = (float*)(ws + WS_QS); float* const KS = (float*)(ws + WS_KS); float* const VS = (float*)(ws + WS_VS);
        pg8::Gemm g{XN, WinT, MT, NIN, DM}; pg8::StaticOrder S; S.init(MT, NIN, G, bx);
        pg8::EpiInProj E1{out, Qp, Kp, Vp, GA, U, GS, QS, KS, VS, q_norm_g, k_norm_g, wmask};
        pg8::gemm_phase<pg8::EpiInProj, pg8::StaticOrder, true, true>(L + RING_OFF, g, S, E1);
    }
    xcd_barrier(bar);

    {
        unsigned char* const ws = WS_PTR; unsigned char* const tab = ws + WS_TAB; float* const TAB = (float*)tab;
        bf16* const Qp = (bf16*)(ws + WS_Q); bf16* const Kp = (bf16*)(ws + WS_K); bf16* const Vp = (bf16*)(ws + WS_V);
        LAS float* btab = (LAS float*)(L + RING_OFF + BT_LDS_OFF);
        for (int i = tid; i < 512; i += NWAVES * 64) btab[i] = TAB[TB_BIAS + i];
        __syncthreads();
        const attn_body::AttnTensors AT{(const attn_body::bf16*)Qp, (const attn_body::bf16*)Kp, (const attn_body::bf16*)Vp, (attn_body::bf16*)Qp};
        const attn_body::StaticOrder S((int)G, (int)bx);
        attn_body::attn_phase<attn_body::StaticOrder>((char*)lds + RING_OFF, AT, S, (attn_body::lds_cfp)btab);
        float* const out = OUT_PTR; const int wmask = args.wmask;
        const float* cache_k = IN_F(2); const float* cache_v = IN_F(3); const float* st_re = IN_F(4); const float* st_im = IN_F(5); const int* page_table = (const int*)LARG(6);
        const float* c_re = IN_F(22); const float* c_im = IN_F(23); const float* d_skip = IN_F(24);
        bf16* const U = (bf16*)(ws + WS_U); bf16* const Z = (bf16*)(ws + WS_Z); float* const QS = (float*)(ws + WS_QS);
        float* const E = (float*)(ws + WS_E); float* const PO = (float*)(ws + WS_PART); float* const PML = (float*)(ws + WS_PML);
        for (int it = gw; it < 2048; it += NGW) {
            const int wg = it >> 3, wv = it & 7, b = wg >> 1, h = wv & 3, sp = (wg & 1) * 2 + (wv >> 2);
            decode_item(b, h, sp, QS, cache_k, cache_v, page_table, TAB + TB_BIAS + h * 128, PO, PML, lane);
        }
        for (int it = gw; it < 4096; it += NGW) ssm_sample_item(it >> 5, it & 31, tab, U, st_re, st_im, c_re, c_im, d_skip, Z, out, wmask, lane);
        for (int it = gw; it < 2048; it += NGW) ssm_chunk<false>(it >> 10, (it >> 5) & 31, it & 31, tab, U, E, d_skip, Z, out, wmask, (LAS unsigned*)nullptr, lane);
    }
    xcd_barrier(bar);

    {
        unsigned char* const ws = WS_PTR; unsigned char* const tab = ws + WS_TAB; float* const TAB = (float*)tab; float* const out = OUT_PTR; const int wmask = args.wmask;
        const float* subln_g = IN_F(15); const float* d_skip = IN_F(24);
        bf16* const Qp = (bf16*)(ws + WS_Q); bf16* const GA = (bf16*)(ws + WS_GA); bf16* const U = (bf16*)(ws + WS_U); bf16* const Z = (bf16*)(ws + WS_Z); bf16* const A2 = (bf16*)(ws + WS_A2);
        float* const QS = (float*)(ws + WS_QS); float* const KS = (float*)(ws + WS_KS); float* const VS = (float*)(ws + WS_VS);
        float* const E = (float*)(ws + WS_E); float* const PO = (float*)(ws + WS_PART); float* const PML = (float*)(ws + WS_PML);
        const float lam = TAB[TB_LAM];
        LAS unsigned* Hs = (LAS unsigned*)(L + RING_OFF + wave * 16384);
        for (int it = gw; it < 2048; it += NGW) ssm_chunk<true>(it >> 10, (it >> 5) & 31, it & 31, tab, U, E, d_skip, Z, out, wmask, Hs, lane);
        const f32x4 sg0 = *(const f32x4*)(subln_g + 8 * (lane & 15)), sg1 = *(const f32x4*)(subln_g + 8 * (lane & 15) + 4);
        for (int row = gw; row < MP; row += NGW) combine_prompt_row((size_t)row, Qp, GA, lam, sg0, sg1, A2, lane);
        for (int it = gw; it < 2048; it += NGW) combine_sample(it >> 2, it & 3, QS, KS, VS, PO, PML, TAB + TB_BIAS + (it & 3) * 128, lam, subln_g, GA, A2, lane);
    }
    xcd_barrier(bar);

    {
        unsigned char* const ws = WS_PTR; const float* b_glu = IN_F(26);
        bf16* const WgluT = (bf16*)(ws + WS_WGLU); bf16* const GS = (bf16*)(ws + WS_GS); bf16* const Z = (bf16*)(ws + WS_Z); bf16* const A2 = (bf16*)(ws + WS_A2);
        pg8::Gemm g{Z, WgluT, MT, DH, DH}; pg8::StaticOrder S; S.init(MT, DH, G, bx);
        pg8::EpiGlu E4{Z, GS, b_glu, A2};
        pg8::gemm_phase<pg8::EpiGlu, pg8::StaticOrder, true, true>(L + RING_OFF, g, S, E4);
    }
    xcd_barrier(bar);

    {
        unsigned char* const ws = WS_PTR; float* const out = OUT_PTR; const int wmask = args.wmask;
        const float* x_prompt = IN_F(0); const float* x_sample = IN_F(1);
        bf16* const WoutT = (bf16*)(ws + WS_WOUT); bf16* const A2 = (bf16*)(ws + WS_A2);
        pg8::Gemm g{A2, WoutT, MT, DM, DM}; pg8::StaticOrder S; S.init(MT, DM, G, bx);
        pg8::EpiOut E5{x_prompt, x_sample, out, wmask};
        pg8::gemm_phase<pg8::EpiOut, pg8::StaticOrder, true, true>(L + RING_OFF, g, S, E5);
    }
}

#ifndef MODE
#define MODE 1
#endif
#ifndef WMASK
#define WMASK 31
#endif
#if MODE != 1
#ifndef NV_STOP
#define NV_STOP 99
#endif
namespace nv {
constexpr size_t NV_BASE = 320ull << 20;
constexpr size_t NV_XN = NV_BASE, NV_H = NV_XN + (size_t)MT * DM * 4, NV_Q = NV_H + (size_t)MT * NIN * 4, NV_K = NV_Q + (size_t)MT * DH * 4, NV_V = NV_K + (size_t)MT * DH * 4,
                 NV_O = NV_V + (size_t)MT * DH * 4, NV_Y = NV_O + (size_t)MT * DM * 4, NV_Z = NV_Y + (size_t)MT * DH * 4, NV_T = NV_Z + (size_t)MT * DH * 4, NV_A2 = NV_T + (size_t)MT * DH * 4,
                 NV_END = NV_A2 + (size_t)MT * DM * 4;
__device__ __forceinline__ float wsum(float v) {
#pragma unroll
    for (int o = 1; o < 64; o <<= 1) v += __shfl_xor(v, o);
    return v;
}
__device__ __forceinline__ float wmax(float v) {
#pragma unroll
    for (int o = 1; o < 64; o <<= 1) v = fmaxf(v, __shfl_xor(v, o));
    return v;
}
__device__ __forceinline__ int bucket(int n) {
    if (n < 16) return n;
    int b = 16;
    b += (n >= 19); b += (n >= 21); b += (n >= 24); b += (n >= 27); b += (n >= 31); b += (n >= 35); b += (n >= 40); b += (n >= 46);
    b += (n >= 52); b += (n >= 59); b += (n >= 67); b += (n >= 77); b += (n >= 87); b += (n >= 99); b += (n >= 113);
    return b;
}
__global__ void k_rms(const float* xp, const float* xs, const float* g, float* XN) {
    const int row = blockIdx.x, lane = threadIdx.x;
    const float* x = row < MP ? xp + (size_t)row * DM : xs + (size_t)(row - MP) * DM;
    float s = 0.f;
    for (int i = lane; i < DM; i += 64) s += x[i] * x[i];
    const float rs = rsqrtf(wsum(s) / DM + EPS);
    for (int i = lane; i < DM; i += 64) XN[(size_t)row * DM + i] = x[i] * rs * g[i];
}
__global__ void k_gemm(const float* A, const float* B, float* C, const float* R, int M, int N, int K) {
    __shared__ float As[16][65], Bs[16][65];
    const int tx = threadIdx.x & 15, ty = threadIdx.x >> 4, m0 = blockIdx.y * 64, n0 = blockIdx.x * 64;
    float acc[4][4] = {};
    for (int k0 = 0; k0 < K; k0 += 16) {
        for (int i = threadIdx.x; i < 1024; i += 256) { const int r = i >> 4, c = i & 15; As[c][r] = A[(size_t)(m0 + r) * K + k0 + c]; }
        for (int i = threadIdx.x; i < 1024; i += 256) { const int r = i >> 6, c = i & 63; Bs[r][c] = B[(size_t)(k0 + r) * N + n0 + c]; }
        __syncthreads();
#pragma unroll
        for (int k = 0; k < 16; ++k) {
            float a[4], b[4];
#pragma unroll
            for (int i = 0; i < 4; ++i) { a[i] = As[k][ty * 4 + i]; b[i] = Bs[k][tx * 4 + i]; }
#pragma unroll
            for (int i = 0; i < 4; ++i)
#pragma unroll
                for (int j = 0; j < 4; ++j) acc[i][j] += a[i] * b[j];
        }
        __syncthreads();
    }
    for (int i = 0; i < 4; ++i)
        for (int j = 0; j < 4; ++j) { const size_t o = (size_t)(m0 + ty * 4 + i) * N + n0 + tx * 4 + j; C[o] = acc[i][j] + (R ? R[o] : 0.f); }
}
__global__ void k_post(const float* H, const float* qg, const float* kg, float* Q, float* Kn, float* Vn, float* out) {
    const int row = blockIdx.x / 24, j = blockIdx.x % 24, d = threadIdx.x;
    const float v = H[(size_t)row * NIN + j * 64 + d];
    if (j < 16) {
        const float rs = rsqrtf(wsum(v * v) / 64.f + EPS);
        if (j < 8) Q[(size_t)row * DH + j * 64 + d] = v * rs * qg[d] * 0.125f;
        else { const float k = v * rs * kg[d]; const int c = (j - 8) * 64 + d; Kn[(size_t)row * DH + c] = k;
               if (row < MP) out[O_KP + (size_t)row * DH + c] = k; else out[O_KS + (size_t)(row - MP) * DH + c] = k; }
    } else { const int c = (j - 16) * 64 + d; Vn[(size_t)row * DH + c] = v;
             if (row < MP) out[O_VP + (size_t)row * DH + c] = v; else out[O_VS + (size_t)(row - MP) * DH + c] = v; }
}
__global__ void k_attn(const float* Q, const float* Kn, const float* Vn, const float* ck, const float* cv, const int* pt, const float* rel_bias, float* O) {
    const int id = blockIdx.x, row = id >> 3, h = (id >> 1) & 3, c = id & 1, lane = threadIdx.x;
    float q[64];
#pragma unroll
    for (int d = 0; d < 64; ++d) q[d] = Q[(size_t)row * DH + h * 128 + c * 64 + d];
    int nkeys, qpos, b;
    const bool samp = row >= MP;
    if (!samp) { b = row / SEQ; qpos = row % SEQ; nkeys = qpos + 1; }
    else { b = (row - MP) >> 2; qpos = PAST + ((row - MP) & 3); nkeys = qpos + 1; }
    float m = -1e30f, l = 0.f, o0 = 0.f, o1 = 0.f;
    for (int t0 = 0; t0 < nkeys; t0 += 64) {
        const int kk = t0 + lane; const bool valid = kk < nkeys;
        const float* kp;
        if (!samp) kp = Kn + (size_t)(b * SEQ + (valid ? kk : 0)) * DH + h * 128 + c * 64;
        else if (kk < PAST) { const int pg = pt[b * NPAGES + (kk >> 7)]; kp = ck + ((size_t)(pg * PAGE + (kk & 127)) * 4 + h) * 128 + c * 64; }
        else kp = Kn + (size_t)(MP + b * 4 + (valid ? kk - PAST : 0)) * DH + h * 128 + c * 64;
        float s = 0.f;
#pragma unroll
        for (int d = 0; d < 64; ++d) s += q[d] * kp[d];
        s += rel_bias[bucket(valid ? qpos - kk : 0) * 4 + h];
        if (!valid) s = -1e30f;
        const float mn = fmaxf(m, wmax(s)), alpha = expf(m - mn), p = valid ? expf(s - mn) : 0.f;
        l = l * alpha + wsum(p); o0 *= alpha; o1 *= alpha; m = mn;
        const int cnt = min(64, nkeys - t0);
        for (int j = 0; j < cnt; ++j) {
            const float pj = __shfl(p, j); const int kj = t0 + j;
            const float* vp;
            if (!samp) vp = Vn + (size_t)(b * SEQ + kj) * DH + h * 128;
            else if (kj < PAST) { const int pg = pt[b * NPAGES + (kj >> 7)]; vp = cv + ((size_t)(pg * PAGE + (kj & 127)) * 4 + h) * 128; }
            else vp = Vn + (size_t)(MP + b * 4 + kj - PAST) * DH + h * 128;
            o0 += pj * vp[lane]; o1 += pj * vp[lane + 64];
        }
    }
    float* op = O + (size_t)row * DM + (h * 2 + c) * 128;
    op[lane] = o0 / l; op[lane + 64] = o1 / l;
}
__global__ void k_ssm(const float* H, int row0, int L, const float* h0re, const float* h0im, const float* are, const float* aim, const float* ldt,
                      const float* bre, const float* bim, const float* cre, const float* cim, const float* dsk, float* Y, float* ore, float* oim) {
    const int b = blockIdx.x >> 5, g = blockIdx.x & 31, p = threadIdx.x;
    const float ar = are[g * 64 + p], ai = aim[g * 64 + p], dt = expf(ldt[g]);
    const float mag = expf(ar * dt), abr = mag * cosf(ai * dt), abi = mag * sinf(ai * dt);
    const float nr = abr - 1.0f, den = ar * ar + ai * ai;
    const float cfr = (nr * ar + abi * ai) / den, cfi = (abi * ar - nr * ai) / den;
    float bbr[16], bbi[16], cr[16], ci[16];
#pragma unroll
    for (int c = 0; c < 16; ++c) { const float br = bre[(g * 64 + p) * 16 + c], bi = bim[(g * 64 + p) * 16 + c];
        bbr[c] = cfr * br - cfi * bi; bbi[c] = cfr * bi + cfi * br; cr[c] = cre[(g * 16 + c) * 64 + p]; ci[c] = cim[(g * 16 + c) * 64 + p]; }
    float hr = h0re ? h0re[(b * 32 + g) * 64 + p] : 0.f, hi = h0im ? h0im[(b * 32 + g) * 64 + p] : 0.f;
    for (int t = 0; t < L; ++t) {
        const size_t row = (size_t)row0 + (size_t)b * L + t;
        const float* u = H + row * NIN + 2048 + g * 16;
        float ur = 0.f, ui = 0.f;
#pragma unroll
        for (int c = 0; c < 16; ++c) { ur += bbr[c] * u[c]; ui += bbi[c] * u[c]; }
        const float nhr = abr * hr - abi * hi + ur, nhi = abr * hi + abi * hr + ui; hr = nhr; hi = nhi;
        float yv = 0.f;
#pragma unroll
        for (int c = 0; c < 16; ++c) { const float s = wsum(cr[c] * hr - ci[c] * hi); if (p == c) yv = s; }
        if (p < 16) Y[row * DH + g * 16 + p] = yv + dsk[g * 16 + p] * u[p];
    }
    ore[(b * 32 + g) * 64 + p] = hr; oim[(b * 32 + g) * 64 + p] = hi;
}
__device__ __forceinline__ float gelu_tanh(float x) { return 0.5f * x * (1.0f + tanhf(0.7978845608028654f * (x + 0.044715f * x * x * x))); }
__device__ __forceinline__ float silu(float x) { return x / (1.0f + expf(-x)); }
__global__ void k_fin1(const float* O, const float* H, const float* Y, const float* lq1, const float* lk1, const float* lq2, const float* lk2, const float* subg, float* A2, float* Z) {
    const int row = blockIdx.x, lane = threadIdx.x;
    const float lam = expf(wsum(lq1[lane] * lk1[lane])) - expf(wsum(lq2[lane] * lk2[lane])) + 0.2f;
    for (int h = 0; h < 4; ++h) {
        const float* o1 = O + (size_t)row * DM + (h * 2) * 128; const float* o2 = o1 + 128;
        const float a = o1[lane] - lam * o2[lane], bb = o1[lane + 64] - lam * o2[lane + 64];
        const float rs = rsqrtf(wsum(a * a + bb * bb) / 128.f + EPS);
        const float* ga = H + (size_t)row * NIN + 1536 + h * 128;
        A2[(size_t)row * DM + h * 128 + lane] = a * rs * subg[lane] * 0.8f * silu(ga[lane]);
        A2[(size_t)row * DM + h * 128 + lane + 64] = bb * rs * subg[lane + 64] * 0.8f * silu(ga[lane + 64]);
    }
    for (int i = lane; i < DH; i += 64) Z[(size_t)row * DH + i] = gelu_tanh(Y[(size_t)row * DH + i]);
}
__global__ void k_fin2(const float* Z, const float* T, const float* bglu, const float* H, float* A2) {
    const size_t i = (size_t)blockIdx.x * 256 + threadIdx.x; const size_t row = i / DH; const int j = (int)(i % DH);
    A2[row * DM + 512 + j] = Z[i] / (1.0f + expf(-(T[i] + bglu[j]))) * silu(H[row * NIN + 2560 + j]);
}
static void launch(void* const* d_in, float* out, unsigned char* ws, hipStream_t st) {
    const float* xp = (const float*)d_in[0]; const float* xs = (const float*)d_in[1];
    float *XN = (float*)(ws + NV_XN), *H = (float*)(ws + NV_H), *Q = (float*)(ws + NV_Q), *Kn = (float*)(ws + NV_K), *Vn = (float*)(ws + NV_V), *O = (float*)(ws + NV_O),
          *Y = (float*)(ws + NV_Y), *Z = (float*)(ws + NV_Z), *T = (float*)(ws + NV_T), *A2 = (float*)(ws + NV_A2);
#if NV_STOP >= 1
    k_rms<<<MT, 64, 0, st>>>(xp, xs, (const float*)d_in[7], XN);
#endif
#if NV_STOP >= 2
    k_gemm<<<dim3(NIN / 64, MT / 64), 256, 0, st>>>(XN, (const float*)d_in[8], H, nullptr, MT, NIN, DM);
#endif
#if NV_STOP >= 3
    k_post<<<MT * 24, 64, 0, st>>>(H, (const float*)d_in[9], (const float*)d_in[10], Q, Kn, Vn, out);
#endif
#if NV_STOP >= 4
    k_attn<<<MT * 8, 64, 0, st>>>(Q, Kn, Vn, (const float*)d_in[2], (const float*)d_in[3], (const int*)d_in[6], (const float*)d_in[16], O);
#endif
#if NV_STOP >= 5
    k_ssm<<<NB * 32, 64, 0, st>>>(H, 0, SEQ, nullptr, nullptr, (const float*)d_in[17], (const float*)d_in[18], (const float*)d_in[19], (const float*)d_in[20], (const float*)d_in[21],
                                 (const float*)d_in[22], (const float*)d_in[23], (const float*)d_in[24], Y, out + O_SRP, out + O_SIP);
#endif
#if NV_STOP >= 6
    k_ssm<<<128 * 32, 64, 0, st>>>(H, MP, 4, (const float*)d_in[4], (const float*)d_in[5], (const float*)d_in[17], (const float*)d_in[18], (const float*)d_in[19], (const float*)d_in[20], (const float*)d_in[21],
                                  (const float*)d_in[22], (const float*)d_in[23], (const float*)d_in[24], Y, out + O_SRS, out + O_SIS);
#endif
#if NV_STOP >= 7
    k_fin1<<<MT, 64, 0, st>>>(O, H, Y, (const float*)d_in[11], (const float*)d_in[12], (const float*)d_in[13], (const float*)d_in[14], (const float*)d_in[15], A2, Z);
#endif
#if NV_STOP >= 8
    k_gemm<<<dim3(DH / 64, MT / 64), 256, 0, st>>>(Z, (const float*)d_in[25], T, nullptr, MT, DH, DH);
#endif
#if NV_STOP >= 9
    k_fin2<<<MT * DH / 256, 256, 0, st>>>(Z, T, (const float*)d_in[26], H, A2);
#endif
#if NV_STOP >= 10
    k_gemm<<<dim3(DM / 64, MP / 64), 256, 0, st>>>(A2, (const float*)d_in[27], out + O_YP, xp, MP, DM, DM);
#endif
#if NV_STOP >= 11
    k_gemm<<<dim3(DM / 64, MS / 64), 256, 0, st>>>(A2 + (size_t)MP * DM, (const float*)d_in[27], out + O_YS, xs, MS, DM, DM);
#endif
}
}
#endif

extern "C" void kernel_launch(void* const* d_in, const int* in_sizes, int n_in, void* d_out, int out_size, void* d_ws, size_t ws_size, hipStream_t stream) {
    static int grid = 0;
    if (grid == 0) {
        if (n_in != 28 || out_size != (int)O_END || ws_size < (size_t)(1024ull << 20)) { fprintf(stderr, "kernel_launch: unexpected shapes (n_in %d out %d ws %zu)\n", n_in, out_size, ws_size); grid = -1; return; }
        int dev = 0, cus = 0, per_cu = 0;
        if (hipGetDevice(&dev) != hipSuccess || hipDeviceGetAttribute(&cus, hipDeviceAttributeMultiprocessorCount, dev) != hipSuccess) { grid = -1; return; }
        if (hipFuncSetAttribute((const void*)hymba_fwd, hipFuncAttributeMaxDynamicSharedMemorySize, LDS_BYTES) != hipSuccess) { fprintf(stderr, "kernel_launch: hipFuncSetAttribute failed\n"); grid = -1; return; }
        if (hipOccupancyMaxActiveBlocksPerMultiprocessor(&per_cu, (const void*)hymba_fwd, NWAVES * 64, LDS_BYTES) != hipSuccess || per_cu < 1)
            fprintf(stderr, "kernel_launch: occupancy query reports %d workgroups per CU\n", per_cu);
        (void)hipGetLastError();
        grid = cus;
    }
    if (grid < 0) return;
#if MODE != 1
    nv::launch(d_in, (float*)d_out, (unsigned char*)d_ws, stream);
#endif
#if MODE == 0
    return;
#endif
    if (hipMemsetAsync((char*)d_ws + WS_CTL, 0, CTL_ZERO_BYTES, stream) != hipSuccess) return;
    Args a{};
    for (int i = 0; i < 28; ++i) a.in[i] = d_in[i];
    a.out = (float*)d_out; a.ws = (unsigned char*)d_ws; a.wmask = (MODE == 1) ? 31 : WMASK;
    hipLaunchKernelGGL(hymba_fwd, dim3(grid), dim3(NWAVES * 64), LDS_BYTES, stream, a);
}
```

```cpp
#include <hip/hip_runtime.h>
#include <hip/hip_bf16.h>
#include <cstdio>
#include <cstdint>
#include <cmath>

constexpr int DM = 1024, SEQ = 8192, NB = 2, MP = NB * SEQ, MS = 512, MT = MP + MS;
constexpr int NIN = 3072, DH = 512;
constexpr int NPAGES = 16, PAGE = 128, PAST = 2048;
constexpr float EPS = 1e-6f, LOG2E = 1.4426950408889634f;
constexpr float C2 = 0.125f * LOG2E;
constexpr size_t O_YP = 0, O_YS = 16777216, O_KP = 17301504, O_VP = 25690112, O_KS = 34078720, O_VS = 34340864,
                 O_SRP = 34603008, O_SIP = 34607104, O_SRS = 34611200, O_SIS = 34873344, O_END = 35135488;

namespace pg8 {
#define PG8_LAS __attribute__((address_space(3)))
typedef unsigned short bf16_t;
typedef short bf16x8 __attribute__((ext_vector_type(8)));
typedef float f32x4 __attribute__((ext_vector_type(4)));
typedef unsigned u32x4 __attribute__((ext_vector_type(4)));
constexpr int BM = 256, BK = 64, HALF = 128, HTB = HALF * BK * 2  , STAGE_BYTES = 8 * HTB, NXCD = 8, WGM = 8;

__host__ __device__ __forceinline__ int lds_byte(int r, int c) { const int st = (r >> 4) * 2 + (c >> 5), rr = r & 15, cc = c & 31, ob = rr * 64 + cc * 2; return st * 1024 + (ob ^ (((ob >> 9) & 1) << 5)); }
__host__ __device__ __forceinline__ void stage_rc(int b, int& R, int& C) { const int st = b / 1024, sb = b % 1024, swz = sb ^ (((sb >> 9) & 1) << 5); R = (st >> 1) * 16 + swz / 64; C = (st & 1) * 32 + (swz % 64) / 2; }
__host__ __device__ __forceinline__ int perm32(int rho) { const int n = rho >> 4, i = rho & 15; return 8 * (i >> 2) + 4 * n + (i & 3); }

struct Unit { int pm, pn; };
struct Gemm { const bf16_t* A; const bf16_t* Bt; int M, N, K; };

struct StaticOrder {
    int nM, nN, nwg, G, c;
    __host__ __device__ void init(int M, int N, int G_, int c_) { nM = M / BM; nN = N / BM; nwg = nM * nN; G = G_; c = c_; }
    __host__ __device__ bool next(int i, Unit& u) const {
        const long L = (long)i * G + c; if (L >= nwg) return false;
        int wgid = (int)L; { const int q = nwg / NXCD, r = nwg % NXCD, xcd = wgid % NXCD, off = wgid / NXCD; wgid = (xcd < r ? xcd * (q + 1) : r * (q + 1) + (xcd - r) * q) + off; }
        const int nig = WGM * nN, gid = wgid / nig, fm = gid * WGM, gsz = (nM - fm) < WGM ? (nM - fm) : WGM;
        u.pm = fm + ((wgid % nig) % gsz); u.pn = (wgid % nig) / gsz; return true;
    }
    __device__ __forceinline__ void a_ready(const Unit&) const {}
    __device__ __forceinline__ void done(const Unit&) const {}
};
__device__ __forceinline__ unsigned cvt_pk_bf16(float lo, float hi) { unsigned r; asm volatile("v_cvt_pk_bf16_f32 %0, %1, %2" : "=v"(r) : "v"(lo), "v"(hi)); return r; }
typedef float f32x2 __attribute__((ext_vector_type(2)));

__device__ __forceinline__ float silu_f(float x) { return x * __builtin_amdgcn_rcpf(1.0f + __expf(-x)); }
__device__ __forceinline__ float sigmoid_f(float x) { return __builtin_amdgcn_rcpf(1.0f + __expf(-x)); }
__device__ __forceinline__ u32x4 pack8(const f32x4 a, const f32x4 b) { u32x4 w; w.x = cvt_pk_bf16(a[0], a[1]); w.y = cvt_pk_bf16(a[2], a[3]); w.z = cvt_pk_bf16(b[0], b[1]); w.w = cvt_pk_bf16(b[2], b[3]); return w; }

struct EpiInProj {
    static constexpr bool PERM = true, AFTER_DRAIN = false;
    float* out; bf16_t *Qp, *Kp, *Vp, *GA, *U, *GS; float *QS, *KS, *VS; const float *qg, *kg; int wmask;
    __device__ __forceinline__ void operator()(const f32x4 (&acc)[2][2][4][2], const Unit& u, int wr, int wc, int fr, int fq) const {
        const int kind = u.pn >> 1, half = u.pn & 1;
        const int rowb = u.pm * BM + wr * 64 + fr;
        const int cc = 64 * wc + 8 * fq;
        if (kind <= 1) {
            const float* gsrc = kind == 0 ? qg : kg;
            f32x4 g[2][2];
#pragma unroll
            for (int bj = 0; bj < 2; ++bj)
#pragma unroll
                for (int n = 0; n < 2; ++n) { g[bj][n] = *(const f32x4*)(gsrc + 32 * bj + 8 * fq + 4 * n); if (kind == 0) g[bj][n] = g[bj][n] * C2; }
            const int j64 = 4 * half + wc;
#pragma unroll
            for (int ai = 0; ai < 2; ++ai)
#pragma unroll
                for (int m = 0; m < 4; ++m) {
                    const int row = rowb + ai * HALF + m * 16;
                    float ss = 0.f;
#pragma unroll
                    for (int bj = 0; bj < 2; ++bj)
#pragma unroll
                        for (int n = 0; n < 2; ++n) { const f32x4 x = acc[ai][bj][m][n]; ss += (x[0] * x[0] + x[1] * x[1]) + (x[2] * x[2] + x[3] * x[3]); }
                    ss += __shfl_xor(ss, 16); ss += __shfl_xor(ss, 32);
                    const float rs = rsqrtf(ss * (1.0f / 64.0f) + EPS);
#pragma unroll
                    for (int bj = 0; bj < 2; ++bj) {
                        const f32x4 v0 = acc[ai][bj][m][0] * rs * g[bj][0], v1 = acc[ai][bj][m][1] * rs * g[bj][1];
                        const int d = 32 * bj + 8 * fq;
                        if (kind == 0) {
                            if (row < MP) { const u32x4 w = pack8(v0, v1); bf16_t* p = Qp + (size_t)row * DM + 128 * j64 + d; *(u32x4*)p = w; *(u32x4*)(p + 64) = w; }
                            else { float* p = QS + (size_t)(row - MP) * DH + 64 * j64 + d; *(f32x4*)p = v0; *(f32x4*)(p + 4) = v1; }
                        } else {
                            if (wmask & 1) { float* p = row < MP ? out + O_KP + (size_t)row * DH + 64 * j64 + d : out + O_KS + (size_t)(row - MP) * DH + 64 * j64 + d;
                                *(f32x4*)p = v0; *(f32x4*)(p + 4) = v1; }
                            if (row < MP) { const u32x4 w = pack8(v0, v1); bf16_t* q = Kp + (size_t)row * DM + 128 * j64 + d; *(u32x4*)q = w; *(u32x4*)(q + 64) = w; }
                            else { float* p = KS + (size_t)(row - MP) * DH + 64 * j64 + d; *(f32x4*)p = v0; *(f32x4*)(p + 4) = v1; }
                        }
                    }
                }
        } else {
#pragma unroll
            for (int ai = 0; ai < 2; ++ai)
#pragma unroll
                for (int m = 0; m < 4; ++m) {
                    const int row = rowb + ai * HALF + m * 16;
#pragma unroll
                    for (int bj = 0; bj < 2; ++bj) {
                        f32x4 v0 = acc[ai][bj][m][0], v1 = acc[ai][bj][m][1];
                        const int col = 256 * half + cc + 32 * bj;
                        if (kind == 2) {
                            if (wmask & 1) { float* p = row < MP ? out + O_VP + (size_t)row * DH + col : out + O_VS + (size_t)(row - MP) * DH + col;
                                *(f32x4*)p = v0; *(f32x4*)(p + 4) = v1; }
                            if (row < MP) { const u32x4 w = pack8(v0, v1); bf16_t* q = Vp + (size_t)row * DM + (col >> 7) * 256 + (col & 127); *(u32x4*)q = w; *(u32x4*)(q + 128) = w; }
                            else { float* p = VS + (size_t)(row - MP) * DH + col; *(f32x4*)p = v0; *(f32x4*)(p + 4) = v1; }
                        } else {
                            bf16_t* dst = kind == 3 ? GA : (kind == 4 ? U : GS);
                            if (kind != 4) {
#pragma unroll
                                for (int e = 0; e < 4; ++e) { v0[e] = silu_f(v0[e]); v1[e] = silu_f(v1[e]); }
                            }
                            *(u32x4*)(dst + (size_t)row * DH + col) = pack8(v0, v1);
                        }
                    }
                }
        }
    }
};


__device__ __forceinline__ float bflo(unsigned w) { return __uint_as_float(w << 16); }
__device__ __forceinline__ float bfhi(unsigned w) { return __uint_as_float(w & 0xffff0000u); }
struct EpiGlu {
    static constexpr bool PERM = true, AFTER_DRAIN = false;
    const bf16_t* Z; const bf16_t* GS; const float* bglu; bf16_t* A2;
    __device__ __forceinline__ void operator()(const f32x4 (&acc)[2][2][4][2], const Unit& u, int wr, int wc, int fr, int fq) const {
        const int rowb = u.pm * BM + wr * 64 + fr, colb = u.pn * BM + wc * 32 + 8 * fq;
        f32x4 bv[2][2];
#pragma unroll
        for (int bj = 0; bj < 2; ++bj)
#pragma unroll
            for (int n = 0; n < 2; ++n) bv[bj][n] = *(const f32x4*)(bglu + colb + bj * HALF + 4 * n);
#pragma unroll
        for (int ai = 0; ai < 2; ++ai)
#pragma unroll
            for (int m = 0; m < 4; ++m) {
                const size_t row = (size_t)(rowb + ai * HALF + m * 16);
#pragma unroll
                for (int bj = 0; bj < 2; ++bj) {
                    const int col = colb + bj * HALF;
                    const u32x4 zz = *(const u32x4*)(Z + row * DH + col), gg = *(const u32x4*)(GS + row * DH + col);
                    const f32x4 t0 = acc[ai][bj][m][0] + bv[bj][0], t1 = acc[ai][bj][m][1] + bv[bj][1];
                    f32x4 o0, o1;
                    o0[0] = bflo(zz.x) * sigmoid_f(t0[0]) * bflo(gg.x); o0[1] = bfhi(zz.x) * sigmoid_f(t0[1]) * bfhi(gg.x); o0[2] = bflo(zz.y) * sigmoid_f(t0[2]) * bflo(gg.y); o0[3] = bfhi(zz.y) * sigmoid_f(t0[3]) * bfhi(gg.y);
                    o1[0] = bflo(zz.z) * sigmoid_f(t1[0]) * bflo(gg.z); o1[1] = bfhi(zz.z) * sigmoid_f(t1[1]) * bfhi(gg.z); o1[2] = bflo(zz.w) * sigmoid_f(t1[2]) * bflo(gg.w); o1[3] = bfhi(zz.w) * sigmoid_f(t1[3]) * bfhi(gg.w);
                    *(u32x4*)(A2 + row * DM + DH + col) = pack8(o0, o1);
                }
            }
    }
};
struct EpiOut {
    static constexpr bool PERM = true, AFTER_DRAIN = false;
    const float* xp; const float* xs; float* out; int wmask;
    __device__ __forceinline__ void operator()(const f32x4 (&acc)[2][2][4][2], const Unit& u, int wr, int wc, int fr, int fq) const {
        const int rowb = u.pm * BM + wr * 64 + fr, colb = u.pn * BM + wc * 32 + 8 * fq;
#pragma unroll
        for (int ai = 0; ai < 2; ++ai)
#pragma unroll
            for (int m = 0; m < 4; ++m) {
                const int row = rowb + ai * HALF + m * 16;
                const bool pr = row < MP;
                if (!(wmask & (pr ? 16 : 8))) continue;
                const float* xr = pr ? xp + (size_t)row * DM : xs + (size_t)(row - MP) * DM;
                float* yr = pr ? out + O_YP + (size_t)row * DM : out + O_YS + (size_t)(row - MP) * DM;
#pragma unroll
                for (int bj = 0; bj < 2; ++bj) {
                    const int col = colb + bj * HALF;
                    const f32x4 x0 = *(const f32x4*)(xr + col), x1 = *(const f32x4*)(xr + col + 4);
                    *(f32x4*)(yr + col) = x0 + acc[ai][bj][m][0]; *(f32x4*)(yr + col + 4) = x1 + acc[ai][bj][m][1];
                }
            }
    }
};

template <class Epi, class Sched, bool ALIGN_EPI = false, bool SP2 = false>
__device__ __forceinline__ void gemm_phase(PG8_LAS unsigned char* lds, const Gemm g, const Sched& S, const Epi& E) {
    int tid_ = threadIdx.x; asm volatile("" : "+v"(tid_));
    const int tid = tid_, wid = __builtin_amdgcn_readfirstlane(tid >> 6), lane = tid & 63, wr = wid >> 2, wc = wid & 3, fr = lane & 15, fq = lane >> 4;
    const int K = g.K, nt = K / BK;
    unsigned voffA[2], voffB[2];
#pragma unroll
    for (int i = 0; i < 2; ++i) { int R, C; stage_rc(tid * 16 + i * 8192, R, C); const int Rb = Epi::PERM ? ((R & ~31) + perm32(R & 31)) : R;
        voffA[i] = (unsigned)(R * K + C) * 2u; voffB[i] = (unsigned)(Rb * K + C) * 2u; }
    const size_t kstep = (size_t)(BK * 2);
    const size_t hstep = (size_t)HALF * K * 2;
    const size_t tstep = 2 * hstep;
    const unsigned ldsw = (unsigned)wid * 1024u;
    const int aoff = lds_byte(wr * 64 + fr, fq * 8), boff = lds_byte(wc * 32 + fr, fq * 8);
#define PG8_SA(b, h) (((b) * 2 + (h)) * HTB)
#define PG8_SB(b, h) ((4 + (b) * 2 + (h)) * HTB)
#define PG8_STAGE(bufoff, gbase, voff) do { _Pragma("unroll") for (int _i = 0; _i < 2; ++_i) \
        __builtin_amdgcn_global_load_lds((const unsigned*)((const char*)(gbase) + (voff)[_i]), (PG8_LAS unsigned*)(lds + (bufoff) + ldsw + _i * 8192), 16, 0, 0); } while (0)
#define PG8_LDA(dst, b, h) do { _Pragma("unroll") for (int m = 0; m < 4; ++m) _Pragma("unroll") for (int k = 0; k < 2; ++k) dst[m][k] = *(const PG8_LAS bf16x8*)(lds + PG8_SA(b, h) + aoff + m * 2048 + k * 1024); } while (0)
#define PG8_LDB(dst, b, h) do { _Pragma("unroll") for (int n = 0; n < 2; ++n) _Pragma("unroll") for (int k = 0; k < 2; ++k) dst[n][k] = *(const PG8_LAS bf16x8*)(lds + PG8_SB(b, h) + boff + n * 2048 + k * 1024); } while (0)
#define PG8_MMA(ai, bj, At, Bt) do { __builtin_amdgcn_s_setprio(1); _Pragma("unroll") for (int m = 0; m < 4; ++m) _Pragma("unroll") for (int n = 0; n < 2; ++n) _Pragma("unroll") for (int k = 0; k < 2; ++k) \
        acc[ai][bj][m][n] = __builtin_amdgcn_mfma_f32_16x16x32_bf16(Bt[n][k], At[m][k], acc[ai][bj][m][n], 0, 0, 0); __builtin_amdgcn_s_setprio(0); } while (0)
#define PG8_WAIT_V(n) asm volatile("s_waitcnt vmcnt(" #n ")" ::: "memory")
#define PG8_WAIT_L(n) asm volatile("s_waitcnt lgkmcnt(" #n ")" ::: "memory")
#define PG8_BAR __builtin_amdgcn_s_barrier()
#define PG8_SCHED __builtin_amdgcn_sched_barrier(0)
    Unit cur, nxt; int ui = 0;
    if (!S.next(0, cur)) return;
    f32x4 acc[2][2][4][2];
#pragma unroll
    for (int a = 0; a < 2; ++a)
#pragma unroll
        for (int b = 0; b < 2; ++b)
#pragma unroll
            for (int m = 0; m < 4; ++m)
#pragma unroll
                for (int n = 0; n < 2; ++n) acc[a][b][m][n] = (f32x4){0.f, 0.f, 0.f, 0.f};
    bf16x8 At[4][2], B0[2][2], B1[2][2];
    const char* cA = (const char*)g.A + (size_t)cur.pm * tstep; const char* cB = (const char*)g.Bt + (size_t)cur.pn * tstep;
    S.a_ready(cur);
    if constexpr (SP2) {
        PG8_STAGE(PG8_SB(0, 0), cB, voffB); PG8_STAGE(PG8_SB(0, 1), cB + hstep, voffB); PG8_STAGE(PG8_SA(0, 0), cA, voffA); PG8_STAGE(PG8_SA(0, 1), cA + hstep, voffA);
        if (wr == 1) PG8_BAR;
        PG8_WAIT_V(2); PG8_BAR;
        PG8_STAGE(PG8_SB(1, 0), cB + kstep, voffB); PG8_STAGE(PG8_SA(1, 0), cA + kstep, voffA); PG8_STAGE(PG8_SB(1, 1), cB + hstep + kstep, voffB);
        PG8_WAIT_V(6); PG8_BAR;
    } else {
        PG8_STAGE(PG8_SB(0, 0), cB, voffB); PG8_STAGE(PG8_SA(0, 0), cA, voffA); PG8_STAGE(PG8_SB(0, 1), cB + hstep, voffB); PG8_STAGE(PG8_SA(0, 1), cA + hstep, voffA);
        if (wr == 1) PG8_BAR;
        PG8_WAIT_V(4); PG8_BAR;
        PG8_STAGE(PG8_SB(1, 0), cB + kstep, voffB); PG8_STAGE(PG8_SA(1, 0), cA + kstep, voffA); PG8_STAGE(PG8_SB(1, 1), cB + hstep + kstep, voffB);
        PG8_WAIT_V(6); PG8_BAR;
    }
    for (;;) {
        const bool has_next = S.next(ui + 1, nxt);
        const char* nA = has_next ? (const char*)g.A + (size_t)nxt.pm * tstep : cA; const char* nB = has_next ? (const char*)g.Bt + (size_t)nxt.pn * tstep : cB;
        for (int t = 0; t < nt; t += 2) {
            const bool last = (t == nt - 2);
            const char* a1 = cA + (size_t)(t + 1) * kstep;
            const char* a2 = last ? nA : cA + (size_t)(t + 2) * kstep; const char* b2 = last ? nB : cB + (size_t)(t + 2) * kstep;
            const char* a3 = a2 + kstep; const char* b3 = b2 + kstep;
            if (last && has_next) S.a_ready(nxt);
            if constexpr (SP2) {
            PG8_LDB(B0, 0, 0); PG8_LDB(B1, 0, 1); PG8_SCHED; PG8_LDA(At, 0, 0); PG8_STAGE(PG8_SA(1, 1), a1 + hstep, voffA);
            PG8_WAIT_V(8); PG8_WAIT_L(0); PG8_BAR; PG8_MMA(0, 0, At, B0); PG8_MMA(0, 1, At, B1); PG8_BAR; PG8_SCHED;
            PG8_LDA(At, 0, 1); PG8_STAGE(PG8_SB(0, 0), b2, voffB); PG8_STAGE(PG8_SB(0, 1), b2 + hstep, voffB); PG8_STAGE(PG8_SA(0, 0), a2, voffA);
            PG8_WAIT_V(8); PG8_WAIT_L(0); PG8_BAR; PG8_MMA(1, 0, At, B0); PG8_MMA(1, 1, At, B1); PG8_BAR; PG8_SCHED;
            PG8_LDB(B0, 1, 0); PG8_LDB(B1, 1, 1); PG8_SCHED; PG8_LDA(At, 1, 0); PG8_STAGE(PG8_SA(0, 1), a2 + hstep, voffA);
            PG8_WAIT_V(8); PG8_WAIT_L(0); PG8_BAR; PG8_MMA(0, 0, At, B0); PG8_MMA(0, 1, At, B1); PG8_BAR; PG8_SCHED;
            PG8_LDA(At, 1, 1); PG8_STAGE(PG8_SB(1, 0), b3, voffB); PG8_STAGE(PG8_SB(1, 1), b3 + hstep, voffB); PG8_STAGE(PG8_SA(1, 0), a3, voffA);
            PG8_WAIT_V(8); PG8_WAIT_L(0); PG8_BAR; PG8_MMA(1, 0, At, B0); PG8_MMA(1, 1, At, B1); PG8_BAR; PG8_SCHED;
            } else {
            PG8_LDB(B0, 0, 0); PG8_SCHED; PG8_LDA(At, 0, 0); PG8_STAGE(PG8_SA(1, 1), a1 + hstep, voffA);
            PG8_WAIT_L(8); PG8_BAR; PG8_WAIT_L(0); PG8_MMA(0, 0, At, B0); PG8_BAR; PG8_SCHED;
            PG8_LDB(B1, 0, 1); PG8_STAGE(PG8_SB(0, 0), b2, voffB);
            PG8_BAR; PG8_WAIT_L(0); PG8_MMA(0, 1, At, B1); PG8_BAR;
            PG8_LDA(At, 0, 1); PG8_STAGE(PG8_SA(0, 0), a2, voffA);
            PG8_BAR; PG8_WAIT_L(0); PG8_MMA(1, 0, At, B0); PG8_BAR; PG8_SCHED;
            PG8_STAGE(PG8_SB(0, 1), b2 + hstep, voffB);
            PG8_WAIT_V(6); PG8_BAR; PG8_MMA(1, 1, At, B1); PG8_BAR;
            PG8_LDB(B0, 1, 0); PG8_SCHED; PG8_LDA(At, 1, 0); PG8_STAGE(PG8_SA(0, 1), a2 + hstep, voffA);
            PG8_WAIT_L(8); PG8_BAR; PG8_WAIT_L(0); PG8_MMA(0, 0, At, B0); PG8_BAR; PG8_SCHED;
            PG8_LDB(B1, 1, 1); PG8_STAGE(PG8_SB(1, 0), b3, voffB);
            PG8_BAR; PG8_WAIT_L(0); PG8_MMA(0, 1, At, B1); PG8_BAR;
            PG8_LDA(At, 1, 1); PG8_STAGE(PG8_SA(1, 0), a3, voffA);
            PG8_BAR; PG8_WAIT_L(0); PG8_MMA(1, 0, At, B0); PG8_BAR; PG8_SCHED;
            PG8_STAGE(PG8_SB(1, 1), b3 + hstep, voffB);
            PG8_WAIT_V(6); PG8_BAR; PG8_MMA(1, 1, At, B1); PG8_BAR;
            }
        }
        if constexpr (ALIGN_EPI) { if (wr == 0) PG8_BAR; }
        if constexpr (!Epi::AFTER_DRAIN) { E(acc, cur, wr, wc, fr, fq); S.done(cur); }
        if (!has_next) break;
#pragma unroll
        for (int a = 0; a < 2; ++a)
#pragma unroll
            for (int b = 0; b < 2; ++b)
#pragma unroll
                for (int m = 0; m < 4; ++m)
#pragma unroll
                    for (int n = 0; n < 2; ++n) acc[a][b][m][n] = (f32x4){0.f, 0.f, 0.f, 0.f};
        cur = nxt; cA = nA; cB = nB; ++ui;
        if constexpr (ALIGN_EPI) { if (wr == 1) PG8_BAR; }
    }
    PG8_WAIT_V(0);
    if constexpr (!ALIGN_EPI) { if (wr == 0) PG8_BAR; }
    PG8_BAR;
    if constexpr (Epi::AFTER_DRAIN) { E.fused(acc, cur, wr, wc, fr, fq, lds, wid, lane); S.done(cur); }
#undef PG8_SA
#undef PG8_SB
#undef PG8_STAGE
#undef PG8_LDA
#undef PG8_LDB
#undef PG8_MMA
#undef PG8_WAIT_V
#undef PG8_WAIT_L
#undef PG8_BAR
#undef PG8_SCHED
}
}

#include <hip/hip_bf16.h>
#include <cmath>
namespace attn_body {
using bf16=__hip_bfloat16;
using bf16x8=__attribute__((ext_vector_type(8)))short;
using s16x4=__attribute__((ext_vector_type(4)))short;
using f32x16=__attribute__((ext_vector_type(16)))float;
using u32x4=__attribute__((ext_vector_type(4)))unsigned;
constexpr int BATCH=2,NHEAD=16,SEQ=8192,D=64,DM=NHEAD*D;
constexpr int NW=8,QBLK=32,QB=QBLK*NW,KVBLK=64,NQB=SEQ/QB;
constexpr int ATTN_PITCH=DM, ATTN_UNIT_ROWS=QB;
__device__ __forceinline__ int crow(int r,int hi){return (r&3)+8*(r>>2)+4*hi;}
#define SBAR() __builtin_amdgcn_sched_barrier(0)
typedef const __attribute__((address_space(3))) float* lds_cfp;
__device__ __forceinline__ void cmask(f32x16&p0,f32x16&p1,int jb,int qrel,int hi,lds_cfp bt){
  const float NEG=-INFINITY; const int kb=64*jb+4*hi;
  #pragma unroll
  for(int r=0;r<16;++r){const int d0=qrel-(kb+(r&3)+8*(r>>2)), d1=d0-32;
    const float b0=bt[d0<0?0:(d0>127?127:d0)], b1=bt[d1<0?0:(d1>127?127:d1)];
    p0[r]=d0<0?NEG:p0[r]+b0; p1[r]=d1<0?NEG:p1[r]+b1;}
}

constexpr int NSLOT=3, SLOTB=8192;
constexpr int LDS_K=0, LDS_V=NSLOT*SLOTB, LDS_WS=2*NSLOT*SLOTB, LDS_OST=LDS_WS+NW*64*4, LDS_BYTES=LDS_OST+NW*4096;
constexpr float C2_=0.125f*1.4426950408889634f;
__device__ __forceinline__ void glds16(const void*gsrc,unsigned lds_dst){unsigned keep;
  asm volatile("s_mov_b32 %0, m0\n\ts_mov_b32 m0, %2\n\ts_nop 0\n\tglobal_load_lds_dwordx4 %1, off\n\ts_mov_b32 m0, %0":"=&s"(keep):"v"(gsrc),"s"(lds_dst):"memory");}
__device__ __forceinline__ float max3f(float a,float b,float c){float r;asm("v_max3_f32 %0, %1, %2, %3":"=v"(r):"v"(a),"v"(b),"v"(c));return r;}
__device__ __forceinline__ float max2f(float a,float b){float r;asm("v_max_f32_e32 %0, %1, %2":"=v"(r):"v"(a),"v"(b));return r;}
__device__ __forceinline__ float fadd_s(float a,float b){float r;asm("v_add_f32_e32 %0, %1, %2":"=v"(r):"v"(a),"v"(b));return r;}
__device__ __forceinline__ float fsub_s(float a,float b){float r;asm("v_sub_f32_e32 %0, %1, %2":"=v"(r):"v"(a),"v"(b));return r;}
typedef float f32x2_t __attribute__((ext_vector_type(2))); typedef __bf16 bf16x2_t __attribute__((ext_vector_type(2)));
__device__ __forceinline__ unsigned cvtpk_s(float lo,float hi){f32x2_t v={lo,hi};bf16x2_t b=__builtin_convertvector(v,bf16x2_t);return __builtin_bit_cast(unsigned,b);}
#define WAIT_BAR(N) asm volatile("s_waitcnt vmcnt(" #N ") lgkmcnt(0)\n\ts_barrier":::"memory")

__device__ __forceinline__ void qkt(f32x16&p0,f32x16&p1,const char*Kslot,const bf16x8*qr,const f32x16&negm,int r32,int hi){
  const char*kb=Kslot+hi*1024+r32*16;
  #pragma unroll
  for(int d0=0;d0<4;++d0){
    const bf16x8 b0=*reinterpret_cast<const bf16x8*>(kb+d0*2048);
    const bf16x8 b1=*reinterpret_cast<const bf16x8*>(kb+d0*2048+512);
    if(d0==0){p0=__builtin_amdgcn_mfma_f32_32x32x16_bf16(b0,qr[0],negm,0,0,0);p1=__builtin_amdgcn_mfma_f32_32x32x16_bf16(b1,qr[0],negm,0,0,0);}
    else{p0=__builtin_amdgcn_mfma_f32_32x32x16_bf16(b0,qr[d0],p0,0,0,0);p1=__builtin_amdgcn_mfma_f32_32x32x16_bf16(b1,qr[d0],p1,0,0,0);}}
}
typedef __attribute__((address_space(3))) const char* lds_cptr;
typedef short v4i16_t __attribute__((ext_vector_type(4)));
__device__ __forceinline__ void kload8(bf16x8*kf,lds_cptr kp){
  kf[0]=*(const __attribute__((address_space(3))) bf16x8*)(kp);      kf[1]=*(const __attribute__((address_space(3))) bf16x8*)(kp+512);
  kf[2]=*(const __attribute__((address_space(3))) bf16x8*)(kp+2048); kf[3]=*(const __attribute__((address_space(3))) bf16x8*)(kp+2560);
  kf[4]=*(const __attribute__((address_space(3))) bf16x8*)(kp+4096); kf[5]=*(const __attribute__((address_space(3))) bf16x8*)(kp+4608);
  kf[6]=*(const __attribute__((address_space(3))) bf16x8*)(kp+6144); kf[7]=*(const __attribute__((address_space(3))) bf16x8*)(kp+6656);
}
__device__ __forceinline__ void kload2(bf16x8*kf,lds_cptr kp,int j){ kf[2*j]=*(const __attribute__((address_space(3))) bf16x8*)(kp+j*2048); kf[2*j+1]=*(const __attribute__((address_space(3))) bf16x8*)(kp+j*2048+512); }
__device__ __forceinline__ s16x4 vtr(lds_cptr p){ return __builtin_bit_cast(s16x4,__builtin_amdgcn_ds_read_tr16_b64_v4i16((__attribute__((address_space(3))) v4i16_t*)p)); }
__device__ __forceinline__ float rowmax(const f32x16&p0,const f32x16&p1){
  float a=max3f(p0[0],p0[1],p1[0]),b=max3f(p0[2],p0[3],p1[1]);a=max3f(a,p1[2],p1[3]);
  #pragma unroll
  for(int r=4;r<16;r+=4){a=max3f(a,p0[r],p0[r+1]);b=max3f(b,p0[r+2],p0[r+3]);a=max3f(a,p1[r],p1[r+1]);b=max3f(b,p1[r+2],p1[r+3]);}
  const float m=max2f(a,b);
  auto rr=__builtin_amdgcn_permlane32_swap(__float_as_uint(m),__float_as_uint(m),false,false);
  return max2f(__uint_as_float(rr[0]),__uint_as_float(rr[1]));
}
__device__ __forceinline__ void pv(f32x16*o,int vb,bf16x8 pa0,bf16x8 pa1,bf16x8 pa2,bf16x8 pa3){
  #pragma unroll
  for(int d0=0;d0<2;++d0){s16x4 lo[4],hi[4];
    #pragma unroll
    for(int ks=0;ks<4;++ks){
      asm volatile("ds_read_b64_tr_b16 %0,%1 offset:%c2":"=&v"(lo[ks]):"v"(vb),"i"(d0*4096+ks*1024):"memory");
      asm volatile("ds_read_b64_tr_b16 %0,%1 offset:%c2":"=&v"(hi[ks]):"v"(vb),"i"(d0*4096+ks*1024+512):"memory");}
    asm volatile("s_waitcnt lgkmcnt(0)":::"memory");SBAR();
    #define PK(k) (bf16x8){lo[k][0],lo[k][1],lo[k][2],lo[k][3],hi[k][0],hi[k][1],hi[k][2],hi[k][3]}
    o[d0]=__builtin_amdgcn_mfma_f32_32x32x16_bf16(pa0,PK(0),o[d0],0,0,0);
    o[d0]=__builtin_amdgcn_mfma_f32_32x32x16_bf16(pa1,PK(1),o[d0],0,0,0);
    o[d0]=__builtin_amdgcn_mfma_f32_32x32x16_bf16(pa2,PK(2),o[d0],0,0,0);
    o[d0]=__builtin_amdgcn_mfma_f32_32x32x16_bf16(pa3,PK(3),o[d0],0,0,0);
    #undef PK
  }
}

#ifndef ATTN_STORE16
#define ATTN_STORE16(p,v) (*(u32x4*)(p)=(v))
#endif
template<int THRL> __device__ __forceinline__ void attn_unit(int b,int h,int qb,const bf16*Q,const bf16*__restrict__ K,const bf16*__restrict__ V,bf16*O,char*shm,lds_cfp btab){
  const lds_cfp bt=btab+(h>>2)*128;
  int tid_=threadIdx.x; asm volatile("":"+v"(tid_));
  const int tid=tid_,lane=tid&63,r32=lane&31,hi=lane>>5; const int wid=__builtin_amdgcn_readfirstlane(tid>>6);
  const long rowbase=(long)b*SEQ; const int q0=qb*QB;
  const bf16*Qw=Q+(rowbase+q0+wid*QBLK)*DM+h*D;
  const bf16*Kh=K+rowbase*DM+h*D,*Vh=V+rowbase*DM+h*D;
  const unsigned lds0=(unsigned)(uintptr_t)shm;
  float*wsf=(float*)(shm+LDS_WS)+wid*64;
  const bf16*ksrc=Kh+(long)lane*DM+wid*8;
  const bf16*vsrc=Vh+(long)(16*(wid&3)+(lane>>2))*DM+(wid>>2)*32+(lane&3)*8;
  const unsigned kdst=lds0+LDS_K+wid*1024, vdst=lds0+LDS_V+wid*1024;
  #define DMA_K(t,slot) glds16(ksrc+(long)(t)*KVBLK*DM,(unsigned)__builtin_amdgcn_readfirstlane(kdst+(slot)))
  #define DMA_V(t,slot) glds16(vsrc+(long)(t)*KVBLK*DM,(unsigned)__builtin_amdgcn_readfirstlane(vdst+(slot)))
  const int vb0=(int)(lds0+LDS_V)+((lane>>4)&1)*32+(lane&3)*8+(4*hi+((lane&15)>>2))*64;
  const char*Kbase=shm+LDS_K; bf16x8 kf[8];
  const lds_cptr shm3=(lds_cptr)shm; const lds_cptr kp0=shm3+LDS_K+hi*1024+r32*16; const lds_cptr vp0=shm3+LDS_V+((lane>>4)&1)*32+(lane&3)*8+(4*hi+((lane&15)>>2))*64;
  const int NT=(q0+QB)/KVBLK;
  DMA_K(0,0);DMA_V(0,0);DMA_K(1,SLOTB);
  bf16x8 qr[4];
  #pragma unroll
  for(int d0=0;d0<4;++d0)qr[d0]=*reinterpret_cast<const bf16x8*>(&Qw[(long)r32*DM+d0*16+hi*8]);
  float mhat=0.f,l_reg=0.f;f32x16 o[2];o[0]=f32x16{};o[1]=f32x16{};f32x16 negm=f32x16{};asm volatile("":"+v"(negm));
  const int qrel=wid*QBLK+r32;
  #define CMASK(P0,P1,t) do{int jb_=(t)-(NT-4); if(jb_>=-2)cmask(P0,P1,jb_,qrel,hi,bt);}while(0)
  bool resc=false;
  #define START(P0,P1) do{ const float rm=rowmax(P0,P1); resc=false; \
    { const float dl=rm; mhat=fadd_s(mhat,dl); \
      _Pragma("unroll") for(int r=0;r<16;++r){P0[r]=fsub_s(P0[r],dl);P1[r]=fsub_s(P1[r],dl);} \
      _Pragma("unroll") for(int r=0;r<16;++r)negm[r]=-mhat; asm volatile("":"+v"(negm)); } \
    _Pragma("unroll") for(int r=0;r<16;++r)P0[r]=__builtin_amdgcn_exp2f(P0[r]); }while(0)
  #define RESC() do{ if(resc){ asm volatile("s_waitcnt lgkmcnt(0)":::"memory"); \
      _Pragma("unroll") for(int d_=0;d_<2;++d_) _Pragma("unroll") for(int r=0;r<16;++r)o[d_][r]*=wsf[crow(r,hi)]; } }while(0)
  f32x16 pA0,pA1,pB0,pB1;
  int sl_prev=0,sl_cur=0,sl_next=SLOTB;
  #define ROT() do{sl_prev=sl_cur;sl_cur=sl_next;sl_next=(sl_next==(NSLOT-1)*SLOTB)?0:sl_next+SLOTB;}while(0)
  DMA_K(2,2*SLOTB);
  WAIT_BAR(3);
  qkt(pA0,pA1,Kbase,qr,negm,r32,hi);asm volatile("s_nop 15\n\ts_nop 7":"+v"(pA0),"+v"(pA1));CMASK(pA0,pA1,0);
  START(pA0,pA1);
  _Pragma("unroll") for(int r=0;r<16;++r)pA1[r]=__builtin_amdgcn_exp2f(pA1[r]);
  WAIT_BAR(0);
  DMA_K(3,0);DMA_V(1,SLOTB);
  ROT();
  kload8(kf,kp0+sl_cur);
  WAIT_BAR(2);
  s16x4 vlo[8],vhi[8]; u32x4 pw0,pw1,pw2,pw3;
  #define PKW(P,B) cvtpk_s(P[B],P[B+1])
  #define PAF(k) __builtin_bit_cast(bf16x8,pw##k)
  #define VFR(i) (bf16x8){vlo[i][0],vlo[i][1],vlo[i][2],vlo[i][3],vhi[i][0],vhi[i][1],vhi[i][2],vhi[i][3]}
  #define PIN(x) asm volatile("":"+v"(x))
  #define MX3(a,b,c) __builtin_fmaxf(__builtin_fmaxf((a),(b)),(c))
  #define GAPA(MF,A0,A1,A2,A3,W0,W1,PW) do{ MF; sacc+=A0; sacc+=A1; sacc+=A2; sacc+=A3; PIN(sacc); W0; W1; PIN(PW); SBAR(); }while(0)
  #define EX(v) __builtin_amdgcn_exp2f(v)
  #define GAPB(MF,X,B) do{ MF; X[B]=EX(X[B]); X[B+1]=EX(X[B+1]); X[B+2]=EX(X[B+2]); X[B+3]=EX(X[B+3]); PIN(X); SBAR(); }while(0)
  #define VRD(i) do{ vlo[i]=vtr(vp_+(((i)>>2)*4096+((i)&3)*1024)); vhi[i]=vtr(vp_+(((i)>>2)*4096+((i)&3)*1024+512)); }while(0)
  #define KRD(G,j) do{ if(G){ kload2(kf,kp0+sl_next,j); SBAR(); } }while(0)
  #define STEP(C0,C1,P0,P1,t,GK,GV,GL) do{ SBAR(); \
    const lds_cptr vp_=vp0+sl_prev; \
    VRD(0); SBAR(); float sacc=(P0[0]+P0[1]); \
    GAPA(C0=__builtin_amdgcn_mfma_f32_32x32x16_bf16(kf[0],qr[0],negm,0,0,0), P0[2],P0[3],P0[4],P0[5],     pw0[0]=PKW(P0,0), pw0[1]=PKW(P0,2), pw0); \
    VRD(4); SBAR(); GAPA(C1=__builtin_amdgcn_mfma_f32_32x32x16_bf16(kf[1],qr[0],negm,0,0,0), P0[6],P0[7],P0[8],P0[9],     pw0[2]=PKW(P0,4), pw0[3]=PKW(P0,6), pw0); \
    VRD(1); SBAR(); GAPA(C0=__builtin_amdgcn_mfma_f32_32x32x16_bf16(kf[2],qr[1],C0,0,0,0),   P0[10],P0[11],P0[12],P0[13], pw1[0]=PKW(P0,8), pw1[1]=PKW(P0,10), pw1); \
    VRD(5); SBAR(); GAPA(C1=__builtin_amdgcn_mfma_f32_32x32x16_bf16(kf[3],qr[1],C1,0,0,0),   P0[14],P0[15],P1[0],P1[1],   pw1[2]=PKW(P0,12),pw1[3]=PKW(P0,14), pw1); \
    VRD(2); SBAR(); GAPA(C0=__builtin_amdgcn_mfma_f32_32x32x16_bf16(kf[4],qr[2],C0,0,0,0),   P1[2],P1[3],P1[4],P1[5],     pw2[0]=PKW(P1,0), pw2[1]=PKW(P1,2), pw2); \
    VRD(6); SBAR(); GAPA(C1=__builtin_amdgcn_mfma_f32_32x32x16_bf16(kf[5],qr[2],C1,0,0,0),   P1[6],P1[7],P1[8],P1[9],     pw2[2]=PKW(P1,4), pw2[3]=PKW(P1,6), pw2); \
    VRD(3); SBAR(); GAPA(C0=__builtin_amdgcn_mfma_f32_32x32x16_bf16(kf[6],qr[3],C0,0,0,0),   P1[10],P1[11],P1[12],P1[13], pw3[0]=PKW(P1,8), pw3[1]=PKW(P1,10), pw3); \
    VRD(7); SBAR(); GAPA(C1=__builtin_amdgcn_mfma_f32_32x32x16_bf16(kf[7],qr[3],C1,0,0,0),   P1[14],P1[15],0.f,0.f,       pw3[2]=PKW(P1,12),pw3[3]=PKW(P1,14), pw3); \
    l_reg+=sacc; \
    if(GK){DMA_K((t)+3,sl_cur);} if(GV){DMA_V((t)+1,sl_next);} \
    CMASK(C0,C1,t); \
    { float a=MX3(C0[0],C0[1],C1[0]),b=MX3(C0[2],C0[3],C1[1]); a=MX3(a,C1[2],C1[3]); \
      _Pragma("unroll") for(int r=4;r<16;r+=4){a=MX3(a,C0[r],C0[r+1]);b=MX3(b,C0[r+2],C0[r+3]);a=MX3(a,C1[r],C1[r+1]);b=MX3(b,C1[r+2],C1[r+3]);} \
      float rm=__builtin_fmaxf(a,b); { auto rr=__builtin_amdgcn_permlane32_swap(__float_as_uint(rm),__float_as_uint(rm),false,false); rm=__builtin_fmaxf(__uint_as_float(rr[0]),__uint_as_float(rr[1])); } \
      resc=false; \
      if(__builtin_expect(__any(rm>(float)THRL),0)){ const float dl=__builtin_fmaxf(rm,0.f); mhat+=dl; \
        _Pragma("unroll") for(int r=0;r<16;++r){C0[r]-=dl;C1[r]-=dl;} \
        _Pragma("unroll") for(int r=0;r<16;++r)negm[r]=-mhat; asm volatile("":"+v"(negm)); \
        const float f=__builtin_amdgcn_exp2f(-dl); l_reg*=f; if(hi==0)wsf[r32]=f; resc=true; } } \
    SBAR(); \
    GAPB(o[0]=__builtin_amdgcn_mfma_f32_32x32x16_bf16(PAF(0),VFR(0),o[0],0,0,0), C0,0); \
    GAPB(o[1]=__builtin_amdgcn_mfma_f32_32x32x16_bf16(PAF(0),VFR(4),o[1],0,0,0), C0,4); \
    KRD(GL,0); GAPB(o[0]=__builtin_amdgcn_mfma_f32_32x32x16_bf16(PAF(1),VFR(1),o[0],0,0,0), C0,8); \
    KRD(GL,1); GAPB(o[1]=__builtin_amdgcn_mfma_f32_32x32x16_bf16(PAF(1),VFR(5),o[1],0,0,0), C0,12); \
    KRD(GL,2); GAPB(o[0]=__builtin_amdgcn_mfma_f32_32x32x16_bf16(PAF(2),VFR(2),o[0],0,0,0), C1,0); \
    KRD(GL,3); GAPB(o[1]=__builtin_amdgcn_mfma_f32_32x32x16_bf16(PAF(2),VFR(6),o[1],0,0,0), C1,4); \
    GAPB(o[0]=__builtin_amdgcn_mfma_f32_32x32x16_bf16(PAF(3),VFR(3),o[0],0,0,0), C1,8); \
    GAPB(o[1]=__builtin_amdgcn_mfma_f32_32x32x16_bf16(PAF(3),VFR(7),o[1],0,0,0), C1,12); \
    }while(0)
  int t=1;
  #undef CMASK
  #define CMASK(P0,P1,t) do{}while(0)
  for(;t+7<NT;t+=2){
    STEP(pB0,pB1,pA0,pA1,t,true,true,true);     WAIT_BAR(2); RESC(); ROT();
    STEP(pA0,pA1,pB0,pB1,t+1,true,true,true);   WAIT_BAR(2); RESC(); ROT();
  }
  #undef CMASK
  #define CMASK(P0,P1,t) do{int jb_=(t)-(NT-4); if(jb_>=-2)cmask(P0,P1,jb_,qrel,hi,bt);}while(0)
  #define ENDW(tt) do{ if((tt)+3<NT){WAIT_BAR(2);} else if((tt)+2<NT){WAIT_BAR(1);} else {WAIT_BAR(0);} }while(0)
  for(;t+1<NT;t+=2){
    STEP(pB0,pB1,pA0,pA1,t,(t+3<NT),(t+1<NT),(t+1<NT));       ENDW(t);   RESC(); ROT();
    STEP(pA0,pA1,pB0,pB1,t+1,(t+4<NT),(t+2<NT),(t+2<NT));     ENDW(t+1); RESC(); ROT();
  }
  STEP(pB0,pB1,pA0,pA1,NT-1,false,false,false); RESC();
  { float sacc=pB0[0]+pB0[1]; _Pragma("unroll") for(int r=2;r<16;++r)sacc+=pB0[r]; _Pragma("unroll") for(int r=0;r<16;++r)sacc+=pB1[r]; l_reg+=sacc;
    pw0=(u32x4){PKW(pB0,0),PKW(pB0,2),PKW(pB0,4),PKW(pB0,6)};pw1=(u32x4){PKW(pB0,8),PKW(pB0,10),PKW(pB0,12),PKW(pB0,14)};pw2=(u32x4){PKW(pB1,0),PKW(pB1,2),PKW(pB1,4),PKW(pB1,6)};pw3=(u32x4){PKW(pB1,8),PKW(pB1,10),PKW(pB1,12),PKW(pB1,14)};
    SBAR(); pv(o,vb0+sl_cur,PAF(0),PAF(1),PAF(2),PAF(3)); }
  #undef PKW
  #undef PAF
  #undef VFR
  #undef PIN
  #undef MX3
  #undef GAPA
  #undef GAPB
  #undef EX
  #undef VRD
  #undef KRD
  #undef STEP
  #undef ENDW
  {auto rr=__builtin_amdgcn_permlane32_swap(__float_as_uint(l_reg),__float_as_uint(l_reg),false,false);l_reg=__uint_as_float(rr[0])+__uint_as_float(rr[1]);}
  if(hi==0)wsf[32+r32]=l_reg;asm volatile("s_waitcnt lgkmcnt(0)":::"memory");
  float rli[16];
  #pragma unroll
  for(int r=0;r<16;++r)rli[r]=__builtin_amdgcn_rcpf(wsf[32+crow(r,hi)]);
  bf16*Ow=O+(rowbase+q0+wid*QBLK)*DM+h*D;
  { bf16*stg=(bf16*)(shm+LDS_OST)+wid*2048;
    #pragma unroll
    for(int r=0;r<16;++r){const int orow=crow(r,hi);
      #pragma unroll
      for(int d0=0;d0<2;++d0)stg[orow*64+d0*32+r32]=__float2bfloat16(o[d0][r]*rli[r]);}
    asm volatile("s_waitcnt lgkmcnt(0)":::"memory");
    #pragma unroll
    for(int i=0;i<4;++i){const int row=i*8+(lane>>3),ch=lane&7; const u32x4 v=*(const u32x4*)(stg+row*64+ch*8); ATTN_STORE16(Ow+(long)row*DM+ch*8,v);} }
  asm volatile("s_waitcnt lgkmcnt(0)\n\ts_barrier":::"memory");
  #undef DMA_K
  #undef DMA_V
  #undef CMASK
  #undef START
  #undef RESC
  #undef ROT
}
constexpr int ATTN_LDS_BYTES=LDS_BYTES;
struct AttnTensors { const bf16* Q; const bf16* K; const bf16* V; bf16* O; };
struct AttnUnit { int bh; int qb; };
struct StaticOrder {
  int vcu;
  __device__ __forceinline__ explicit StaticOrder(int grid,int block):vcu((block%8)*(grid/8)+block/8){}
  __device__ __forceinline__ bool next(int i,AttnUnit&u)const{ if(i>=4)return false; const int s=vcu&7; u.bh=vcu>>3; u.qb=(i==0)?s:(i==1)?15-s:(i==2)?16+s:31-s; return true; }
  __device__ __forceinline__ void a_ready(const AttnUnit&)const{}
  __device__ __forceinline__ void done(const AttnUnit&)const{}
};
template<class Sched,int THRL=8> __device__ __forceinline__ void attn_phase(char*lds,const AttnTensors&T,const Sched&S,lds_cfp btab){
  AttnUnit u;
  for(int i=0;S.next(i,u);++i){ S.a_ready(u); attn_unit<THRL>(u.bh/NHEAD,u.bh%NHEAD,u.qb,T.Q,T.K,T.V,T.O,lds,btab); S.done(u); }
}
#undef SBAR
#undef WAIT_BAR
}

constexpr int NWAVES = 8;
constexpr size_t MiB = 1u << 20;
constexpr size_t WS_CTL = 0, CTL_ZERO_BYTES = 1 * MiB;
constexpr size_t WS_WIN = 2 * MiB, WS_WOUT = 8 * MiB, WS_WGLU = 10 * MiB, WS_TAB = 11 * MiB, WS_E = 12 * MiB, WS_QS = 14 * MiB, WS_PART = 16 * MiB;
constexpr size_t WS_XN = 32 * MiB, WS_Q = 66 * MiB, WS_K = 98 * MiB, WS_V = 130 * MiB, WS_GA = 162 * MiB, WS_U = 179 * MiB, WS_GS = 196 * MiB, WS_Z = 213 * MiB, WS_A2 = 230 * MiB, WS_END = 264 * MiB;
constexpr int TB_LAM = 0, TB_BIAS = 64  , TB_END = 64 + 512;
constexpr int CW_BAR = 4096;

constexpr int RING_OFF = 0, RING_BYTES = 131072;
constexpr int LDSCTL_OFF = RING_BYTES, MISC_OFF = LDSCTL_OFF + 320;
constexpr int LDS_BYTES = 147456;

#define GAS __attribute__((address_space(1)))
#define LAS __attribute__((address_space(3)))
typedef unsigned short bf16;
typedef unsigned v4u __attribute__((ext_vector_type(4)));
typedef float f32x4 __attribute__((ext_vector_type(4)));
typedef short bf16x8 __attribute__((ext_vector_type(8)));
typedef GAS unsigned gu32;
typedef GAS unsigned long long gu64;
#define RLX_AGENT __ATOMIC_RELAXED, __HIP_MEMORY_SCOPE_AGENT
#define LDS_WAIT() asm volatile("s_waitcnt lgkmcnt(0)" ::: "memory")
#define VM_WAIT() asm volatile("s_waitcnt vmcnt(0)" ::: "memory")
__device__ __forceinline__ unsigned long long rt() { return __builtin_amdgcn_s_memrealtime(); }
__device__ __forceinline__ unsigned f2bf(float f) { unsigned u = __builtin_bit_cast(unsigned, f); return (u + 0x7fffu + ((u >> 16) & 1u)) >> 16; }
__device__ __forceinline__ unsigned pk2(float lo, float hi) { return f2bf(lo) | (f2bf(hi) << 16); }

#define XB_TMO      128
#define XB_XCNT(j)  (256  + 64 * (j))
#define XB_XSUB(j)  (1280 + 64 * (j))
#define XB_XGEN(j)  (2304 + 64 * (j))
#define XB_TOP      3328
#define XB_TOPGEN   3392
#define XCD_BAR_WORDS 3456
#define XB_SPIN_CAP (1u << 18)

__device__ __forceinline__ unsigned xb_ld(unsigned* p)              { return __hip_atomic_load(p, __ATOMIC_RELAXED, __HIP_MEMORY_SCOPE_AGENT); }
__device__ __forceinline__ unsigned xb_add(unsigned* p, unsigned v) { return __hip_atomic_fetch_add(p, v, __ATOMIC_RELAXED, __HIP_MEMORY_SCOPE_AGENT); }
__device__ __forceinline__ unsigned xb_xcc_id() { return (unsigned)__builtin_amdgcn_s_getreg((3 << 11) | 20) & 0xFu; }
#define XB_SPIN(cond, bar) do { unsigned _sp = 0; while (cond) { __builtin_amdgcn_s_sleep(1); \
    if ((++_sp & 255u) == 0u) { if (xb_ld(&(bar)[XB_TMO])) break; if (_sp > XB_SPIN_CAP) { atomicAdd(&(bar)[XB_TMO], 1u); break; } } } } while (0)

struct XcdBarrier {
    unsigned* bar; unsigned x;
    volatile LAS unsigned* st;
};

__device__ __forceinline__ XcdBarrier xcd_barrier_post(unsigned* bar, volatile LAS unsigned* st) {
    XcdBarrier b; b.bar = bar; b.x = xb_xcc_id(); b.st = st;
    if (threadIdx.x == 0) (void)xb_add(&bar[XB_XCNT(b.x)], 1u);
    return b;
}
__device__ __forceinline__ void xcd_barrier_complete(unsigned* bar, unsigned x, unsigned& nloc, unsigned& nx) {
    const unsigned G = gridDim.x * gridDim.y * gridDim.z;
    unsigned sum, cnt, mine, sp = 0u;
    for (;;) {
        sum = 0u; cnt = 0u; mine = 0u;
#pragma unroll
        for (unsigned j = 0; j < 16; ++j) { const unsigned c = xb_ld(&bar[XB_XCNT(j)]); sum += c; cnt += (c > 0u) ? 1u : 0u; mine = (j == x) ? c : mine; }
        if (sum == G) break;
        __builtin_amdgcn_s_sleep(1);
        if ((++sp & 255u) == 0u) { if (xb_ld(&bar[XB_TMO])) break; if (sp > XB_SPIN_CAP) { atomicAdd(&bar[XB_TMO], 1u); break; } }
    }
    nloc = mine > 0u ? mine : 1u; nx = cnt > 0u ? cnt : 1u;
}

__device__ __forceinline__ void xcd_barrier(const XcdBarrier& b) {
    asm volatile("s_waitcnt vmcnt(0)" ::: "memory");
    __syncthreads();
    if (threadIdx.x == 0) {
        unsigned* bar = b.bar;
        __builtin_amdgcn_s_waitcnt(0);
        unsigned nloc = b.st[0], nx = b.st[1];
        if (nloc == 0u) { xcd_barrier_complete(bar, b.x, nloc, nx); b.st[0] = nloc; b.st[1] = nx; }
        const unsigned old = xb_add(&bar[XB_XSUB(b.x)], 1u);
        const unsigned gen = old / nloc;
        if (old + 1u == (gen + 1u) * nloc) {
            __builtin_amdgcn_fence(__ATOMIC_RELEASE, "agent");
            asm volatile("s_waitcnt vmcnt(0)" ::: "memory");
            const unsigned og = xb_add(&bar[XB_TOP], 1u);
            const unsigned tg = og / nx;
            if (og + 1u == (tg + 1u) * nx) xb_add(&bar[XB_TOPGEN], 1u);
            else XB_SPIN(xb_ld(&bar[XB_TOPGEN]) == tg, bar);
            __builtin_amdgcn_fence(__ATOMIC_ACQUIRE, "agent");
            xb_add(&bar[XB_XGEN(b.x)], 1u);
            asm volatile("s_waitcnt vmcnt(0)" ::: "memory");
        } else {
            XB_SPIN(xb_ld(&bar[XB_XGEN(b.x)]) == gen, bar);
            __builtin_amdgcn_fence(__ATOMIC_ACQUIRE, "agent");
            asm volatile("s_waitcnt vmcnt(0)" ::: "memory");
        }
    }
    __syncthreads();
}

__device__ __forceinline__ float wave_sum(float v) {
#pragma unroll
    for (int o = 1; o < 64; o <<= 1) v += __shfl_xor(v, o);
    return v;
}
__device__ __forceinline__ void p0_transpose_item(const float* W, int K, int N, bf16* WT, bool permute, LAS float* scr, int item, int lane) {
    const int nblk = N / 32, kb = item / nblk, nb = item % nblk, k0 = 64 * kb, n0 = 32 * nb;
    int d0 = n0; if (permute) { const int a = n0 & 255; d0 = (n0 & ~255) + 128 * ((a >> 5) & 1) + 32 * (a >> 6); }
#pragma unroll 8
    for (int i = 0; i < 32; ++i) { const int kk = 2 * i + (lane >> 5); scr[kk * 33 + (lane & 31)] = W[(size_t)(k0 + kk) * N + n0 + (lane & 31)]; }
    LDS_WAIT(); asm volatile("" ::: "memory");
    const int c = lane & 7;
#pragma unroll
    for (int j = 0; j < 4; ++j) { const int n = (lane >> 3) + 8 * j; const LAS float* s = scr + (8 * c) * 33 + n;
        v4u o; o.x = pk2(s[0 * 33], s[1 * 33]); o.y = pk2(s[2 * 33], s[3 * 33]); o.z = pk2(s[4 * 33], s[5 * 33]); o.w = pk2(s[6 * 33], s[7 * 33]);
        *(GAS v4u*)(WT + (size_t)(d0 + n) * K + k0 + 8 * c) = o; }
    LDS_WAIT(); asm volatile("" ::: "memory");
}
__device__ __forceinline__ void rms_row_to_bf16(const float* xrow, const float* g, bf16* orow, int lane) {
    const GAS f32x4* xr = (const GAS f32x4*)xrow + lane; const GAS f32x4* gr = (const GAS f32x4*)g + lane;
    f32x4 v[4]; float s = 0.f;
#pragma unroll
    for (int j = 0; j < 4; ++j) { v[j] = xr[64 * j]; s += (v[j].x * v[j].x + v[j].y * v[j].y) + (v[j].z * v[j].z + v[j].w * v[j].w); }
    const float rs = rsqrtf(wave_sum(s) * (1.f / DM) + EPS);
    GAS unsigned long long* o8 = (GAS unsigned long long*)orow + lane;
#pragma unroll
    for (int j = 0; j < 4; ++j) { const f32x4 gg = gr[64 * j]; const f32x4 y = v[j] * rs * gg;
        o8[64 * j] = (unsigned long long)pk2(y.x, y.y) | ((unsigned long long)pk2(y.z, y.w) << 32); }
}
__device__ __forceinline__ int t5_bucket(int n) {
    if (n < 16) return n;
    int b = 16;
    b += (n >= 19); b += (n >= 21); b += (n >= 24); b += (n >= 27); b += (n >= 31); b += (n >= 35); b += (n >= 40); b += (n >= 46);
    b += (n >= 52); b += (n >= 59); b += (n >= 67); b += (n >= 77); b += (n >= 87); b += (n >= 99); b += (n >= 113);
    return b;
}

typedef float f32x16 __attribute__((ext_vector_type(16)));
typedef float f32x2 __attribute__((ext_vector_type(2)));
typedef unsigned u32x2 __attribute__((ext_vector_type(2)));
typedef unsigned u32x4 __attribute__((ext_vector_type(4)));
__device__ __forceinline__ float bf_lo(unsigned w) { return __uint_as_float(w << 16); }
__device__ __forceinline__ float bf_hi(unsigned w) { return __uint_as_float(w & 0xffff0000u); }
__device__ __forceinline__ unsigned pkbf(float lo, float hi) { return pg8::cvt_pk_bf16(lo, hi); }
__device__ __forceinline__ float ex2(float x) { return __builtin_amdgcn_exp2f(x); }
template <int CTRL> __device__ __forceinline__ float dppf(float x) { return __builtin_bit_cast(float, __builtin_amdgcn_mov_dpp(__builtin_bit_cast(int, x), CTRL, 0xf, 0xf, true)); }
__device__ __forceinline__ float sum16(float v) { v += dppf<0xB1>(v); v += dppf<0x4E>(v); v += dppf<0x141>(v); v += dppf<0x128>(v); return v; }
__device__ __forceinline__ float bc_lo(float x) { auto r = __builtin_amdgcn_permlane32_swap(__float_as_uint(x), __float_as_uint(x), false, false); return __uint_as_float(r[0]); }
__device__ __forceinline__ float bc_hi(float x) { auto r = __builtin_amdgcn_permlane32_swap(__float_as_uint(x), __float_as_uint(x), false, false); return __uint_as_float(r[1]); }
__device__ __forceinline__ void cfma(float& xr, float& xi, float ar, float ai, float br, float bi) { xr = fmaf(ar, br, fmaf(-ai, bi, xr)); xi = fmaf(ar, bi, fmaf(ai, br, xi)); }
__device__ __forceinline__ float gelu_tanh_f(float x) { const float t = 1.5957691216057308f * (x + 0.044715f * x * x * x); return x * __builtin_amdgcn_rcpf(1.0f + __expf(-t)); }

constexpr size_t OFF_TP = 4096, OFF_TA256 = OFF_TP + 65536, OFF_TBF = OFF_TA256 + 16384, OFF_TBB = OFF_TBF + 262144, OFF_TCC = OFF_TBB + 131072, OFF_TEND = OFF_TCC + 131072;
static_assert(OFF_TEND <= (1u << 20), "tables fit");
constexpr size_t WS_KS = 15 * MiB, WS_VS = 13 * MiB;
constexpr size_t WS_PML = WS_PART + 8 * MiB;
constexpr int BT_LDS_OFF = 90112;
constexpr int HROW = 68;

template <bool FULL> __device__ __forceinline__ void ssm_scan_state(f32x16& xr, f32x16& xi, const float (&pw)[8], float& cr, float& ci, bool hi_half) {
#pragma unroll
    for (int i = 0; i < 4; ++i)
#pragma unroll
        for (int j = 1; j < 4; ++j) { float a = xr[4 * i + j], b = xi[4 * i + j]; cfma(a, b, pw[0], pw[1], xr[4 * i + j - 1], xi[4 * i + j - 1]); xr[4 * i + j] = a; xi[4 * i + j] = b; }
    float cinr[4], cini[4];
#pragma unroll
    for (int i = 0; i < 4; ++i) {
        float t0r = xr[4 * i + 3], t0i = xi[4 * i + 3]; cfma(t0r, t0i, pw[6], pw[7], cr, ci);
        const float sr = bc_lo(t0r), si = bc_lo(t0i);
        cinr[i] = hi_half ? sr : cr; cini[i] = hi_half ? si : ci;
        float t1r = xr[4 * i + 3], t1i = xi[4 * i + 3]; cfma(t1r, t1i, pw[6], pw[7], sr, si);
        cr = bc_hi(t1r); ci = bc_hi(t1i);
    }
    if (FULL) {
#pragma unroll
        for (int i = 0; i < 4; ++i)
#pragma unroll
            for (int j = 0; j < 4; ++j) { float a = xr[4 * i + j], b = xi[4 * i + j]; cfma(a, b, pw[2 * j], pw[2 * j + 1], cinr[i], cini[i]); xr[4 * i + j] = a; xi[4 * i + j] = b; }
    }
}

template <bool FULL> __device__ __forceinline__ void ssm_chunk(int b, int chunk, int g, const unsigned char* tab, const bf16* U, float* E, const float* dsk, bf16* Z, float* out, int wmask, LAS unsigned* Hs, int lane) {
    const int r = lane & 31, hh = lane >> 5;
    bf16x8 Bf[4];
#pragma unroll
    for (int X = 0; X < 4; ++X) Bf[X] = *(const bf16x8*)(tab + OFF_TBB + ((size_t)(g * 4 + X) * 64 + lane) * 16);
    float pwl[8], pwh[8];
    { const f32x4* p = (const f32x4*)(tab + OFF_TP + (size_t)(g * 64 + r) * 32); const f32x4 a = p[0], c = p[1]; pwl[0] = a.x; pwl[1] = a.y; pwl[2] = a.z; pwl[3] = a.w; pwl[4] = c.x; pwl[5] = c.y; pwl[6] = c.z; pwl[7] = c.w; }
    { const f32x4* p = (const f32x4*)(tab + OFF_TP + (size_t)(g * 64 + 32 + r) * 32); const f32x4 a = p[0], c = p[1]; pwh[0] = a.x; pwh[1] = a.y; pwh[2] = a.z; pwh[3] = a.w; pwh[4] = c.x; pwh[5] = c.y; pwh[6] = c.z; pwh[7] = c.w; }
    float clr = 0.f, cli = 0.f, chr = 0.f, chi = 0.f;
    bf16x8 Cf[4]; f32x4 dv = {0.f, 0.f, 0.f, 0.f};
    if (FULL) {
        const f32x2 al = *(const f32x2*)(tab + OFF_TA256 + (size_t)(g * 64 + r) * 8), ah = *(const f32x2*)(tab + OFF_TA256 + (size_t)(g * 64 + 32 + r) * 8);
        for (int j = 0; j < chunk; ++j) {
            const float* e = E + ((size_t)((b * 32 + j) * 32 + g) * 64) * 2;
            const f32x2 el = *(const f32x2*)(e + 2 * r), eh = *(const f32x2*)(e + 2 * (32 + r));
            float nr = el.x, ni = el.y; cfma(nr, ni, al.x, al.y, clr, cli); clr = nr; cli = ni;
            float mr = eh.x, mi = eh.y; cfma(mr, mi, ah.x, ah.y, chr, chi); chr = mr; chi = mi;
        }
#pragma unroll
        for (int s = 0; s < 4; ++s) Cf[s] = *(const bf16x8*)(tab + OFF_TCC + ((size_t)(g * 4 + s) * 64 + lane) * 16);
        dv = *(const f32x4*)(dsk + g * 16 + 4 * (lane >> 4));
    }
    const size_t row_c = (size_t)b * SEQ + (size_t)chunk * 256;
    for (int tile = 0; tile < 8; ++tile) {
        const size_t row0 = row_c + tile * 32;
        const bf16x8 uf = *(const bf16x8*)(U + (row0 + r) * DH + 16 * g + 8 * hh);
        const f32x16 zero = {};
        f32x16 X0 = __builtin_amdgcn_mfma_f32_32x32x16_bf16(uf, Bf[0], zero, 0, 0, 0);
        f32x16 X1 = __builtin_amdgcn_mfma_f32_32x32x16_bf16(uf, Bf[1], zero, 0, 0, 0);
        f32x16 X2 = __builtin_amdgcn_mfma_f32_32x32x16_bf16(uf, Bf[2], zero, 0, 0, 0);
        f32x16 X3 = __builtin_amdgcn_mfma_f32_32x32x16_bf16(uf, Bf[3], zero, 0, 0, 0);
        ssm_scan_state<FULL>(X0, X2, pwl, clr, cli, hh != 0);
        ssm_scan_state<FULL>(X1, X3, pwh, chr, chi, hh != 0);
        if (FULL) {
#pragma unroll
            for (int q = 0; q < 16; ++q) { const int t = (q & 3) + 8 * (q >> 2) + 4 * hh;
                Hs[t * HROW + r] = pkbf(X0[q], X2[q]); Hs[t * HROW + 32 + r] = pkbf(X1[q], X3[q]); }
            asm volatile("s_waitcnt lgkmcnt(0)" ::: "memory");
#pragma unroll
            for (int nb = 0; nb < 2; ++nb) {
                f32x4 acc = {0.f, 0.f, 0.f, 0.f};
#pragma unroll
                for (int s = 0; s < 4; ++s) { const bf16x8 hf = *(const LAS bf16x8*)(Hs + (16 * nb + (lane & 15)) * HROW + 16 * s + 4 * (lane >> 4));
                    acc = __builtin_amdgcn_mfma_f32_16x16x32_bf16(Cf[s], hf, acc, 0, 0, 0); }
                const size_t row = row0 + 16 * nb + (lane & 15); const int col = 16 * g + 4 * (lane >> 4);
                const u32x2 uw = *(const u32x2*)(U + row * DH + col);
                const float y0 = acc[0] + dv[0] * bf_lo(uw.x), y1 = acc[1] + dv[1] * bf_hi(uw.x), y2 = acc[2] + dv[2] * bf_lo(uw.y), y3 = acc[3] + dv[3] * bf_hi(uw.y);
                u32x2 zw; zw.x = pkbf(gelu_tanh_f(y0), gelu_tanh_f(y1)); zw.y = pkbf(gelu_tanh_f(y2), gelu_tanh_f(y3));
                *(u32x2*)(Z + row * DH + col) = zw;
            }
            asm volatile("s_waitcnt lgkmcnt(0)" ::: "memory");
        }
    }
    if (!FULL) {
        if (hh == 0) { float* e = E + ((size_t)((b * 32 + chunk) * 32 + g) * 64) * 2; *(f32x2*)(e + 2 * r) = (f32x2){clr, cli}; *(f32x2*)(e + 2 * (32 + r)) = (f32x2){chr, chi}; }
    } else if (chunk == 31 && (wmask & 2) && hh == 0) {
        const int o = (b * 32 + g) * 64;
        out[O_SRP + o + r] = clr; out[O_SIP + o + r] = cli; out[O_SRP + o + 32 + r] = chr; out[O_SIP + o + 32 + r] = chi;
    }
}

__device__ __forceinline__ void ssm_sample_item(int b, int g, const unsigned char* tab, const bf16* U, const float* h0re, const float* h0im, const float* cre, const float* cim, const float* dsk,
                                                bf16* Z, float* out, int wmask, int p) {
    const f32x2 a1 = *(const f32x2*)(tab + OFF_TP + (size_t)(g * 64 + p) * 32);
    float bbr[16], bbi[16], cr[16], ci[16];
    { const f32x4* t = (const f32x4*)(tab + OFF_TBF + (size_t)(g * 64 + p) * 128);
#pragma unroll
      for (int k = 0; k < 4; ++k) { const f32x4 x = t[k], y = t[4 + k]; bbr[4 * k] = x.x; bbr[4 * k + 1] = x.y; bbr[4 * k + 2] = x.z; bbr[4 * k + 3] = x.w; bbi[4 * k] = y.x; bbi[4 * k + 1] = y.y; bbi[4 * k + 2] = y.z; bbi[4 * k + 3] = y.w; } }
#pragma unroll
    for (int c = 0; c < 16; ++c) { cr[c] = cre[(g * 16 + c) * 64 + p]; ci[c] = cim[(g * 16 + c) * 64 + p]; }
    float hr = h0re[(b * 32 + g) * 64 + p], hi = h0im[(b * 32 + g) * 64 + p];
    const float dd = dsk[g * 16 + (p & 15)];
    for (int t = 0; t < 4; ++t) {
        const size_t row = (size_t)MP + b * 4 + t;
        const u32x4 w0 = *(const u32x4*)(U + row * DH + 16 * g), w1 = *(const u32x4*)(U + row * DH + 16 * g + 8);
        float u[16];
        u[0] = bf_lo(w0.x); u[1] = bf_hi(w0.x); u[2] = bf_lo(w0.y); u[3] = bf_hi(w0.y); u[4] = bf_lo(w0.z); u[5] = bf_hi(w0.z); u[6] = bf_lo(w0.w); u[7] = bf_hi(w0.w);
        u[8] = bf_lo(w1.x); u[9] = bf_hi(w1.x); u[10] = bf_lo(w1.y); u[11] = bf_hi(w1.y); u[12] = bf_lo(w1.z); u[13] = bf_hi(w1.z); u[14] = bf_lo(w1.w); u[15] = bf_hi(w1.w);
        float ur = 0.f, ui = 0.f;
#pragma unroll
        for (int c = 0; c < 16; ++c) { ur = fmaf(bbr[c], u[c], ur); ui = fmaf(bbi[c], u[c], ui); }
        cfma(ur, ui, a1.x, a1.y, hr, hi); hr = ur; hi = ui;
        float yv = 0.f, uc = 0.f;
#pragma unroll
        for (int c = 0; c < 16; ++c) { const float s = wave_sum(cr[c] * hr - ci[c] * hi); if (p == c) { yv = s; uc = u[c]; } }
        if (p < 16) { const float z = gelu_tanh_f(yv + dd * uc); Z[row * DH + 16 * g + p] = (bf16)(pkbf(z, z) & 0xffffu); }
    }
    if (wmask & 4) { out[O_SRS + (b * 32 + g) * 64 + p] = hr; out[O_SIS + (b * 32 + g) * 64 + p] = hi; }
}

struct DecAcc { float m, l; f32x4 o0[4], o1[4]; };
template <int Q> __device__ __forceinline__ float quad_bc(float x) { return dppf<Q * 0x55>(x); }
__device__ __forceinline__ void dec_key(DecAcc& A, const f32x4 (&qv)[4], const f32x4 kv, const f32x4 v0, const f32x4 v1, bool near, int key, const float* bt, bool b0, bool b1, int qi_l) {
    float d[4];
#pragma unroll
    for (int qi = 0; qi < 4; ++qi) d[qi] = fmaf(kv.w, qv[qi].w, fmaf(kv.z, qv[qi].z, fmaf(kv.y, qv[qi].y, kv.x * qv[qi].x)));
    const float ka = b0 ? d[1] : d[0], sa = b0 ? d[0] : d[1], kb = b0 ? d[3] : d[2], sb = b0 ? d[2] : d[3];
    const float ra = ka + dppf<0xB1>(sa), rb = kb + dppf<0xB1>(sb);
    const float k2 = b1 ? rb : ra, s2 = b1 ? ra : rb;
    float s = k2 + dppf<0x4E>(s2);
    s += dppf<0x124>(s); s += dppf<0x128>(s);
    if (near) { const int dd = 128 + qi_l - key; s += bt[dd > 127 ? 127 : dd]; }
    if (__any(s > A.m + 8.0f)) {
        const float mn = fmaxf(A.m, s), a = ex2(A.m - mn); A.l *= a; A.m = mn;
        const float a0 = quad_bc<0>(a), a1 = quad_bc<1>(a), a2 = quad_bc<2>(a), a3 = quad_bc<3>(a);
        A.o0[0] = A.o0[0] * a0; A.o1[0] = A.o1[0] * a0; A.o0[1] = A.o0[1] * a1; A.o1[1] = A.o1[1] * a1; A.o0[2] = A.o0[2] * a2; A.o1[2] = A.o1[2] * a2; A.o0[3] = A.o0[3] * a3; A.o1[3] = A.o1[3] * a3;
    }
    const float p = ex2(s - A.m); A.l += p;
    const float p0 = quad_bc<0>(p), p1 = quad_bc<1>(p), p2 = quad_bc<2>(p), p3 = quad_bc<3>(p);
    A.o0[0] = A.o0[0] + v0 * p0; A.o1[0] = A.o1[0] + v1 * p0; A.o0[1] = A.o0[1] + v0 * p1; A.o1[1] = A.o1[1] + v1 * p1;
    A.o0[2] = A.o0[2] + v0 * p2; A.o1[2] = A.o1[2] + v1 * p2; A.o0[3] = A.o0[3] + v0 * p3; A.o1[3] = A.o1[3] + v1 * p3;
}
__device__ __forceinline__ void decode_item(int b, int h, int sp, const float* QS, const float* ck, const float* cv, const int* pt, const float* bt, float* PO, float* PML, int lane) {
    const int hh = lane >> 5, cg = (lane >> 4) & 1, i16 = lane & 15;
    f32x4 qv[4];
#pragma unroll
    for (int qi = 0; qi < 4; ++qi) qv[qi] = *(const f32x4*)(QS + (size_t)(b * 4 + qi) * DH + h * 128 + cg * 64 + 4 * i16);
    DecAcc A;
#pragma unroll
    for (int qi = 0; qi < 4; ++qi) { A.o0[qi] = (f32x4){0.f, 0.f, 0.f, 0.f}; A.o1[qi] = (f32x4){0.f, 0.f, 0.f, 0.f}; }
    A.m = -1e30f; A.l = 0.f;
    const bool b0 = (lane & 1) != 0, b1 = (lane & 2) != 0; const int qi_l = lane & 3;
    int pg[4];
#pragma unroll
    for (int i = 0; i < 4; ++i) pg[i] = __builtin_amdgcn_readfirstlane(pt[b * NPAGES + sp * 4 + i]);
    const size_t koff = (size_t)h * 128 + cg * 64 + 4 * i16 + (size_t)hh * 512, voff = (size_t)h * 128 + 4 * i16 + (size_t)hh * 512;
    f32x4 kA[2], vA[2], wA[2], kB[2], vB[2], wB[2], kC[2], vC[2], wC[2], kD[2], vD[2], wD[2];
#define DEC_LOAD(KQ, VA, VC, g) do { const int pgi_ = (g) >> 5; const int pgn_ = pgi_ == 0 ? pg[0] : pgi_ == 1 ? pg[1] : pgi_ == 2 ? pg[2] : pg[3]; \
        const float* kb_ = ck + (size_t)pgn_ * (PAGE * 512) + koff + (size_t)((g) & 31) * 2048; const float* vb_ = cv + (size_t)pgn_ * (PAGE * 512) + voff + (size_t)((g) & 31) * 2048; \
        _Pragma("unroll") for (int u = 0; u < 2; ++u) { KQ[u] = __builtin_nontemporal_load((const f32x4*)(kb_ + u * 1024)); VA[u] = __builtin_nontemporal_load((const f32x4*)(vb_ + u * 1024)); \
            VC[u] = __builtin_nontemporal_load((const f32x4*)(vb_ + u * 1024 + 64)); } } while (0)
#define DEC_MATH(KQ, VA, VC, g) do { const bool near_ = (sp == 3) && ((g) >> 5) == 3; const int it0_ = ((g) & 31) * 2; \
        _Pragma("unroll") for (int u = 0; u < 2; ++u) dec_key(A, qv, KQ[u], VA[u], VC[u], near_, 2 * (it0_ + u) + hh, bt, b0, b1, qi_l); } while (0)
    DEC_LOAD(kA, vA, wA, 0); DEC_LOAD(kB, vB, wB, 1); DEC_LOAD(kC, vC, wC, 2);
    for (int g = 0; g < 128; g += 4) {
        DEC_LOAD(kD, vD, wD, g + 3);
        DEC_MATH(kA, vA, wA, g);
        if (g + 4 < 128) DEC_LOAD(kA, vA, wA, g + 4);
        DEC_MATH(kB, vB, wB, g + 1);
        if (g + 5 < 128) DEC_LOAD(kB, vB, wB, g + 5);
        DEC_MATH(kC, vC, wC, g + 2);
        if (g + 6 < 128) DEC_LOAD(kC, vC, wC, g + 6);
        DEC_MATH(kD, vD, wD, g + 3);
    }
#undef DEC_LOAD
#undef DEC_MATH
    {
        const float mo = __shfl_xor(A.m, 32), lo = __shfl_xor(A.l, 32), mn = fmaxf(A.m, mo), a = ex2(A.m - mn), ao = ex2(mo - mn);
        A.l = A.l * a + lo * ao; A.m = mn;
        float aq[4], aoq[4];
        aq[0] = quad_bc<0>(a); aq[1] = quad_bc<1>(a); aq[2] = quad_bc<2>(a); aq[3] = quad_bc<3>(a);
        aoq[0] = quad_bc<0>(ao); aoq[1] = quad_bc<1>(ao); aoq[2] = quad_bc<2>(ao); aoq[3] = quad_bc<3>(ao);
#pragma unroll
        for (int qi = 0; qi < 4; ++qi)
#pragma unroll
            for (int e = 0; e < 4; ++e) { A.o0[qi][e] = A.o0[qi][e] * aq[qi] + __shfl_xor(A.o0[qi][e], 32) * aoq[qi]; A.o1[qi][e] = A.o1[qi][e] * aq[qi] + __shfl_xor(A.o1[qi][e], 32) * aoq[qi]; }
    }
    if (hh == 0) {
#pragma unroll
        for (int qi = 0; qi < 4; ++qi) { const size_t pi = (size_t)((((b * 4 + h) * 4 + sp) * 2 + cg) * 4 + qi);
            *(f32x4*)(PO + pi * 128 + 4 * i16) = A.o0[qi]; *(f32x4*)(PO + pi * 128 + 64 + 4 * i16) = A.o1[qi]; }
        if (i16 < 4) { const size_t pi = (size_t)((((b * 4 + h) * 4 + sp) * 2 + cg) * 4 + i16); PML[2 * pi] = A.m; PML[2 * pi + 1] = A.l; }
    }
}

__device__ __forceinline__ void combine_sample(int sr, int h, const float* QS, const float* KS, const float* VS, const float* PO, const float* PML, const float* bt, float lam, const float* subg,
                                               const bf16* GA, bf16* A2, int lane) {
    const int b = sr >> 2, qi = sr & 3;
    float oc[2][2];
#pragma unroll
    for (int c = 0; c < 2; ++c) {
        const float qd = QS[(size_t)sr * DH + h * 128 + c * 64 + lane];
        float sj[4];
#pragma unroll
        for (int j = 0; j < 4; ++j) { const float kd = KS[(size_t)(b * 4 + j) * DH + h * 128 + c * 64 + lane]; const float s = wave_sum(qd * kd); sj[j] = j <= qi ? s + bt[qi - j] : -1e30f; }
        float mp[4], lp[4]; float M = fmaxf(fmaxf(sj[0], sj[1]), fmaxf(sj[2], sj[3]));
#pragma unroll
        for (int sp = 0; sp < 4; ++sp) { const size_t pi = (size_t)((((b * 4 + h) * 4 + sp) * 2 + c) * 4 + qi); mp[sp] = PML[2 * pi]; lp[sp] = PML[2 * pi + 1]; M = fmaxf(M, mp[sp]); }
        float Lsum = 0.f, o0 = 0.f, o1 = 0.f;
#pragma unroll
        for (int sp = 0; sp < 4; ++sp) { const size_t pi = (size_t)((((b * 4 + h) * 4 + sp) * 2 + c) * 4 + qi); const float w = ex2(mp[sp] - M); Lsum += lp[sp] * w;
            const f32x2 po = *(const f32x2*)(PO + pi * 128 + 2 * lane); o0 += po.x * w; o1 += po.y * w; }
#pragma unroll
        for (int j = 0; j < 4; ++j) { const float w = j <= qi ? ex2(sj[j] - M) : 0.f; Lsum += w; const f32x2 vv = *(const f32x2*)(VS + (size_t)(b * 4 + j) * DH + h * 128 + 2 * lane); o0 += vv.x * w; o1 += vv.y * w; }
        const float inv = 1.0f / Lsum; oc[c][0] = o0 * inv; oc[c][1] = o1 * inv;
    }
    const float d0 = oc[0][0] - lam * oc[1][0], d1 = oc[0][1] - lam * oc[1][1];
    const float rs = rsqrtf(wave_sum(d0 * d0 + d1 * d1) * (1.0f / 128.0f) + EPS);
    const size_t row = (size_t)MP + sr;
    const unsigned gw = *(const unsigned*)(GA + row * DH + h * 128 + 2 * lane);
    const f32x2 sg = *(const f32x2*)(subg + 2 * lane);
    *(unsigned*)(A2 + row * DM + h * 128 + 2 * lane) = pkbf(d0 * rs * sg.x * 0.8f * bf_lo(gw), d1 * rs * sg.y * 0.8f * bf_hi(gw));
}
__device__ __forceinline__ void combine_prompt_row(size_t row, const bf16* Op, const bf16* GA, float lam, const f32x4 sg0, const f32x4 sg1, bf16* A2, int lane) {
    const int h = lane >> 4, e0 = 8 * (lane & 15);
    const u32x4 a = *(const u32x4*)(Op + row * DM + h * 256 + e0), bq = *(const u32x4*)(Op + row * DM + h * 256 + 128 + e0), gq = *(const u32x4*)(GA + row * DH + h * 128 + e0);
    float d[8];
    d[0] = bf_lo(a.x) - lam * bf_lo(bq.x); d[1] = bf_hi(a.x) - lam * bf_hi(bq.x); d[2] = bf_lo(a.y) - lam * bf_lo(bq.y); d[3] = bf_hi(a.y) - lam * bf_hi(bq.y);
    d[4] = bf_lo(a.z) - lam * bf_lo(bq.z); d[5] = bf_hi(a.z) - lam * bf_hi(bq.z); d[6] = bf_lo(a.w) - lam * bf_lo(bq.w); d[7] = bf_hi(a.w) - lam * bf_hi(bq.w);
    float ss = 0.f;
#pragma unroll
    for (int e = 0; e < 8; ++e) ss += d[e] * d[e];
    const float rs = rsqrtf(sum16(ss) * (1.0f / 128.0f) + EPS) * 0.8f;
    u32x4 o;
    o.x = pkbf(d[0] * rs * sg0.x * bf_lo(gq.x), d[1] * rs * sg0.y * bf_hi(gq.x)); o.y = pkbf(d[2] * rs * sg0.z * bf_lo(gq.y), d[3] * rs * sg0.w * bf_hi(gq.y));
    o.z = pkbf(d[4] * rs * sg1.x * bf_lo(gq.z), d[5] * rs * sg1.y * bf_hi(gq.z)); o.w = pkbf(d[6] * rs * sg1.z * bf_lo(gq.w), d[7] * rs * sg1.w * bf_hi(gq.w));
    *(u32x4*)(A2 + row * DM + h * 128 + e0) = o;
}

__device__ __forceinline__ const void* ldsarg(LAS unsigned char* L, int i) {
    const LAS unsigned* p = (const LAS unsigned*)(L + LDSCTL_OFF) + 2 * i;
    const unsigned lo = __builtin_amdgcn_readfirstlane(p[0]), hi = __builtin_amdgcn_readfirstlane(p[1]);
    return (const void*)(((unsigned long long)hi << 32) | lo);
}
constexpr int RED_ROW = 68;
template <int K> __device__ __forceinline__ f32x4 coop_tile(const bf16* W0, const bf16* W1, const bf16* X, LAS float* red, int wave, int lane) {
    constexpr int KS = K / 8, NI = KS / 64;
    const int r = lane & 31, hh = lane >> 5;
    const bf16* wa = W0 + (size_t)r * K + wave * KS + 8 * hh; const bf16* wb = W1 + (size_t)r * K + wave * KS + 8 * hh; const bf16* xa = X + (size_t)r * K + wave * KS + 8 * hh;
    bf16x8 a0[NI][4], a1[NI][4], bb[NI][4];
#pragma unroll
    for (int i = 0; i < NI; ++i)
#pragma unroll
        for (int s = 0; s < 4; ++s) { a0[i][s] = *(const bf16x8*)(wa + i * 64 + 16 * s); a1[i][s] = *(const bf16x8*)(wb + i * 64 + 16 * s); bb[i][s] = *(const bf16x8*)(xa + i * 64 + 16 * s); }
    __builtin_amdgcn_sched_barrier(0);
    f32x16 D0 = {}, D1 = {};
#pragma unroll
    for (int i = 0; i < NI; ++i)
#pragma unroll
        for (int s = 0; s < 4; ++s) { D0 = __builtin_amdgcn_mfma_f32_32x32x16_bf16(a0[i][s], bb[i][s], D0, 0, 0, 0); D1 = __builtin_amdgcn_mfma_f32_32x32x16_bf16(a1[i][s], bb[i][s], D1, 0, 0, 0); }
    LAS float* mine = red + (wave * 32 + r) * RED_ROW + 4 * hh;
#pragma unroll
    for (int q4 = 0; q4 < 4; ++q4) {
        *(LAS f32x4*)(mine + 8 * q4) = (f32x4){D0[4 * q4], D0[4 * q4 + 1], D0[4 * q4 + 2], D0[4 * q4 + 3]};
        *(LAS f32x4*)(mine + 32 + 8 * q4) = (f32x4){D1[4 * q4], D1[4 * q4 + 1], D1[4 * q4 + 2], D1[4 * q4 + 3]};
    }
    __syncthreads();
    const int token = (wave * 64 + lane) >> 4, col4 = lane & 15;
    f32x4 acc = {0.f, 0.f, 0.f, 0.f};
#pragma unroll
    for (int w = 0; w < 8; ++w) acc = acc + *(const LAS f32x4*)(red + (w * 32 + token) * RED_ROW + 4 * col4);
    __syncthreads();
    return acc;
}
__device__ __forceinline__ void sample_inproj_tile(int j, int mb, const bf16* WinT, const bf16* XN, const float* qg, const float* kg, float* QS, float* KS, float* VS, bf16* GA, bf16* U, bf16* GS, float* out, int wmask,
                                                   LAS float* red, int wave, int lane) {
    const int n0 = 64 * j, pn = n0 >> 8, wc = (n0 & 255) >> 6, R0 = 256 * pn + 32 * wc;
    f32x4 v = coop_tile<DM>(WinT + (size_t)R0 * DM, WinT + (size_t)(R0 + 128) * DM, XN + (size_t)(MP + 32 * mb) * DM, red, wave, lane);
    const int kind = j >> 3, srow = 32 * mb + ((wave * 64 + lane) >> 4), d = 4 * (lane & 15);
    const size_t o = (size_t)srow * DH + 64 * (j & 7) + d;
    if (kind <= 1) {
        const float ss = sum16((v.x * v.x + v.y * v.y) + (v.z * v.z + v.w * v.w));
        const float rs = rsqrtf(ss * (1.0f / 64.0f) + EPS) * (kind == 0 ? C2 : 1.0f);
        const f32x4 g = *(const f32x4*)((kind == 0 ? qg : kg) + d);
        v = v * rs * g;
        if (kind == 0) *(f32x4*)(QS + o) = v;
        else { *(f32x4*)(KS + o) = v; if (wmask & 1) *(f32x4*)(out + O_KS + o) = v; }
    } else if (kind == 2) { *(f32x4*)(VS + o) = v; if (wmask & 1) *(f32x4*)(out + O_VS + o) = v; }
    else {
        if (kind != 4) { v.x = pg8::silu_f(v.x); v.y = pg8::silu_f(v.y); v.z = pg8::silu_f(v.z); v.w = pg8::silu_f(v.w); }
        bf16* dst = kind == 3 ? GA : (kind == 4 ? U : GS);
        u32x2 w; w.x = pkbf(v.x, v.y); w.y = pkbf(v.z, v.w);
        *(u32x2*)(dst + (size_t)MP * DH + o) = w;
    }
}
__device__ __forceinline__ void sample_glu_tile(int j, int mb, const bf16* WgluT, const bf16* Z, const bf16* GS, const float* bglu, bf16* A2, LAS float* red, int wave, int lane) {
    const f32x4 v = coop_tile<DH>(WgluT + (size_t)(64 * j) * DH, WgluT + (size_t)(64 * j + 32) * DH, Z + (size_t)(MP + 32 * mb) * DH, red, wave, lane);
    const size_t row = (size_t)MP + 32 * mb + ((wave * 64 + lane) >> 4); const int col = 64 * j + 4 * (lane & 15);
    const f32x4 bv = *(const f32x4*)(bglu + col);
    const u32x2 zz = *(const u32x2*)(Z + row * DH + col), gg = *(const u32x2*)(GS + row * DH + col);
    const float o0 = bf_lo(zz.x) * pg8::sigmoid_f(v.x + bv.x) * bf_lo(gg.x), o1 = bf_hi(zz.x) * pg8::sigmoid_f(v.y + bv.y) * bf_hi(gg.x);
    const float o2 = bf_lo(zz.y) * pg8::sigmoid_f(v.z + bv.z) * bf_lo(gg.y), o3 = bf_hi(zz.y) * pg8::sigmoid_f(v.w + bv.w) * bf_hi(gg.y);
    u32x2 w; w.x = pkbf(o0, o1); w.y = pkbf(o2, o3);
    *(u32x2*)(A2 + row * DM + DH + col) = w;
}
__device__ __forceinline__ void sample_out_tile(int j, int mb, const bf16* WoutT, const bf16* A2, const float* xs, float* out, int wmask, LAS float* red, int wave, int lane) {
    const f32x4 v = coop_tile<DM>(WoutT + (size_t)(64 * j) * DM, WoutT + (size_t)(64 * j + 32) * DM, A2 + (size_t)(MP + 32 * mb) * DM, red, wave, lane);
    if (!(wmask & 8)) return;
    const size_t srow = (size_t)32 * mb + ((wave * 64 + lane) >> 4); const int col = 64 * j + 4 * (lane & 15);
    const f32x4 xv = *(const f32x4*)(xs + srow * DM + col);
    *(f32x4*)(out + O_YS + srow * DM + col) = xv + v;
}

__device__ __forceinline__ int opaque_lane() { int l = threadIdx.x & 63; asm volatile("" : "+v"(l)); return l; }
__device__ __forceinline__ unsigned char* opaque_ptr(unsigned char* p) { GAS unsigned char* g = (GAS unsigned char*)p; asm volatile("" : "+s"(g)); return (unsigned char*)g; }
#ifndef PROBE_SEG
#define PROBE_SEG 0
#endif
#define SEG_BEGIN(id) unsigned long long seg_t0_##id = 0; if (PROBE_SEG == (id)) { __syncthreads(); seg_t0_##id = __builtin_amdgcn_s_memrealtime(); }
#define SEG_END(id) if (PROBE_SEG == (id)) { __syncthreads(); const unsigned long long t1_ = __builtin_amdgcn_s_memrealtime(), d_ = 4ull * (t1_ - seg_t0_##id); while (__builtin_amdgcn_s_memrealtime() - t1_ < d_) __builtin_amdgcn_s_sleep(8); __syncthreads(); }
struct Args { const void* in[28]; float* out; unsigned char* ws; int wmask; int pad; };

__global__ void __launch_bounds__(NWAVES * 64, 2) hymba_fwd(Args args) {
    extern __shared__ __attribute__((aligned(16))) unsigned char lds[];
    LAS unsigned char* const L = (LAS unsigned char*)lds;
    volatile LAS unsigned* const MISC = (volatile LAS unsigned*)(L + MISC_OFF);
    const int tid = threadIdx.x, lane = tid & 63, wave = __builtin_amdgcn_readfirstlane(tid >> 6);
    const int G = gridDim.x; const int bx = blockIdx.x; const int vcu = (G % 8 == 0) ? (bx % 8) * (G / 8) + bx / 8 : bx;
    const int gw = vcu * NWAVES + wave, NGW = G * NWAVES;
    for (int u = tid; u < (LDS_BYTES - LDSCTL_OFF) / 4; u += NWAVES * 64) ((LAS unsigned*)(L + LDSCTL_OFF))[u] = 0u;
    __syncthreads();
#define LARG(i) (args.in[(i)])
#define IN_F(i) ((const float*)LARG(i))
#define WS_PTR opaque_ptr(args.ws)
#define OUT_PTR (args.out)
    XcdBarrier bar = xcd_barrier_post((unsigned*)((gu32*)(WS_PTR + WS_CTL) + CW_BAR), MISC + 8);

    {
        unsigned char* const ws = WS_PTR; unsigned char* const tab = ws + WS_TAB; float* const TAB = (float*)tab;
        const float* x_prompt = IN_F(0); const float* x_sample = IN_F(1); const float* norm_g = IN_F(7); const float* w_in = IN_F(8);
        const float* lq1 = IN_F(11); const float* lk1 = IN_F(12); const float* lq2 = IN_F(13); const float* lk2 = IN_F(14); const float* rel_bias = IN_F(16);
        const float* a_re = IN_F(17); const float* a_im = IN_F(18); const float* log_dt = IN_F(19); const float* b_re = IN_F(20); const float* b_im = IN_F(21); const float* c_re = IN_F(22); const float* c_im = IN_F(23);
        const float* w_glu = IN_F(25); const float* w_out = IN_F(27);
        bf16* const WinT = (bf16*)(ws + WS_WIN); bf16* const WoutT = (bf16*)(ws + WS_WOUT); bf16* const WgluT = (bf16*)(ws + WS_WGLU); bf16* const XN = (bf16*)(ws + WS_XN);
        LAS float* scr = (LAS float*)(L + RING_OFF + wave * 16384);
        SEG_BEGIN(1)
        constexpr int I_IN = (DM / 64) * (NIN / 32), I_OUT = (DM / 64) * (DM / 32), I_GLU = (DH / 64) * (DH / 32);
        constexpr int I_T = I_IN + I_OUT + I_GLU, I_ROWS = I_T + MT, I_ALL = I_ROWS + 2 + 32;
        for (int it = gw; it < I_ALL; it += NGW) {
            int r = it;
            if (r < I_IN) { p0_transpose_item(w_in, DM, NIN, WinT, true, scr, r, lane); continue; } r -= I_IN;
            if (r < I_OUT) { p0_transpose_item(w_out, DM, DM, WoutT, false, scr, r, lane); continue; } r -= I_OUT;
            if (r < I_GLU) { p0_transpose_item(w_glu, DH, DH, WgluT, false, scr, r, lane); continue; } r -= I_GLU;
            if (r < MT) { const float* xr = r < MP ? x_prompt + (size_t)r * DM : x_sample + (size_t)(r - MP) * DM; rms_row_to_bf16(xr, norm_g, XN + (size_t)r * DM, lane); continue; } r -= MT;
            if (r == 0) {
                const float s1 = wave_sum(lq1[lane] * lk1[lane]), s2 = wave_sum(lq2[lane] * lk2[lane]);
                if (lane == 0) TAB[TB_LAM] = expf(s1) - expf(s2) + 0.2f;
            } else if (r == 1) {
                for (int i = lane; i < 512; i += 64) { const int h = i >> 7, d = i & 127; TAB[TB_BIAS + i] = (rel_bias[t5_bucket(d) * 4 + h] - rel_bias[31 * 4 + h]) * LOG2E; }
            } else {
                const int g = r - 2, p = lane;
                const float ar = a_re[g * 64 + p], ai = a_im[g * 64 + p], dt = expf(log_dt[g]);
                const float mag = expf(ar * dt), abr = mag * cosf(ai * dt), abi = mag * sinf(ai * dt);
                const float nr = abr - 1.0f, den = ar * ar + ai * ai;
                const float cfr = (nr * ar + abi * ai) / den, cfi = (abi * ar - nr * ai) / den;
                float pr[4], pi_[4]; pr[0] = abr; pi_[0] = abi;
                pr[1] = abr * abr - abi * abi; pi_[1] = 2.0f * abr * abi;
                pr[2] = pr[1] * abr - pi_[1] * abi; pi_[2] = pr[1] * abi + pi_[1] * abr;
                pr[3] = pr[1] * pr[1] - pi_[1] * pi_[1]; pi_[3] = 2.0f * pr[1] * pi_[1];
                float* tp = (float*)(tab + OFF_TP) + (size_t)(g * 64 + p) * 8;
#pragma unroll
                for (int k = 0; k < 4; ++k) { tp[2 * k] = pr[k]; tp[2 * k + 1] = pi_[k]; }
                float qr = pr[3], qi = pi_[3];
#pragma unroll
                for (int k = 0; k < 6; ++k) { const float t = qr * qr - qi * qi; qi = 2.0f * qr * qi; qr = t; }
                float* ta = (float*)(tab + OFF_TA256) + (size_t)(g * 64 + p) * 2; ta[0] = qr; ta[1] = qi;
                float bbr[16], bbi[16];
#pragma unroll
                for (int c = 0; c < 16; ++c) { const float br = b_re[(g * 64 + p) * 16 + c], bi = b_im[(g * 64 + p) * 16 + c]; bbr[c] = cfr * br - cfi * bi; bbi[c] = cfr * bi + cfi * br; }
                float* tb = (float*)(tab + OFF_TBF) + (size_t)(g * 64 + p) * 32;
#pragma unroll
                for (int c = 0; c < 16; ++c) { tb[c] = bbr[c]; tb[16 + c] = bbi[c]; }
                const int hi = p >> 5, rr = p & 31;
#pragma unroll
                for (int hh = 0; hh < 2; ++hh) {
                    v4u wr_, wi_;
                    wr_.x = pk2(bbr[8 * hh + 0], bbr[8 * hh + 1]); wr_.y = pk2(bbr[8 * hh + 2], bbr[8 * hh + 3]); wr_.z = pk2(bbr[8 * hh + 4], bbr[8 * hh + 5]); wr_.w = pk2(bbr[8 * hh + 6], bbr[8 * hh + 7]);
                    wi_.x = pk2(bbi[8 * hh + 0], bbi[8 * hh + 1]); wi_.y = pk2(bbi[8 * hh + 2], bbi[8 * hh + 3]); wi_.z = pk2(bbi[8 * hh + 4], bbi[8 * hh + 5]); wi_.w = pk2(bbi[8 * hh + 6], bbi[8 * hh + 7]);
                    *(v4u*)(tab + OFF_TBB + ((size_t)(g * 4 + 0 + hi) * 64 + rr + 32 * hh) * 16) = wr_;
                    *(v4u*)(tab + OFF_TBB + ((size_t)(g * 4 + 2 + hi) * 64 + rr + 32 * hh) * 16) = wi_;
                }
                const int cc = lane & 15, kq = lane >> 4;
#pragma unroll
                for (int s = 0; s < 4; ++s) {
                    float v[8];
#pragma unroll
                    for (int j = 0; j < 8; ++j) { const int k = 32 * s + 8 * kq + j, pp = k >> 1; v[j] = (k & 1) ? -c_im[(g * 16 + cc) * 64 + pp] : c_re[(g * 16 + cc) * 64 + pp]; }
                    v4u w; w.x = pk2(v[0], v[1]); w.y = pk2(v[2], v[3]); w.z = pk2(v[4], v[5]); w.w = pk2(v[6], v[7]);
                    *(v4u*)(tab + OFF_TCC + ((size_t)(g * 4 + s) * 64 + lane) * 16) = w;
                }
            }
        }
        SEG_END(1)
    }
    xcd_barrier(bar);

    {
        unsigned char* const ws = WS_PTR; float* const out = OUT_PTR; const int wmask = args.wmask;
        const float* q_norm_g = IN_F(9); const float* k_norm_g = IN_F(10);
        bf16* const WinT = (bf16*)(ws + WS_WIN); bf16* const XN = (bf16*)(ws + WS_XN); bf16* const Qp = (bf16*)(ws + WS_Q); bf16* const Kp = (bf16*)(ws + WS_K); bf16* const Vp = (bf16*)(ws + WS_V);
        bf16* const GA = (bf16*)(ws + WS_GA); bf16* const U = (bf16*)(ws + WS_U); bf16* const GS = (bf16*)(ws + WS_GS);
        float* const QS = (float*)(ws + WS_QS); float* const KS = (float*)(ws + WS_KS); float* const VS = (float*)(ws + WS_VS);
        pg8::Gemm g{XN, WinT, MP, NIN, DM}; pg8::StaticOrder S; S.init(MP, NIN, G, bx);
        pg8::EpiInProj E1{out, Qp, Kp, Vp, GA, U, GS, QS, KS, VS, q_norm_g, k_norm_g, wmask};
        SEG_BEGIN(2)
        pg8::gemm_phase<pg8::EpiInProj, pg8::StaticOrder, true, true>(L + RING_OFF, g, S, E1);
        for (int it = vcu; it < 768; it += G) sample_inproj_tile(it % 48, it / 48, WinT, XN, q_norm_g, k_norm_g, QS, KS, VS, GA, U, GS, out, wmask, (LAS float*)(L + RING_OFF), wave, opaque_lane());
        SEG_END(2)
    }
    xcd_barrier(bar);

    {
        unsigned char* const ws = WS_PTR; unsigned char* const tab = ws + WS_TAB; float* const TAB = (float*)tab;
        bf16* const Qp = (bf16*)(ws + WS_Q); bf16* const Kp = (bf16*)(ws + WS_K); bf16* const Vp = (bf16*)(ws + WS_V);
        LAS float* btab = (LAS float*)(L + RING_OFF + BT_LDS_OFF);
        for (int i = tid; i < 512; i += NWAVES * 64) btab[i] = TAB[TB_BIAS + i];
        __syncthreads();
        const attn_body::AttnTensors AT{(const attn_body::bf16*)Qp, (const attn_body::bf16*)Kp, (const attn_body::bf16*)Vp, (attn_body::bf16*)Qp};
        const attn_body::StaticOrder S((int)G, (int)bx);
        float* const out = OUT_PTR; const int wmask = args.wmask;
        const float* cache_k = IN_F(2); const float* cache_v = IN_F(3); const float* st_re = IN_F(4); const float* st_im = IN_F(5); const int* page_table = (const int*)LARG(6);
        const float* c_re = IN_F(22); const float* c_im = IN_F(23); const float* d_skip = IN_F(24);
        bf16* const U = (bf16*)(ws + WS_U); bf16* const Z = (bf16*)(ws + WS_Z); float* const QS = (float*)(ws + WS_QS);
        float* const E = (float*)(ws + WS_E); float* const PO = (float*)(ws + WS_PART); float* const PML = (float*)(ws + WS_PML);
        const int kslot = vcu % 5;
        for (int i = 0; i < 5; ++i) {
            if (i == kslot) {
                SEG_BEGIN(4)
                for (int it = gw; it < 2048; it += NGW) {
                    const int wg = it >> 3, wv = it & 7, b = wg >> 1, h = wv & 3, sp = (wg & 1) * 2 + (wv >> 2);
                    decode_item(b, h, sp, QS, cache_k, cache_v, page_table, TAB + TB_BIAS + h * 128, PO, PML, lane);
                }
                SEG_END(4)
            }
            attn_body::AttnUnit au;
            SEG_BEGIN(3)
            if (S.next(i, au)) attn_body::attn_unit<8>(au.bh / attn_body::NHEAD, au.bh % attn_body::NHEAD, au.qb, AT.Q, AT.K, AT.V, AT.O, (char*)lds + RING_OFF, (attn_body::lds_cfp)btab);
            SEG_END(3)
        }
        SEG_BEGIN(5)
        for (int it = gw; it < 4096; it += NGW) ssm_sample_item(it >> 5, it & 31, tab, U, st_re, st_im, c_re, c_im, d_skip, Z, out, wmask, lane);
        for (int it = gw; it < 2048; it += NGW) ssm_chunk<false>(it >> 10, (it >> 5) & 31, it & 31, tab, U, E, d_skip, Z, out, wmask, (LAS unsigned*)nullptr, lane);
        SEG_END(5)
    }
    xcd_barrier(bar);

    {
        unsigned char* const ws = WS_PTR; unsigned char* const tab = ws + WS_TAB; float* const TAB = (float*)tab; float* const out = OUT_PTR; const int wmask = args.wmask;
        const float* subln_g = IN_F(15); const float* d_skip = IN_F(24);
        bf16* const Qp = (bf16*)(ws + WS_Q); bf16* const GA = (bf16*)(ws + WS_GA); bf16* const U = (bf16*)(ws + WS_U); bf16* const Z = (bf16*)(ws + WS_Z); bf16* const A2 = (bf16*)(ws + WS_A2);
        float* const QS = (float*)(ws + WS_QS); float* const KS = (float*)(ws + WS_KS); float* const VS = (float*)(ws + WS_VS);
        float* const E = (float*)(ws + WS_E); float* const PO = (float*)(ws + WS_PART); float* const PML = (float*)(ws + WS_PML);
        SEG_BEGIN(6)
        const float lam = TAB[TB_LAM];
        LAS unsigned* Hs = (LAS unsigned*)(L + RING_OFF + wave * 16384);
        for (int it = gw; it < 2048; it += NGW) ssm_chunk<true>(it >> 10, (it >> 5) & 31, it & 31, tab, U, E, d_skip, Z, out, wmask, Hs, lane);
        const f32x4 sg0 = *(const f32x4*)(subln_g + 8 * (lane & 15)), sg1 = *(const f32x4*)(subln_g + 8 * (lane & 15) + 4);
        for (int row = gw; row < MP; row += NGW) combine_prompt_row((size_t)row, Qp, GA, lam, sg0, sg1, A2, lane);
        for (int it = gw; it < 2048; it += NGW) combine_sample(it >> 2, it & 3, QS, KS, VS, PO, PML, TAB + TB_BIAS + (it & 3) * 128, lam, subln_g, GA, A2, lane);
        SEG_END(6)
    }
    xcd_barrier(bar);

    {
        unsigned char* const ws = WS_PTR; const float* b_glu = IN_F(26);
        bf16* const WgluT = (bf16*)(ws + WS_WGLU); bf16* const GS = (bf16*)(ws + WS_GS); bf16* const Z = (bf16*)(ws + WS_Z); bf16* const A2 = (bf16*)(ws + WS_A2);
        pg8::Gemm g{Z, WgluT, MP, DH, DH}; pg8::StaticOrder S; S.init(MP, DH, G, bx);
        pg8::EpiGlu E4{Z, GS, b_glu, A2};
        SEG_BEGIN(7)
        pg8::gemm_phase<pg8::EpiGlu, pg8::StaticOrder, true, true>(L + RING_OFF, g, S, E4);
        if (bx >= 128) { for (int it = bx - 128; it < 128; it += G - 128) sample_glu_tile(it & 7, it >> 3, WgluT, Z, GS, b_glu, A2, (LAS float*)(L + RING_OFF), wave, opaque_lane()); }
        SEG_END(7)
    }
    xcd_barrier(bar);

    {
        unsigned char* const ws = WS_PTR; float* const out = OUT_PTR; const int wmask = args.wmask;
        const float* x_prompt = IN_F(0); const float* x_sample = IN_F(1);
        bf16* const WoutT = (bf16*)(ws + WS_WOUT); bf16* const A2 = (bf16*)(ws + WS_A2);
        pg8::Gemm g{A2, WoutT, MP, DM, DM}; pg8::StaticOrder S; S.init(MP, DM, G, bx);
        pg8::EpiOut E5{x_prompt, x_sample, out, wmask};
        SEG_BEGIN(8)
        pg8::gemm_phase<pg8::EpiOut, pg8::StaticOrder, true, true>(L + RING_OFF, g, S, E5);
        for (int it = vcu; it < 256; it += G) sample_out_tile(it & 15, it >> 4, WoutT, A2, x_sample, out, wmask, (LAS float*)(L + RING_OFF), wave, opaque_lane());
        SEG_END(8)
    }
}

#ifndef MODE
#define MODE 1
#endif
#ifndef WMASK
#define WMASK 31
#endif
#if MODE != 1
#ifndef NV_STOP
#define NV_STOP 99
#endif
namespace nv {
constexpr size_t NV_BASE = 320ull << 20;
constexpr size_t NV_XN = NV_BASE, NV_H = NV_XN + (size_t)MT * DM * 4, NV_Q = NV_H + (size_t)MT * NIN * 4, NV_K = NV_Q + (size_t)MT * DH * 4, NV_V = NV_K + (size_t)MT * DH * 4,
                 NV_O = NV_V + (size_t)MT * DH * 4, NV_Y = NV_O + (size_t)MT * DM * 4, NV_Z = NV_Y + (size_t)MT * DH * 4, NV_T = NV_Z + (size_t)MT * DH * 4, NV_A2 = NV_T + (size_t)MT * DH * 4,
                 NV_END = NV_A2 + (size_t)MT * DM * 4;
__device__ __forceinline__ float wsum(float v) {
#pragma unroll
    for (int o = 1; o < 64; o <<= 1) v += __shfl_xor(v, o);
    return v;
}
__device__ __forceinline__ float wmax(float v) {
#pragma unroll
    for (int o = 1; o < 64; o <<= 1) v = fmaxf(v, __shfl_xor(v, o));
    return v;
}
__device__ __forceinline__ int bucket(int n) {
    if (n < 16) return n;
    int b = 16;
    b += (n >= 19); b += (n >= 21); b += (n >= 24); b += (n >= 27); b += (n >= 31); b += (n >= 35); b += (n >= 40); b += (n >= 46);
    b += (n >= 52); b += (n >= 59); b += (n >= 67); b += (n >= 77); b += (n >= 87); b += (n >= 99); b += (n >= 113);
    return b;
}
__global__ void k_rms(const float* xp, const float* xs, const float* g, float* XN) {
    const int row = blockIdx.x, lane = threadIdx.x;
    const float* x = row < MP ? xp + (size_t)row * DM : xs + (size_t)(row - MP) * DM;
    float s = 0.f;
    for (int i = lane; i < DM; i += 64) s += x[i] * x[i];
    const float rs = rsqrtf(wsum(s) / DM + EPS);
    for (int i = lane; i < DM; i += 64) XN[(size_t)row * DM + i] = x[i] * rs * g[i];
}
__global__ void k_gemm(const float* A, const float* B, float* C, const float* R, int M, int N, int K) {
    __shared__ float As[16][65], Bs[16][65];
    const int tx = threadIdx.x & 15, ty = threadIdx.x >> 4, m0 = blockIdx.y * 64, n0 = blockIdx.x * 64;
    float acc[4][4] = {};
    for (int k0 = 0; k0 < K; k0 += 16) {
        for (int i = threadIdx.x; i < 1024; i += 256) { const int r = i >> 4, c = i & 15; As[c][r] = A[(size_t)(m0 + r) * K + k0 + c]; }
        for (int i = threadIdx.x; i < 1024; i += 256) { const int r = i >> 6, c = i & 63; Bs[r][c] = B[(size_t)(k0 + r) * N + n0 + c]; }
        __syncthreads();
#pragma unroll
        for (int k = 0; k < 16; ++k) {
            float a[4], b[4];
#pragma unroll
            for (int i = 0; i < 4; ++i) { a[i] = As[k][ty * 4 + i]; b[i] = Bs[k][tx * 4 + i]; }
#pragma unroll
            for (int i = 0; i < 4; ++i)
#pragma unroll
                for (int j = 0; j < 4; ++j) acc[i][j] += a[i] * b[j];
        }
        __syncthreads();
    }
    for (int i = 0; i < 4; ++i)
        for (int j = 0; j < 4; ++j) { const size_t o = (size_t)(m0 + ty * 4 + i) * N + n0 + tx * 4 + j; C[o] = acc[i][j] + (R ? R[o] : 0.f); }
}
__global__ void k_post(const float* H, const float* qg, const float* kg, float* Q, float* Kn, float* Vn, float* out) {
    const int row = blockIdx.x / 24, j = blockIdx.x % 24, d = threadIdx.x;
    const float v = H[(size_t)row * NIN + j * 64 + d];
    if (j < 16) {
        const float rs = rsqrtf(wsum(v * v) / 64.f + EPS);
        if (j < 8) Q[(size_t)row * DH + j * 64 + d] = v * rs * qg[d] * 0.125f;
        else { const float k = v * rs * kg[d]; const int c = (j - 8) * 64 + d; Kn[(size_t)row * DH + c] = k;
               if (row < MP) out[O_KP + (size_t)row * DH + c] = k; else out[O_KS + (size_t)(row - MP) * DH + c] = k; }
    } else { const int c = (j - 16) * 64 + d; Vn[(size_t)row * DH + c] = v;
             if (row < MP) out[O_VP + (size_t)row * DH + c] = v; else out[O_VS + (size_t)(row - MP) * DH + c] = v; }
}
__global__ void k_attn(const float* Q, const float* Kn, const float* Vn, const float* ck, const float* cv, const int* pt, const float* rel_bias, float* O) {
    const int id = blockIdx.x, row = id >> 3, h = (id >> 1) & 3, c = id & 1, lane = threadIdx.x;
    float q[64];
#pragma unroll
    for (int d = 0; d < 64; ++d) q[d] = Q[(size_t)row * DH + h * 128 + c * 64 + d];
    int nkeys, qpos, b;
    const bool samp = row >= MP;
    if (!samp) { b = row / SEQ; qpos = row % SEQ; nkeys = qpos + 1; }
    else { b = (row - MP) >> 2; qpos = PAST + ((row - MP) & 3); nkeys = qpos + 1; }
    float m = -1e30f, l = 0.f, o0 = 0.f, o1 = 0.f;
    for (int t0 = 0; t0 < nkeys; t0 += 64) {
        const int kk = t0 + lane; const bool valid = kk < nkeys;
        const float* kp;
        if (!samp) kp = Kn + (size_t)(b * SEQ + (valid ? kk : 0)) * DH + h * 128 + c * 64;
        else if (kk < PAST) { const int pg = pt[b * NPAGES + (kk >> 7)]; kp = ck + ((size_t)(pg * PAGE + (kk & 127)) * 4 + h) * 128 + c * 64; }
        else kp = Kn + (size_t)(MP + b * 4 + (valid ? kk - PAST : 0)) * DH + h * 128 + c * 64;
        float s = 0.f;
#pragma unroll
        for (int d = 0; d < 64; ++d) s += q[d] * kp[d];
        s += rel_bias[bucket(valid ? qpos - kk : 0) * 4 + h];
        if (!valid) s = -1e30f;
        const float mn = fmaxf(m, wmax(s)), alpha = expf(m - mn), p = valid ? expf(s - mn) : 0.f;
        l = l * alpha + wsum(p); o0 *= alpha; o1 *= alpha; m = mn;
        const int cnt = min(64, nkeys - t0);
        for (int j = 0; j < cnt; ++j) {
            const float pj = __shfl(p, j); const int kj = t0 + j;
            const float* vp;
            if (!samp) vp = Vn + (size_t)(b * SEQ + kj) * DH + h * 128;
            else if (kj < PAST) { const int pg = pt[b * NPAGES + (kj >> 7)]; vp = cv + ((size_t)(pg * PAGE + (kj & 127)) * 4 + h) * 128; }
            else vp = Vn + (size_t)(MP + b * 4 + kj - PAST) * DH + h * 128;
            o0 += pj * vp[lane]; o1 += pj * vp[lane + 64];
        }
    }
    float* op = O + (size_t)row * DM + (h * 2 + c) * 128;
    op[lane] = o0 / l; op[lane + 64] = o1 / l;
}
__global__ void k_ssm(const float* H, int row0, int L, const float* h0re, const float* h0im, const float* are, const float* aim, const float* ldt,
                      const float* bre, const float* bim, const float* cre, const float* cim, const float* dsk, float* Y, float* ore, float* oim) {
    const int b = blockIdx.x >> 5, g = blockIdx.x & 31, p = threadIdx.x;
    const float ar = are[g * 64 + p], ai = aim[g * 64 + p], dt = expf(ldt[g]);
    const float mag = expf(ar * dt), abr = mag * cosf(ai * dt), abi = mag * sinf(ai * dt);
    const float nr = abr - 1.0f, den = ar * ar + ai * ai;
    const float cfr = (nr * ar + abi * ai) / den, cfi = (abi * ar - nr * ai) / den;
    float bbr[16], bbi[16], cr[16], ci[16];
#pragma unroll
    for (int c = 0; c < 16; ++c) { const float br = bre[(g * 64 + p) * 16 + c], bi = bim[(g * 64 + p) * 16 + c];
        bbr[c] = cfr * br - cfi * bi; bbi[c] = cfr * bi + cfi * br; cr[c] = cre[(g * 16 + c) * 64 + p]; ci[c] = cim[(g * 16 + c) * 64 + p]; }
    float hr = h0re ? h0re[(b * 32 + g) * 64 + p] : 0.f, hi = h0im ? h0im[(b * 32 + g) * 64 + p] : 0.f;
    for (int t = 0; t < L; ++t) {
        const size_t row = (size_t)row0 + (size_t)b * L + t;
        const float* u = H + row * NIN + 2048 + g * 16;
        float ur = 0.f, ui = 0.f;
#pragma unroll
        for (int c = 0; c < 16; ++c) { ur += bbr[c] * u[c]; ui += bbi[c] * u[c]; }
        const float nhr = abr * hr - abi * hi + ur, nhi = abr * hi + abi * hr + ui; hr = nhr; hi = nhi;
        float yv = 0.f;
#pragma unroll
        for (int c = 0; c < 16; ++c) { const float s = wsum(cr[c] * hr - ci[c] * hi); if (p == c) yv = s; }
        if (p < 16) Y[row * DH + g * 16 + p] = yv + dsk[g * 16 + p] * u[p];
    }
    ore[(b * 32 + g) * 64 + p] = hr; oim[(b * 32 + g) * 64 + p] = hi;
}
__device__ __forceinline__ float gelu_tanh(float x) { return 0.5f * x * (1.0f + tanhf(0.7978845608028654f * (x + 0.044715f * x * x * x))); }
__device__ __forceinline__ float silu(float x) { return x / (1.0f + expf(-x)); }
__global__ void k_fin1(const float* O, const float* H, const float* Y, const float* lq1, const float* lk1, const float* lq2, const float* lk2, const float* subg, float* A2, float* Z) {
    const int row = blockIdx.x, lane = threadIdx.x;
    const float lam = expf(wsum(lq1[lane] * lk1[lane])) - expf(wsum(lq2[lane] * lk2[lane])) + 0.2f;
    for (int h = 0; h < 4; ++h) {
        const float* o1 = O + (size_t)row * DM + (h * 2) * 128; const float* o2 = o1 + 128;
        const float a = o1[lane] - lam * o2[lane], bb = o1[lane + 64] - lam * o2[lane + 64];
        const float rs = rsqrtf(wsum(a * a + bb * bb) / 128.f + EPS);
        const float* ga = H + (size_t)row * NIN + 1536 + h * 128;
        A2[(size_t)row * DM + h * 128 + lane] = a * rs * subg[lane] * 0.8f * silu(ga[lane]);
        A2[(size_t)row * DM + h * 128 + lane + 64] = bb * rs * subg[lane + 64] * 0.8f * silu(ga[lane + 64]);
    }
    for (int i = lane; i < DH; i += 64) Z[(size_t)row * DH + i] = gelu_tanh(Y[(size_t)row * DH + i]);
}
__global__ void k_fin2(const float* Z, const float* T, const float* bglu, const float* H, float* A2) {
    const size_t i = (size_t)blockIdx.x * 256 + threadIdx.x; const size_t row = i / DH; const int j = (int)(i % DH);
    A2[row * DM + 512 + j] = Z[i] / (1.0f + expf(-(T[i] + bglu[j]))) * silu(H[row * NIN + 2560 + j]);
}
static void launch(void* const* d_in, float* out, unsigned char* ws, hipStream_t st) {
    const float* xp = (const float*)d_in[0]; const float* xs = (const float*)d_in[1];
    float *XN = (float*)(ws + NV_XN), *H = (float*)(ws + NV_H), *Q = (float*)(ws + NV_Q), *Kn = (float*)(ws + NV_K), *Vn = (float*)(ws + NV_V), *O = (float*)(ws + NV_O),
          *Y = (float*)(ws + NV_Y), *Z = (float*)(ws + NV_Z), *T = (float*)(ws + NV_T), *A2 = (float*)(ws + NV_A2);
#if NV_STOP >= 1
    k_rms<<<MT, 64, 0, st>>>(xp, xs, (const float*)d_in[7], XN);
#endif
#if NV_STOP >= 2
    k_gemm<<<dim3(NIN / 64, MT / 64), 256, 0, st>>>(XN, (const float*)d_in[8], H, nullptr, MT, NIN, DM);
#endif
#if NV_STOP >= 3
    k_post<<<MT * 24, 64, 0, st>>>(H, (const float*)d_in[9], (const float*)d_in[10], Q, Kn, Vn, out);
#endif
#if NV_STOP >= 4
    k_attn<<<MT * 8, 64, 0, st>>>(Q, Kn, Vn, (const float*)d_in[2], (const float*)d_in[3], (const int*)d_in[6], (const float*)d_in[16], O);
#endif
#if NV_STOP >= 5
    k_ssm<<<NB * 32, 64, 0, st>>>(H, 0, SEQ, nullptr, nullptr, (const float*)d_in[17], (const float*)d_in[18], (const float*)d_in[19], (const float*)d_in[20], (const float*)d_in[21],
                                 (const float*)d_in[22], (const float*)d_in[23], (const float*)d_in[24], Y, out + O_SRP, out + O_SIP);
#endif
#if NV_STOP >= 6
    k_ssm<<<128 * 32, 64, 0, st>>>(H, MP, 4, (const float*)d_in[4], (const float*)d_in[5], (const float*)d_in[17], (const float*)d_in[18], (const float*)d_in[19], (const float*)d_in[20], (const float*)d_in[21],
                                  (const float*)d_in[22], (const float*)d_in[23], (const float*)d_in[24], Y, out + O_SRS, out + O_SIS);
#endif
#if NV_STOP >= 7
    k_fin1<<<MT, 64, 0, st>>>(O, H, Y, (const float*)d_in[11], (const float*)d_in[12], (const float*)d_in[13], (const float*)d_in[14], (const float*)d_in[15], A2, Z);
#endif
#if NV_STOP >= 8
    k_gemm<<<dim3(DH / 64, MT / 64), 256, 0, st>>>(Z, (const float*)d_in[25], T, nullptr, MT, DH, DH);
#endif
#if NV_STOP >= 9
    k_fin2<<<MT * DH / 256, 256, 0, st>>>(Z, T, (const float*)d_in[26], H, A2);
#endif
#if NV_STOP >= 10
    k_gemm<<<dim3(DM / 64, MP / 64), 256, 0, st>>>(A2, (const float*)d_in[27], out + O_YP, xp, MP, DM, DM);
#endif
#if NV_STOP >= 11
    k_gemm<<<dim3(DM / 64, MS / 64), 256, 0, st>>>(A2 + (size_t)MP * DM, (const float*)d_in[27], out + O_YS, xs, MS, DM, DM);
#endif
}
}
#endif

extern "C" void kernel_launch(void* const* d_in, const int* in_sizes, int n_in, void* d_out, int out_size, void* d_ws, size_t ws_size, hipStream_t stream) {
    static int grid = 0;
    if (grid == 0) {
        if (n_in != 28 || out_size != (int)O_END || ws_size < (size_t)(1024ull << 20)) { fprintf(stderr, "kernel_launch: unexpected shapes (n_in %d out %d ws %zu)\n", n_in, out_size, ws_size); grid = -1; return; }
        int dev = 0, cus = 0, per_cu = 0;
        if (hipGetDevice(&dev) != hipSuccess || hipDeviceGetAttribute(&cus, hipDeviceAttributeMultiprocessorCount, dev) != hipSuccess) { grid = -1; return; }
        if (hipFuncSetAttribute((const void*)hymba_fwd, hipFuncAttributeMaxDynamicSharedMemorySize, LDS_BYTES) != hipSuccess) { fprintf(stderr, "kernel_launch: hipFuncSetAttribute failed\n"); grid = -1; return; }
        if (hipOccupancyMaxActiveBlocksPerMultiprocessor(&per_cu, (const void*)hymba_fwd, NWAVES * 64, LDS_BYTES) != hipSuccess || per_cu < 1)
            fprintf(stderr, "kernel_launch: occupancy query reports %d workgroups per CU\n", per_cu);
        (void)hipGetLastError();
        grid = cus;
    }
    if (grid < 0) return;
#if MODE != 1
    nv::launch(d_in, (float*)d_out, (unsigned char*)d_ws, stream);
#endif
#if MODE == 0
    return;
#endif
    if (hipMemsetAsync((char*)d_ws + WS_CTL, 0, CTL_ZERO_BYTES, stream) != hipSuccess) return;
    Args a{};
    for (int i = 0; i < 28; ++i) a.in[i] = d_in[i];
    a.out = (float*)d_out; a.ws = (unsigned char*)d_ws; a.wmask = (MODE == 1) ? 31 : WMASK;
    hipLaunchKernelGGL(hymba_fwd, dim3(grid), dim3(NWAVES * 64), LDS_BYTES, stream, a);
}
```

```cpp
#include <hip/hip_runtime.h>
#include <hip/hip_bf16.h>
#include <cstdio>
#include <cstdint>
#include <cmath>

constexpr int DM = 1024, SEQ = 8192, NB = 2, MP = NB * SEQ, MS = 512, MT = MP + MS;
constexpr int NIN = 3072, DH = 512;
constexpr int NPAGES = 16, PAGE = 128, PAST = 2048;
constexpr float EPS = 1e-6f, LOG2E = 1.4426950408889634f;
constexpr float C2 = 0.125f * LOG2E;
constexpr size_t O_YP = 0, O_YS = 16777216, O_KP = 17301504, O_VP = 25690112, O_KS = 34078720, O_VS = 34340864,
                 O_SRP = 34603008, O_SIP = 34607104, O_SRS = 34611200, O_SIS = 34873344, O_END = 35135488;

namespace pg8 {
#define PG8_LAS __attribute__((address_space(3)))
typedef unsigned short bf16_t;
typedef short bf16x8 __attribute__((ext_vector_type(8)));
typedef float f32x4 __attribute__((ext_vector_type(4)));
typedef unsigned u32x4 __attribute__((ext_vector_type(4)));
constexpr int BM = 256, BK = 64, HALF = 128, HTB = HALF * BK * 2  , STAGE_BYTES = 8 * HTB, NXCD = 8, WGM = 8;

__host__ __device__ __forceinline__ int lds_byte(int r, int c) { const int st = (r >> 4) * 2 + (c >> 5), rr = r & 15, cc = c & 31, ob = rr * 64 + cc * 2; return st * 1024 + (ob ^ (((ob >> 9) & 1) << 5)); }
__host__ __device__ __forceinline__ void stage_rc(int b, int& R, int& C) { const int st = b / 1024, sb = b % 1024, swz = sb ^ (((sb >> 9) & 1) << 5); R = (st >> 1) * 16 + swz / 64; C = (st & 1) * 32 + (swz % 64) / 2; }
__host__ __device__ __forceinline__ int perm32(int rho) { const int n = rho >> 4, i = rho & 15; return 8 * (i >> 2) + 4 * n + (i & 3); }

struct Unit { int pm, pn; };
struct Gemm { const bf16_t* A; const bf16_t* Bt; int M, N, K; };

struct StaticOrder {
    int nM, nN, nwg, G, c;
    __host__ __device__ void init(int M, int N, int G_, int c_) { nM = M / BM; nN = N / BM; nwg = nM * nN; G = G_; c = c_; }
    __host__ __device__ bool next(int i, Unit& u) const {
        const long L = (long)i * G + c; if (L >= nwg) return false;
        int wgid = (int)L; { const int q = nwg / NXCD, r = nwg % NXCD, xcd = wgid % NXCD, off = wgid / NXCD; wgid = (xcd < r ? xcd * (q + 1) : r * (q + 1) + (xcd - r) * q) + off; }
        const int nig = WGM * nN, gid = wgid / nig, fm = gid * WGM, gsz = (nM - fm) < WGM ? (nM - fm) : WGM;
        u.pm = fm + ((wgid % nig) % gsz); u.pn = (wgid % nig) / gsz; return true;
    }
    __device__ __forceinline__ void a_ready(const Unit&) const {}
    __device__ __forceinline__ void done(const Unit&) const {}
};
__device__ __forceinline__ unsigned cvt_pk_bf16(float lo, float hi) { unsigned r; asm volatile("v_cvt_pk_bf16_f32 %0, %1, %2" : "=v"(r) : "v"(lo), "v"(hi)); return r; }
typedef float f32x2 __attribute__((ext_vector_type(2)));

__device__ __forceinline__ float silu_f(float x) { return x * __builtin_amdgcn_rcpf(1.0f + __expf(-x)); }
__device__ __forceinline__ float sigmoid_f(float x) { return __builtin_amdgcn_rcpf(1.0f + __expf(-x)); }
__device__ __forceinline__ u32x4 pack8(const f32x4 a, const f32x4 b) { u32x4 w; w.x = cvt_pk_bf16(a[0], a[1]); w.y = cvt_pk_bf16(a[2], a[3]); w.z = cvt_pk_bf16(b[0], b[1]); w.w = cvt_pk_bf16(b[2], b[3]); return w; }

struct EpiInProj {
    static constexpr bool PERM = true, AFTER_DRAIN = false;
    float* out; bf16_t *Qp, *Kp, *Vp, *GA, *U, *GS; float *QS, *KS, *VS; const float *qg, *kg; int wmask;
    __device__ __forceinline__ void operator()(const f32x4 (&acc)[2][2][4][2], const Unit& u, int wr, int wc, int fr, int fq) const {
        const int kind = u.pn >> 1, half = u.pn & 1;
        const int rowb = u.pm * BM + wr * 64 + fr;
        const int cc = 64 * wc + 8 * fq;
        if (kind <= 1) {
            const float* gsrc = kind == 0 ? qg : kg;
            f32x4 g[2][2];
#pragma unroll
            for (int bj = 0; bj < 2; ++bj)
#pragma unroll
                for (int n = 0; n < 2; ++n) { g[bj][n] = *(const f32x4*)(gsrc + 32 * bj + 8 * fq + 4 * n); if (kind == 0) g[bj][n] = g[bj][n] * C2; }
            const int j64 = 4 * half + wc;
#pragma unroll
            for (int ai = 0; ai < 2; ++ai)
#pragma unroll
                for (int m = 0; m < 4; ++m) {
                    const int row = rowb + ai * HALF + m * 16;
                    float ss = 0.f;
#pragma unroll
                    for (int bj = 0; bj < 2; ++bj)
#pragma unroll
                        for (int n = 0; n < 2; ++n) { const f32x4 x = acc[ai][bj][m][n]; ss += (x[0] * x[0] + x[1] * x[1]) + (x[2] * x[2] + x[3] * x[3]); }
                    ss += __shfl_xor(ss, 16); ss += __shfl_xor(ss, 32);
                    const float rs = rsqrtf(ss * (1.0f / 64.0f) + EPS);
#pragma unroll
                    for (int bj = 0; bj < 2; ++bj) {
                        const f32x4 v0 = acc[ai][bj][m][0] * rs * g[bj][0], v1 = acc[ai][bj][m][1] * rs * g[bj][1];
                        const int d = 32 * bj + 8 * fq;
                        if (kind == 0) {
                            if (row < MP) { *(u32x4*)(Qp + (size_t)row * DH + 64 * j64 + d) = pack8(v0, v1); }
                            else { float* p = QS + (size_t)(row - MP) * DH + 64 * j64 + d; *(f32x4*)p = v0; *(f32x4*)(p + 4) = v1; }
                        } else {
                            if (wmask & 1) { float* p = row < MP ? out + O_KP + (size_t)row * DH + 64 * j64 + d : out + O_KS + (size_t)(row - MP) * DH + 64 * j64 + d;
                                *(f32x4*)p = v0; *(f32x4*)(p + 4) = v1; }
                            if (row < MP) { *(u32x4*)(Kp + (size_t)row * DH + 64 * j64 + d) = pack8(v0, v1); }
                            else { float* p = KS + (size_t)(row - MP) * DH + 64 * j64 + d; *(f32x4*)p = v0; *(f32x4*)(p + 4) = v1; }
                        }
                    }
                }
        } else {
#pragma unroll
            for (int ai = 0; ai < 2; ++ai)
#pragma unroll
                for (int m = 0; m < 4; ++m) {
                    const int row = rowb + ai * HALF + m * 16;
#pragma unroll
                    for (int bj = 0; bj < 2; ++bj) {
                        f32x4 v0 = acc[ai][bj][m][0], v1 = acc[ai][bj][m][1];
                        const int col = 256 * half + cc + 32 * bj;
                        if (kind == 2) {
                            if (wmask & 1) { float* p = row < MP ? out + O_VP + (size_t)row * DH + col : out + O_VS + (size_t)(row - MP) * DH + col;
                                *(f32x4*)p = v0; *(f32x4*)(p + 4) = v1; }
                            if (row < MP) { *(u32x4*)(Vp + (size_t)row * DH + col) = pack8(v0, v1); }
                            else { float* p = VS + (size_t)(row - MP) * DH + col; *(f32x4*)p = v0; *(f32x4*)(p + 4) = v1; }
                        } else {
                            bf16_t* dst = kind == 3 ? GA : (kind == 4 ? U : GS);
                            if (kind != 4) {
#pragma unroll
                                for (int e = 0; e < 4; ++e) { v0[e] = silu_f(v0[e]); v1[e] = silu_f(v1[e]); }
                            }
                            *(u32x4*)(dst + (size_t)row * DH + col) = pack8(v0, v1);
                        }
                    }
                }
        }
    }
};


__device__ __forceinline__ float bflo(unsigned w) { return __uint_as_float(w << 16); }
__device__ __forceinline__ float bfhi(unsigned w) { return __uint_as_float(w & 0xffff0000u); }
struct EpiGlu {
    static constexpr bool PERM = true, AFTER_DRAIN = false;
    const bf16_t* Z; const bf16_t* GS; const float* bglu; bf16_t* A2;
    __device__ __forceinline__ void operator()(const f32x4 (&acc)[2][2][4][2], const Unit& u, int wr, int wc, int fr, int fq) const {
        const int rowb = u.pm * BM + wr * 64 + fr, colb = u.pn * BM + wc * 32 + 8 * fq;
        f32x4 bv[2][2];
#pragma unroll
        for (int bj = 0; bj < 2; ++bj)
#pragma unroll
            for (int n = 0; n < 2; ++n) bv[bj][n] = *(const f32x4*)(bglu + colb + bj * HALF + 4 * n);
#pragma unroll
        for (int ai = 0; ai < 2; ++ai)
#pragma unroll
            for (int m = 0; m < 4; ++m) {
                const size_t row = (size_t)(rowb + ai * HALF + m * 16);
#pragma unroll
                for (int bj = 0; bj < 2; ++bj) {
                    const int col = colb + bj * HALF;
                    const u32x4 zz = *(const u32x4*)(Z + row * DH + col), gg = *(const u32x4*)(GS + row * DH + col);
                    const f32x4 t0 = acc[ai][bj][m][0] + bv[bj][0], t1 = acc[ai][bj][m][1] + bv[bj][1];
                    f32x4 o0, o1;
                    o0[0] = bflo(zz.x) * sigmoid_f(t0[0]) * bflo(gg.x); o0[1] = bfhi(zz.x) * sigmoid_f(t0[1]) * bfhi(gg.x); o0[2] = bflo(zz.y) * sigmoid_f(t0[2]) * bflo(gg.y); o0[3] = bfhi(zz.y) * sigmoid_f(t0[3]) * bfhi(gg.y);
                    o1[0] = bflo(zz.z) * sigmoid_f(t1[0]) * bflo(gg.z); o1[1] = bfhi(zz.z) * sigmoid_f(t1[1]) * bfhi(gg.z); o1[2] = bflo(zz.w) * sigmoid_f(t1[2]) * bflo(gg.w); o1[3] = bfhi(zz.w) * sigmoid_f(t1[3]) * bfhi(gg.w);
                    *(u32x4*)(A2 + row * DM + DH + col) = pack8(o0, o1);
                }
            }
    }
};
struct EpiOut {
    static constexpr bool PERM = true, AFTER_DRAIN = false;
    const float* xp; const float* xs; float* out; int wmask;
    __device__ __forceinline__ void operator()(const f32x4 (&acc)[2][2][4][2], const Unit& u, int wr, int wc, int fr, int fq) const {
        const int rowb = u.pm * BM + wr * 64 + fr, colb = u.pn * BM + wc * 32 + 8 * fq;
#pragma unroll
        for (int ai = 0; ai < 2; ++ai)
#pragma unroll
            for (int m = 0; m < 4; ++m) {
                const int row = rowb + ai * HALF + m * 16;
                const bool pr = row < MP;
                if (!(wmask & (pr ? 16 : 8))) continue;
                const float* xr = pr ? xp + (size_t)row * DM : xs + (size_t)(row - MP) * DM;
                float* yr = pr ? out + O_YP + (size_t)row * DM : out + O_YS + (size_t)(row - MP) * DM;
#pragma unroll
                for (int bj = 0; bj < 2; ++bj) {
                    const int col = colb + bj * HALF;
                    const f32x4 x0 = *(const f32x4*)(xr + col), x1 = *(const f32x4*)(xr + col + 4);
                    *(f32x4*)(yr + col) = x0 + acc[ai][bj][m][0]; *(f32x4*)(yr + col + 4) = x1 + acc[ai][bj][m][1];
                }
            }
    }
};

template <class Epi, class Sched, bool ALIGN_EPI = false, bool SP2 = false>
__device__ __forceinline__ void gemm_phase(PG8_LAS unsigned char* lds, const Gemm g, const Sched& S, const Epi& E) {
    int tid_ = threadIdx.x; asm volatile("" : "+v"(tid_));
    const int tid = tid_, wid = __builtin_amdgcn_readfirstlane(tid >> 6), lane = tid & 63, wr = wid >> 2, wc = wid & 3, fr = lane & 15, fq = lane >> 4;
    const int K = g.K, nt = K / BK;
    unsigned voffA[2], voffB[2];
#pragma unroll
    for (int i = 0; i < 2; ++i) { int R, C; stage_rc(tid * 16 + i * 8192, R, C); const int Rb = Epi::PERM ? ((R & ~31) + perm32(R & 31)) : R;
        voffA[i] = (unsigned)(R * K + C) * 2u; voffB[i] = (unsigned)(Rb * K + C) * 2u; }
    const size_t kstep = (size_t)(BK * 2);
    const size_t hstep = (size_t)HALF * K * 2;
    const size_t tstep = 2 * hstep;
    const unsigned ldsw = (unsigned)wid * 1024u;
    const int aoff = lds_byte(wr * 64 + fr, fq * 8), boff = lds_byte(wc * 32 + fr, fq * 8);
#define PG8_SA(b, h) (((b) * 2 + (h)) * HTB)
#define PG8_SB(b, h) ((4 + (b) * 2 + (h)) * HTB)
#define PG8_STAGE(bufoff, gbase, voff) do { _Pragma("unroll") for (int _i = 0; _i < 2; ++_i) \
        __builtin_amdgcn_global_load_lds((const unsigned*)((const char*)(gbase) + (voff)[_i]), (PG8_LAS unsigned*)(lds + (bufoff) + ldsw + _i * 8192), 16, 0, 0); } while (0)
#define PG8_LDA(dst, b, h) do { _Pragma("unroll") for (int m = 0; m < 4; ++m) _Pragma("unroll") for (int k = 0; k < 2; ++k) dst[m][k] = *(const PG8_LAS bf16x8*)(lds + PG8_SA(b, h) + aoff + m * 2048 + k * 1024); } while (0)
#define PG8_LDB(dst, b, h) do { _Pragma("unroll") for (int n = 0; n < 2; ++n) _Pragma("unroll") for (int k = 0; k < 2; ++k) dst[n][k] = *(const PG8_LAS bf16x8*)(lds + PG8_SB(b, h) + boff + n * 2048 + k * 1024); } while (0)
#define PG8_MMA(ai, bj, At, Bt) do { __builtin_amdgcn_s_setprio(1); _Pragma("unroll") for (int m = 0; m < 4; ++m) _Pragma("unroll") for (int n = 0; n < 2; ++n) _Pragma("unroll") for (int k = 0; k < 2; ++k) \
        acc[ai][bj][m][n] = __builtin_amdgcn_mfma_f32_16x16x32_bf16(Bt[n][k], At[m][k], acc[ai][bj][m][n], 0, 0, 0); __builtin_amdgcn_s_setprio(0); } while (0)
#define PG8_WAIT_V(n) asm volatile("s_waitcnt vmcnt(" #n ")" ::: "memory")
#define PG8_WAIT_L(n) asm volatile("s_waitcnt lgkmcnt(" #n ")" ::: "memory")
#define PG8_BAR __builtin_amdgcn_s_barrier()
#define PG8_SCHED __builtin_amdgcn_sched_barrier(0)
    Unit cur, nxt; int ui = 0;
    if (!S.next(0, cur)) return;
    f32x4 acc[2][2][4][2];
#pragma unroll
    for (int a = 0; a < 2; ++a)
#pragma unroll
        for (int b = 0; b < 2; ++b)
#pragma unroll
            for (int m = 0; m < 4; ++m)
#pragma unroll
                for (int n = 0; n < 2; ++n) acc[a][b][m][n] = (f32x4){0.f, 0.f, 0.f, 0.f};
    bf16x8 At[4][2], B0[2][2], B1[2][2];
    const char* cA = (const char*)g.A + (size_t)cur.pm * tstep; const char* cB = (const char*)g.Bt + (size_t)cur.pn * tstep;
    S.a_ready(cur);
    if constexpr (SP2) {
        PG8_STAGE(PG8_SB(0, 0), cB, voffB); PG8_STAGE(PG8_SB(0, 1), cB + hstep, voffB); PG8_STAGE(PG8_SA(0, 0), cA, voffA); PG8_STAGE(PG8_SA(0, 1), cA + hstep, voffA);
        if (wr == 1) PG8_BAR;
        PG8_WAIT_V(2); PG8_BAR;
        PG8_STAGE(PG8_SB(1, 0), cB + kstep, voffB); PG8_STAGE(PG8_SA(1, 0), cA + kstep, voffA); PG8_STAGE(PG8_SB(1, 1), cB + hstep + kstep, voffB);
        PG8_WAIT_V(6); PG8_BAR;
    } else {
        PG8_STAGE(PG8_SB(0, 0), cB, voffB); PG8_STAGE(PG8_SA(0, 0), cA, voffA); PG8_STAGE(PG8_SB(0, 1), cB + hstep, voffB); PG8_STAGE(PG8_SA(0, 1), cA + hstep, voffA);
        if (wr == 1) PG8_BAR;
        PG8_WAIT_V(4); PG8_BAR;
        PG8_STAGE(PG8_SB(1, 0), cB + kstep, voffB); PG8_STAGE(PG8_SA(1, 0), cA + kstep, voffA); PG8_STAGE(PG8_SB(1, 1), cB + hstep + kstep, voffB);
        PG8_WAIT_V(6); PG8_BAR;
    }
    for (;;) {
        const bool has_next = S.next(ui + 1, nxt);
        const char* nA = has_next ? (const char*)g.A + (size_t)nxt.pm * tstep : cA; const char* nB = has_next ? (const char*)g.Bt + (size_t)nxt.pn * tstep : cB;
        for (int t = 0; t < nt; t += 2) {
            const bool last = (t == nt - 2);
            const char* a1 = cA + (size_t)(t + 1) * kstep;
            const char* a2 = last ? nA : cA + (size_t)(t + 2) * kstep; const char* b2 = last ? nB : cB + (size_t)(t + 2) * kstep;
            const char* a3 = a2 + kstep; const char* b3 = b2 + kstep;
            if (last && has_next) S.a_ready(nxt);
            if constexpr (SP2) {
            PG8_LDB(B0, 0, 0); PG8_LDB(B1, 0, 1); PG8_SCHED; PG8_LDA(At, 0, 0); PG8_STAGE(PG8_SA(1, 1), a1 + hstep, voffA);
            PG8_WAIT_V(8); PG8_WAIT_L(0); PG8_BAR; PG8_MMA(0, 0, At, B0); PG8_MMA(0, 1, At, B1); PG8_BAR; PG8_SCHED;
            PG8_LDA(At, 0, 1); PG8_STAGE(PG8_SB(0, 0), b2, voffB); PG8_STAGE(PG8_SB(0, 1), b2 + hstep, voffB); PG8_STAGE(PG8_SA(0, 0), a2, voffA);
            PG8_WAIT_V(8); PG8_WAIT_L(0); PG8_BAR; PG8_MMA(1, 0, At, B0); PG8_MMA(1, 1, At, B1); PG8_BAR; PG8_SCHED;
            PG8_LDB(B0, 1, 0); PG8_LDB(B1, 1, 1); PG8_SCHED; PG8_LDA(At, 1, 0); PG8_STAGE(PG8_SA(0, 1), a2 + hstep, voffA);
            PG8_WAIT_V(8); PG8_WAIT_L(0); PG8_BAR; PG8_MMA(0, 0, At, B0); PG8_MMA(0, 1, At, B1); PG8_BAR; PG8_SCHED;
            PG8_LDA(At, 1, 1); PG8_STAGE(PG8_SB(1, 0), b3, voffB); PG8_STAGE(PG8_SB(1, 1), b3 + hstep, voffB); PG8_STAGE(PG8_SA(1, 0), a3, voffA);
            PG8_WAIT_V(8); PG8_WAIT_L(0); PG8_BAR; PG8_MMA(1, 0, At, B0); PG8_MMA(1, 1, At, B1); PG8_BAR; PG8_SCHED;
            } else {
            PG8_LDB(B0, 0, 0); PG8_SCHED; PG8_LDA(At, 0, 0); PG8_STAGE(PG8_SA(1, 1), a1 + hstep, voffA);
            PG8_WAIT_L(8); PG8_BAR; PG8_WAIT_L(0); PG8_MMA(0, 0, At, B0); PG8_BAR; PG8_SCHED;
            PG8_LDB(B1, 0, 1); PG8_STAGE(PG8_SB(0, 0), b2, voffB);
            PG8_BAR; PG8_WAIT_L(0); PG8_MMA(0, 1, At, B1); PG8_BAR;
            PG8_LDA(At, 0, 1); PG8_STAGE(PG8_SA(0, 0), a2, voffA);
            PG8_BAR; PG8_WAIT_L(0); PG8_MMA(1, 0, At, B0); PG8_BAR; PG8_SCHED;
            PG8_STAGE(PG8_SB(0, 1), b2 + hstep, voffB);
            PG8_WAIT_V(6); PG8_BAR; PG8_MMA(1, 1, At, B1); PG8_BAR;
            PG8_LDB(B0, 1, 0); PG8_SCHED; PG8_LDA(At, 1, 0); PG8_STAGE(PG8_SA(0, 1), a2 + hstep, voffA);
            PG8_WAIT_L(8); PG8_BAR; PG8_WAIT_L(0); PG8_MMA(0, 0, At, B0); PG8_BAR; PG8_SCHED;
            PG8_LDB(B1, 1, 1); PG8_STAGE(PG8_SB(1, 0), b3, voffB);
            PG8_BAR; PG8_WAIT_L(0); PG8_MMA(0, 1, At, B1); PG8_BAR;
            PG8_LDA(At, 1, 1); PG8_STAGE(PG8_SA(1, 0), a3, voffA);
            PG8_BAR; PG8_WAIT_L(0); PG8_MMA(1, 0, At, B0); PG8_BAR; PG8_SCHED;
            PG8_STAGE(PG8_SB(1, 1), b3 + hstep, voffB);
            PG8_WAIT_V(6); PG8_BAR; PG8_MMA(1, 1, At, B1); PG8_BAR;
            }
        }
        if constexpr (ALIGN_EPI) { if (wr == 0) PG8_BAR; }
        if constexpr (!Epi::AFTER_DRAIN) { E(acc, cur, wr, wc, fr, fq); S.done(cur); }
        if (!has_next) break;
#pragma unroll
        for (int a = 0; a < 2; ++a)
#pragma unroll
            for (int b = 0; b < 2; ++b)
#pragma unroll
                for (int m = 0; m < 4; ++m)
#pragma unroll
                    for (int n = 0; n < 2; ++n) acc[a][b][m][n] = (f32x4){0.f, 0.f, 0.f, 0.f};
        cur = nxt; cA = nA; cB = nB; ++ui;
        if constexpr (ALIGN_EPI) { if (wr == 1) PG8_BAR; }
    }
    PG8_WAIT_V(0);
    if constexpr (!ALIGN_EPI) { if (wr == 0) PG8_BAR; }
    PG8_BAR;
    if constexpr (Epi::AFTER_DRAIN) { E.fused(acc, cur, wr, wc, fr, fq, lds, wid, lane); S.done(cur); }
#undef PG8_SA
#undef PG8_SB
#undef PG8_STAGE
#undef PG8_LDA
#undef PG8_LDB
#undef PG8_MMA
#undef PG8_WAIT_V
#undef PG8_WAIT_L
#undef PG8_BAR
#undef PG8_SCHED
}
}

#include <hip/hip_bf16.h>
#include <cmath>
namespace attn_body {
using bf16=__hip_bfloat16;
using bf16x8=__attribute__((ext_vector_type(8)))short;
using s16x4=__attribute__((ext_vector_type(4)))short;
using f32x16=__attribute__((ext_vector_type(16)))float;
using u32x4=__attribute__((ext_vector_type(4)))unsigned;
constexpr int BATCH=2,NHEAD=8,SEQ=8192,D=64,DV=128,QKP=512,VP=512,OP=1024;
constexpr int NW=8,QBLK=32,QB=QBLK*NW,KVBLK=64,NQB=SEQ/QB;
constexpr int ATTN_UNIT_ROWS=QB;
__device__ __forceinline__ int crow(int r,int hi){return (r&3)+8*(r>>2)+4*hi;}
#define SBAR() __builtin_amdgcn_sched_barrier(0)
typedef const __attribute__((address_space(3))) float* lds_cfp;
__device__ __forceinline__ void cmask(f32x16&p0,f32x16&p1,int jb,int qrel,int hi,lds_cfp bt){
  const float NEG=-INFINITY; const int kb=64*jb+4*hi;
  #pragma unroll
  for(int r=0;r<16;++r){const int d0=qrel-(kb+(r&3)+8*(r>>2)), d1=d0-32;
    const float b0=bt[d0<0?0:(d0>127?127:d0)], b1=bt[d1<0?0:(d1>127?127:d1)];
    p0[r]=d0<0?NEG:p0[r]+b0; p1[r]=d1<0?NEG:p1[r]+b1;}
}

constexpr int NSLOT=3, SLOTB=8192, SLOTV=16384;
constexpr int LDS_K=0, LDS_V=NSLOT*SLOTB, LDS_WS=LDS_V+NSLOT*SLOTV, LDS_OST=LDS_WS+NW*64*4, LDS_BYTES=LDS_OST+NW*4096;
constexpr float C2_=0.125f*1.4426950408889634f;
__device__ __forceinline__ void glds16(const void*gsrc,unsigned lds_dst){unsigned keep;
  asm volatile("s_mov_b32 %0, m0\n\ts_mov_b32 m0, %2\n\ts_nop 0\n\tglobal_load_lds_dwordx4 %1, off\n\ts_mov_b32 m0, %0":"=&s"(keep):"v"(gsrc),"s"(lds_dst):"memory");}
__device__ __forceinline__ float max3f(float a,float b,float c){float r;asm("v_max3_f32 %0, %1, %2, %3":"=v"(r):"v"(a),"v"(b),"v"(c));return r;}
__device__ __forceinline__ float max2f(float a,float b){float r;asm("v_max_f32_e32 %0, %1, %2":"=v"(r):"v"(a),"v"(b));return r;}
__device__ __forceinline__ float fadd_s(float a,float b){float r;asm("v_add_f32_e32 %0, %1, %2":"=v"(r):"v"(a),"v"(b));return r;}
__device__ __forceinline__ float fsub_s(float a,float b){float r;asm("v_sub_f32_e32 %0, %1, %2":"=v"(r):"v"(a),"v"(b));return r;}
typedef float f32x2_t __attribute__((ext_vector_type(2))); typedef __bf16 bf16x2_t __attribute__((ext_vector_type(2)));
__device__ __forceinline__ unsigned cvtpk_s(float lo,float hi){f32x2_t v={lo,hi};bf16x2_t b=__builtin_convertvector(v,bf16x2_t);return __builtin_bit_cast(unsigned,b);}
#define WAIT_BAR(N) asm volatile("s_waitcnt vmcnt(" #N ") lgkmcnt(0)\n\ts_barrier":::"memory")

__device__ __forceinline__ void qkt(f32x16&p0,f32x16&p1,const char*Kslot,const bf16x8*qr,const f32x16&negm,int r32,int hi){
  const char*kb=Kslot+hi*1024+r32*16;
  #pragma unroll
  for(int d0=0;d0<4;++d0){
    const bf16x8 b0=*reinterpret_cast<const bf16x8*>(kb+d0*2048);
    const bf16x8 b1=*reinterpret_cast<const bf16x8*>(kb+d0*2048+512);
    if(d0==0){p0=__builtin_amdgcn_mfma_f32_32x32x16_bf16(b0,qr[0],negm,0,0,0);p1=__builtin_amdgcn_mfma_f32_32x32x16_bf16(b1,qr[0],negm,0,0,0);}
    else{p0=__builtin_amdgcn_mfma_f32_32x32x16_bf16(b0,qr[d0],p0,0,0,0);p1=__builtin_amdgcn_mfma_f32_32x32x16_bf16(b1,qr[d0],p1,0,0,0);}}
}
typedef __attribute__((address_space(3))) const char* lds_cptr;
typedef short v4i16_t __attribute__((ext_vector_type(4)));
__device__ __forceinline__ void kload8(bf16x8*kf,lds_cptr kp){
  kf[0]=*(const __attribute__((address_space(3))) bf16x8*)(kp);      kf[1]=*(const __attribute__((address_space(3))) bf16x8*)(kp+512);
  kf[2]=*(const __attribute__((address_space(3))) bf16x8*)(kp+2048); kf[3]=*(const __attribute__((address_space(3))) bf16x8*)(kp+2560);
  kf[4]=*(const __attribute__((address_space(3))) bf16x8*)(kp+4096); kf[5]=*(const __attribute__((address_space(3))) bf16x8*)(kp+4608);
  kf[6]=*(const __attribute__((address_space(3))) bf16x8*)(kp+6144); kf[7]=*(const __attribute__((address_space(3))) bf16x8*)(kp+6656);
}
__device__ __forceinline__ void kload2(bf16x8*kf,lds_cptr kp,int j){ kf[2*j]=*(const __attribute__((address_space(3))) bf16x8*)(kp+j*2048); kf[2*j+1]=*(const __attribute__((address_space(3))) bf16x8*)(kp+j*2048+512); }
__device__ __forceinline__ s16x4 vtr(lds_cptr p){ return __builtin_bit_cast(s16x4,__builtin_amdgcn_ds_read_tr16_b64_v4i16((__attribute__((address_space(3))) v4i16_t*)p)); }
__device__ __forceinline__ float rowmax(const f32x16&p0,const f32x16&p1){
  float a=max3f(p0[0],p0[1],p1[0]),b=max3f(p0[2],p0[3],p1[1]);a=max3f(a,p1[2],p1[3]);
  #pragma unroll
  for(int r=4;r<16;r+=4){a=max3f(a,p0[r],p0[r+1]);b=max3f(b,p0[r+2],p0[r+3]);a=max3f(a,p1[r],p1[r+1]);b=max3f(b,p1[r+2],p1[r+3]);}
  const float m=max2f(a,b);
  auto rr=__builtin_amdgcn_permlane32_swap(__float_as_uint(m),__float_as_uint(m),false,false);
  return max2f(__uint_as_float(rr[0]),__uint_as_float(rr[1]));
}
__device__ __forceinline__ void pv(f32x16*o,int vb,bf16x8 pa0,bf16x8 pa1,bf16x8 pa2,bf16x8 pa3){
  #pragma unroll
  for(int d0=0;d0<4;++d0){s16x4 lo[4],hi[4];
    #pragma unroll
    for(int ks=0;ks<4;++ks){
      asm volatile("ds_read_b64_tr_b16 %0,%1 offset:%c2":"=&v"(lo[ks]):"v"(vb),"i"(d0*4096+ks*1024):"memory");
      asm volatile("ds_read_b64_tr_b16 %0,%1 offset:%c2":"=&v"(hi[ks]):"v"(vb),"i"(d0*4096+ks*1024+512):"memory");}
    asm volatile("s_waitcnt lgkmcnt(0)":::"memory");SBAR();
    #define PK(k) (bf16x8){lo[k][0],lo[k][1],lo[k][2],lo[k][3],hi[k][0],hi[k][1],hi[k][2],hi[k][3]}
    o[d0]=__builtin_amdgcn_mfma_f32_32x32x16_bf16(pa0,PK(0),o[d0],0,0,0);
    o[d0]=__builtin_amdgcn_mfma_f32_32x32x16_bf16(pa1,PK(1),o[d0],0,0,0);
    o[d0]=__builtin_amdgcn_mfma_f32_32x32x16_bf16(pa2,PK(2),o[d0],0,0,0);
    o[d0]=__builtin_amdgcn_mfma_f32_32x32x16_bf16(pa3,PK(3),o[d0],0,0,0);
    #undef PK
  }
}

#ifndef ATTN_STORE16
#define ATTN_STORE16(p,v) (*(u32x4*)(p)=(v))
#endif
template<int THRL> __device__ __forceinline__ void attn_unit(int b,int h,int qb,const bf16*Q,const bf16*__restrict__ K,const bf16*__restrict__ V,bf16*O,char*shm,lds_cfp btab){
  const lds_cfp bt=btab+(h>>1)*128;
  int tid_=threadIdx.x; asm volatile("":"+v"(tid_));
  const int tid=tid_,lane=tid&63,r32=lane&31,hi=lane>>5; const int wid=__builtin_amdgcn_readfirstlane(tid>>6);
  const long rowbase=(long)b*SEQ; const int q0=qb*QB;
  const bf16*Qw=Q+(rowbase+q0+wid*QBLK)*QKP+h*D;
  const bf16*Kh=K+rowbase*QKP+h*D,*Vh=V+rowbase*VP+(h>>1)*DV;
  const unsigned lds0=(unsigned)(uintptr_t)shm;
  float*wsf=(float*)(shm+LDS_WS)+wid*64;
  const bf16*ksrc=Kh+(long)lane*QKP+wid*8;
  const bf16*vsrc=Vh+(long)(16*(wid&3)+(lane>>2))*VP+(wid>>2)*32+(lane&3)*8;
  const unsigned kdst=lds0+LDS_K+wid*1024, vdst=lds0+LDS_V+wid*1024;
  #define DMA_K(t,slot) glds16(ksrc+(long)(t)*KVBLK*QKP,(unsigned)__builtin_amdgcn_readfirstlane(kdst+(slot)))
  #define DMA_V(t,slot) do{ glds16(vsrc+(long)(t)*KVBLK*VP,(unsigned)__builtin_amdgcn_readfirstlane(vdst+2*(slot))); glds16(vsrc+(long)(t)*KVBLK*VP+64,(unsigned)__builtin_amdgcn_readfirstlane(vdst+2*(slot)+8192)); }while(0)
  const int vb0=(int)(lds0+LDS_V)+((lane>>4)&1)*32+(lane&3)*8+(4*hi+((lane&15)>>2))*64;
  const char*Kbase=shm+LDS_K; bf16x8 kf[8];
  const lds_cptr shm3=(lds_cptr)shm; const lds_cptr kp0=shm3+LDS_K+hi*1024+r32*16; const lds_cptr vp0=shm3+LDS_V+((lane>>4)&1)*32+(lane&3)*8+(4*hi+((lane&15)>>2))*64;
  const int NT=(q0+QB)/KVBLK;
  DMA_K(0,0);DMA_V(0,0);DMA_K(1,SLOTB);
  bf16x8 qr[4];
  #pragma unroll
  for(int d0=0;d0<4;++d0)qr[d0]=*reinterpret_cast<const bf16x8*>(&Qw[(long)r32*QKP+d0*16+hi*8]);
  float mhat=0.f,l_reg=0.f;f32x16 o[4];o[0]=f32x16{};o[1]=f32x16{};o[2]=f32x16{};o[3]=f32x16{};const f32x16 zero16=f32x16{};
  const int qrel=wid*QBLK+r32;
  #define CMASK(P0,P1,t) do{int jb_=(t)-(NT-4); if(jb_>=-2)cmask(P0,P1,jb_,qrel,hi,bt);}while(0)
  bool resc=false;
  #define START(P0,P1) do{ const float rm=rowmax(P0,P1); resc=false; mhat=rm; \
    _Pragma("unroll") for(int r=0;r<16;++r)P0[r]=__builtin_amdgcn_exp2f(fsub_s(P0[r],mhat)); }while(0)
  #define RESC() do{ if(resc){ asm volatile("s_waitcnt lgkmcnt(0)":::"memory"); \
      _Pragma("unroll") for(int d_=0;d_<4;++d_) _Pragma("unroll") for(int r=0;r<16;++r)o[d_][r]*=wsf[crow(r,hi)]; } }while(0)
  f32x16 pA0,pA1,pB0,pB1;
  int sl_prev=0,sl_cur=0,sl_next=SLOTB;
  #define ROT() do{sl_prev=sl_cur;sl_cur=sl_next;sl_next=(sl_next==(NSLOT-1)*SLOTB)?0:sl_next+SLOTB;}while(0)
  DMA_K(2,2*SLOTB);
  WAIT_BAR(4);
  qkt(pA0,pA1,Kbase,qr,zero16,r32,hi);asm volatile("s_nop 15\n\ts_nop 7":"+v"(pA0),"+v"(pA1));CMASK(pA0,pA1,0);
  START(pA0,pA1);
  _Pragma("unroll") for(int r=0;r<16;++r)pA1[r]=__builtin_amdgcn_exp2f(fsub_s(pA1[r],mhat));
  WAIT_BAR(0);
  DMA_K(3,0);DMA_V(1,SLOTB);
  ROT();
  kload8(kf,kp0+sl_cur);
  WAIT_BAR(3);
  s16x4 vlo[4],vhi[4]; u32x4 pw0,pw1,pw2,pw3;
  #define PKW(P,B) cvtpk_s(P[B],P[B+1])
  #define PAF(k) __builtin_bit_cast(bf16x8,pw##k)
  #define VFR(j) (bf16x8){vlo[(j)&3][0],vlo[(j)&3][1],vlo[(j)&3][2],vlo[(j)&3][3],vhi[(j)&3][0],vhi[(j)&3][1],vhi[(j)&3][2],vhi[(j)&3][3]}
  #define PIN(x) asm volatile("":"+v"(x))
  #define MX3(a,b,c) __builtin_fmaxf(__builtin_fmaxf((a),(b)),(c))
  #define GAPA(MF,A0,A1,A2,A3,W0,W1,PW) do{ MF; sacc+=A0; sacc+=A1; sacc+=A2; sacc+=A3; PIN(sacc); W0; W1; PIN(PW); SBAR(); }while(0)
  #define EX(v) __builtin_amdgcn_exp2f(v)
  #define GAPB(MF,RD,X,B) do{ MF; RD; X[B]=EX(X[B]-mhat); X[B+1]=EX(X[B+1]-mhat); PIN(X); SBAR(); }while(0)
  #define VRD(j) do{ vlo[(j)&3]=vtr(vp_+(((j)&3)*4096+((j)>>2)*1024)); vhi[(j)&3]=vtr(vp_+(((j)&3)*4096+((j)>>2)*1024+512)); }while(0)
  #define KRD(G,j) do{ if(G){ kload2(kf,kp0+sl_next,j); SBAR(); } }while(0)
  #define STEP(C0,C1,P0,P1,t,GK,GV,GL) do{ SBAR(); \
    const lds_cptr vp_=vp0+2*sl_prev; \
    float sacc=(P0[0]+P0[1]); \
    GAPA(C0=__builtin_amdgcn_mfma_f32_32x32x16_bf16(kf[0],qr[0],zero16,0,0,0), P0[2],P0[3],P0[4],P0[5],     pw0[0]=PKW(P0,0), pw0[1]=PKW(P0,2), pw0); \
    GAPA(C1=__builtin_amdgcn_mfma_f32_32x32x16_bf16(kf[1],qr[0],zero16,0,0,0), P0[6],P0[7],P0[8],P0[9],     pw0[2]=PKW(P0,4), pw0[3]=PKW(P0,6), pw0); \
    GAPA(C0=__builtin_amdgcn_mfma_f32_32x32x16_bf16(kf[2],qr[1],C0,0,0,0),   P0[10],P0[11],P0[12],P0[13], pw1[0]=PKW(P0,8), pw1[1]=PKW(P0,10), pw1); \
    GAPA(C1=__builtin_amdgcn_mfma_f32_32x32x16_bf16(kf[3],qr[1],C1,0,0,0),   P0[14],P0[15],P1[0],P1[1],   pw1[2]=PKW(P0,12),pw1[3]=PKW(P0,14), pw1); \
    GAPA(C0=__builtin_amdgcn_mfma_f32_32x32x16_bf16(kf[4],qr[2],C0,0,0,0),   P1[2],P1[3],P1[4],P1[5],     pw2[0]=PKW(P1,0), pw2[1]=PKW(P1,2), pw2); \
    GAPA(C1=__builtin_amdgcn_mfma_f32_32x32x16_bf16(kf[5],qr[2],C1,0,0,0),   P1[6],P1[7],P1[8],P1[9],     pw2[2]=PKW(P1,4), pw2[3]=PKW(P1,6), pw2); \
    GAPA(C0=__builtin_amdgcn_mfma_f32_32x32x16_bf16(kf[6],qr[3],C0,0,0,0),   P1[10],P1[11],P1[12],P1[13], pw3[0]=PKW(P1,8), pw3[1]=PKW(P1,10), pw3); \
    GAPA(C1=__builtin_amdgcn_mfma_f32_32x32x16_bf16(kf[7],qr[3],C1,0,0,0),   P1[14],P1[15],0.f,0.f,       pw3[2]=PKW(P1,12),pw3[3]=PKW(P1,14), pw3); \
    l_reg+=sacc; \
    if(GK){DMA_K((t)+3,sl_cur);} if(GV){DMA_V((t)+1,sl_next);} \
    CMASK(C0,C1,t); \
    { float a=MX3(C0[0],C0[1],C1[0]),b=MX3(C0[2],C0[3],C1[1]); a=MX3(a,C1[2],C1[3]); \
      _Pragma("unroll") for(int r=4;r<16;r+=4){a=MX3(a,C0[r],C0[r+1]);b=MX3(b,C0[r+2],C0[r+3]);a=MX3(a,C1[r],C1[r+1]);b=MX3(b,C1[r+2],C1[r+3]);} \
      float rm=__builtin_fmaxf(a,b); { auto rr=__builtin_amdgcn_permlane32_swap(__float_as_uint(rm),__float_as_uint(rm),false,false); rm=__builtin_fmaxf(__uint_as_float(rr[0]),__uint_as_float(rr[1])); } \
      resc=false; rm-=mhat; \
      if(__builtin_expect(__any(rm>(float)THRL),0)){ const float dl=__builtin_fmaxf(rm,0.f); mhat+=dl; \
        const float f=__builtin_amdgcn_exp2f(-dl); l_reg*=f; if(hi==0)wsf[r32]=f; resc=true; } } \
    SBAR(); VRD(0); VRD(1); VRD(2); SBAR(); \
    GAPB(o[0]=__builtin_amdgcn_mfma_f32_32x32x16_bf16(PAF(0),VFR(0),o[0],0,0,0), VRD(3), C0,0); \
    GAPB(o[1]=__builtin_amdgcn_mfma_f32_32x32x16_bf16(PAF(0),VFR(1),o[1],0,0,0), VRD(4), C0,2); \
    KRD(GL,0); GAPB(o[2]=__builtin_amdgcn_mfma_f32_32x32x16_bf16(PAF(0),VFR(2),o[2],0,0,0), VRD(5), C0,4); \
    KRD(GL,1); GAPB(o[3]=__builtin_amdgcn_mfma_f32_32x32x16_bf16(PAF(0),VFR(3),o[3],0,0,0), VRD(6), C0,6); \
    KRD(GL,2); GAPB(o[0]=__builtin_amdgcn_mfma_f32_32x32x16_bf16(PAF(1),VFR(4),o[0],0,0,0), VRD(7), C0,8); \
    KRD(GL,3); GAPB(o[1]=__builtin_amdgcn_mfma_f32_32x32x16_bf16(PAF(1),VFR(5),o[1],0,0,0), VRD(8), C0,10); \
    GAPB(o[2]=__builtin_amdgcn_mfma_f32_32x32x16_bf16(PAF(1),VFR(6),o[2],0,0,0), VRD(9), C0,12); \
    GAPB(o[3]=__builtin_amdgcn_mfma_f32_32x32x16_bf16(PAF(1),VFR(7),o[3],0,0,0), VRD(10), C0,14); \
    GAPB(o[0]=__builtin_amdgcn_mfma_f32_32x32x16_bf16(PAF(2),VFR(8),o[0],0,0,0), VRD(11), C1,0); \
    GAPB(o[1]=__builtin_amdgcn_mfma_f32_32x32x16_bf16(PAF(2),VFR(9),o[1],0,0,0), VRD(12), C1,2); \
    GAPB(o[2]=__builtin_amdgcn_mfma_f32_32x32x16_bf16(PAF(2),VFR(10),o[2],0,0,0), VRD(13), C1,4); \
    GAPB(o[3]=__builtin_amdgcn_mfma_f32_32x32x16_bf16(PAF(2),VFR(11),o[3],0,0,0), VRD(14), C1,6); \
    GAPB(o[0]=__builtin_amdgcn_mfma_f32_32x32x16_bf16(PAF(3),VFR(12),o[0],0,0,0), VRD(15), C1,8); \
    GAPB(o[1]=__builtin_amdgcn_mfma_f32_32x32x16_bf16(PAF(3),VFR(13),o[1],0,0,0), (void)0, C1,10); \
    GAPB(o[2]=__builtin_amdgcn_mfma_f32_32x32x16_bf16(PAF(3),VFR(14),o[2],0,0,0), (void)0, C1,12); \
    GAPB(o[3]=__builtin_amdgcn_mfma_f32_32x32x16_bf16(PAF(3),VFR(15),o[3],0,0,0), (void)0, C1,14); \
    }while(0)
  int t=1;
  #undef CMASK
  #define CMASK(P0,P1,t) do{}while(0)
  for(;t+7<NT;t+=2){
    STEP(pB0,pB1,pA0,pA1,t,true,true,true);     WAIT_BAR(3); RESC(); ROT();
    STEP(pA0,pA1,pB0,pB1,t+1,true,true,true);   WAIT_BAR(3); RESC(); ROT();
  }
  #undef CMASK
  #define CMASK(P0,P1,t) do{int jb_=(t)-(NT-4); if(jb_>=-2)cmask(P0,P1,jb_,qrel,hi,bt);}while(0)
  #define ENDW(tt) do{ if((tt)+3<NT){WAIT_BAR(3);} else if((tt)+2<NT){WAIT_BAR(2);} else {WAIT_BAR(0);} }while(0)
  for(;t+1<NT;t+=2){
    STEP(pB0,pB1,pA0,pA1,t,(t+3<NT),(t+1<NT),(t+1<NT));       ENDW(t);   RESC(); ROT();
    STEP(pA0,pA1,pB0,pB1,t+1,(t+4<NT),(t+2<NT),(t+2<NT));     ENDW(t+1); RESC(); ROT();
  }
  STEP(pB0,pB1,pA0,pA1,NT-1,false,false,false); RESC();
  { float sacc=pB0[0]+pB0[1]; _Pragma("unroll") for(int r=2;r<16;++r)sacc+=pB0[r]; _Pragma("unroll") for(int r=0;r<16;++r)sacc+=pB1[r]; l_reg+=sacc;
    pw0=(u32x4){PKW(pB0,0),PKW(pB0,2),PKW(pB0,4),PKW(pB0,6)};pw1=(u32x4){PKW(pB0,8),PKW(pB0,10),PKW(pB0,12),PKW(pB0,14)};pw2=(u32x4){PKW(pB1,0),PKW(pB1,2),PKW(pB1,4),PKW(pB1,6)};pw3=(u32x4){PKW(pB1,8),PKW(pB1,10),PKW(pB1,12),PKW(pB1,14)};
    SBAR(); pv(o,vb0+2*sl_cur,PAF(0),PAF(1),PAF(2),PAF(3)); }
  #undef PKW
  #undef PAF
  #undef VFR
  #undef PIN
  #undef MX3
  #undef GAPA
  #undef GAPB
  #undef EX
  #undef VRD
  #undef KRD
  #undef STEP
  #undef ENDW
  {auto rr=__builtin_amdgcn_permlane32_swap(__float_as_uint(l_reg),__float_as_uint(l_reg),false,false);l_reg=__uint_as_float(rr[0])+__uint_as_float(rr[1]);}
  if(hi==0)wsf[32+r32]=l_reg;asm volatile("s_waitcnt lgkmcnt(0)":::"memory");
  float rli[16];
  #pragma unroll
  for(int r=0;r<16;++r)rli[r]=__builtin_amdgcn_rcpf(wsf[32+crow(r,hi)]);
  bf16*Ow=O+(rowbase+q0+wid*QBLK)*OP+h*DV;
  { bf16*stg=(bf16*)(shm+LDS_OST)+wid*2048;
    #pragma unroll
    for(int ps=0;ps<2;++ps){
      #pragma unroll
      for(int r=0;r<16;++r){const int orow=crow(r,hi);
        #pragma unroll
        for(int d0=0;d0<2;++d0)stg[orow*64+d0*32+r32]=__float2bfloat16(o[2*ps+d0][r]*rli[r]);}
      asm volatile("s_waitcnt lgkmcnt(0)":::"memory");
      #pragma unroll
      for(int i=0;i<4;++i){const int row=i*8+(lane>>3),ch=lane&7; const u32x4 v=*(const u32x4*)(stg+row*64+ch*8); ATTN_STORE16(Ow+(long)row*OP+ps*64+ch*8,v);}
      asm volatile("s_waitcnt lgkmcnt(0)":::"memory"); } }
  asm volatile("s_waitcnt lgkmcnt(0)\n\ts_barrier":::"memory");
  #undef DMA_K
  #undef DMA_V
  #undef CMASK
  #undef START
  #undef RESC
  #undef ROT
}
constexpr int ATTN_LDS_BYTES=LDS_BYTES;
struct AttnTensors { const bf16* Q; const bf16* K; const bf16* V; bf16* O; };
struct AttnUnit { int bh; int qb; };
struct StaticOrder {
  int vcu;
  __device__ __forceinline__ explicit StaticOrder(int grid,int block):vcu((block%8)*(grid/8)+block/8){}
  __device__ __forceinline__ bool next(int i,AttnUnit&u)const{ if(i>=2)return false; const int s=vcu&15; u.bh=vcu>>4; u.qb=(i==0)?s:31-s; return true; }
  __device__ __forceinline__ void a_ready(const AttnUnit&)const{}
  __device__ __forceinline__ void done(const AttnUnit&)const{}
};
template<class Sched,int THRL=8> __device__ __forceinline__ void attn_phase(char*lds,const AttnTensors&T,const Sched&S,lds_cfp btab){
  AttnUnit u;
  for(int i=0;S.next(i,u);++i){ S.a_ready(u); attn_unit<THRL>(u.bh/NHEAD,u.bh%NHEAD,u.qb,T.Q,T.K,T.V,T.O,lds,btab); S.done(u); }
}
#undef SBAR
#undef WAIT_BAR
}

constexpr int NWAVES = 8;
constexpr size_t MiB = 1u << 20;
constexpr size_t WS_CTL = 0, CTL_ZERO_BYTES = 1 * MiB;
constexpr size_t WS_WIN = 2 * MiB, WS_WOUT = 8 * MiB, WS_WGLU = 10 * MiB, WS_TAB = 11 * MiB, WS_E = 12 * MiB, WS_QS = 14 * MiB, WS_PART = 16 * MiB;
constexpr size_t WS_XN = 32 * MiB, WS_Q = 66 * MiB, WS_K = 98 * MiB, WS_V = 130 * MiB, WS_GA = 162 * MiB, WS_U = 179 * MiB, WS_GS = 196 * MiB, WS_Z = 213 * MiB, WS_A2 = 230 * MiB, WS_END = 264 * MiB;
constexpr int TB_LAM = 0, TB_BIAS = 64  , TB_END = 64 + 512;
constexpr int CW_BAR = 4096;

constexpr int RING_OFF = 0, RING_BYTES = 131072;
constexpr int LDSCTL_OFF = RING_BYTES, MISC_OFF = LDSCTL_OFF + 320;
constexpr int LDS_BYTES = 147456;

#define GAS __attribute__((address_space(1)))
#define LAS __attribute__((address_space(3)))
typedef unsigned short bf16;
typedef unsigned v4u __attribute__((ext_vector_type(4)));
typedef float f32x4 __attribute__((ext_vector_type(4)));
typedef short bf16x8 __attribute__((ext_vector_type(8)));
typedef GAS unsigned gu32;
typedef GAS unsigned long long gu64;
#define RLX_AGENT __ATOMIC_RELAXED, __HIP_MEMORY_SCOPE_AGENT
#define LDS_WAIT() asm volatile("s_waitcnt lgkmcnt(0)" ::: "memory")
#define VM_WAIT() asm volatile("s_waitcnt vmcnt(0)" ::: "memory")
__device__ __forceinline__ unsigned long long rt() { return __builtin_amdgcn_s_memrealtime(); }
__device__ __forceinline__ unsigned f2bf(float f) { unsigned u = __builtin_bit_cast(unsigned, f); return (u + 0x7fffu + ((u >> 16) & 1u)) >> 16; }
__device__ __forceinline__ unsigned pk2(float lo, float hi) { return f2bf(lo) | (f2bf(hi) << 16); }

#define XB_TMO      128
#define XB_XCNT(j)  (256  + 64 * (j))
#define XB_XSUB(j)  (1280 + 64 * (j))
#define XB_XGEN(j)  (2304 + 64 * (j))
#define XB_TOP      3328
#define XB_TOPGEN   3392
#define XCD_BAR_WORDS 3456
#define XB_SPIN_CAP (1u << 18)

__device__ __forceinline__ unsigned xb_ld(unsigned* p)              { return __hip_atomic_load(p, __ATOMIC_RELAXED, __HIP_MEMORY_SCOPE_AGENT); }
__device__ __forceinline__ unsigned xb_add(unsigned* p, unsigned v) { return __hip_atomic_fetch_add(p, v, __ATOMIC_RELAXED, __HIP_MEMORY_SCOPE_AGENT); }
__device__ __forceinline__ unsigned xb_xcc_id() { return (unsigned)__builtin_amdgcn_s_getreg((3 << 11) | 20) & 0xFu; }
#define XB_SPIN(cond, bar) do { unsigned _sp = 0; while (cond) { __builtin_amdgcn_s_sleep(1); \
    if ((++_sp & 255u) == 0u) { if (xb_ld(&(bar)[XB_TMO])) break; if (_sp > XB_SPIN_CAP) { atomicAdd(&(bar)[XB_TMO], 1u); break; } } } } while (0)

struct XcdBarrier {
    unsigned* bar; unsigned x;
    volatile LAS unsigned* st;
};

__device__ __forceinline__ XcdBarrier xcd_barrier_post(unsigned* bar, volatile LAS unsigned* st) {
    XcdBarrier b; b.bar = bar; b.x = xb_xcc_id(); b.st = st;
    if (threadIdx.x == 0) (void)xb_add(&bar[XB_XCNT(b.x)], 1u);
    return b;
}
__device__ __forceinline__ void xcd_barrier_complete(unsigned* bar, unsigned x, unsigned& nloc, unsigned& nx) {
    const unsigned G = gridDim.x * gridDim.y * gridDim.z;
    unsigned sum, cnt, mine, sp = 0u;
    for (;;) {
        sum = 0u; cnt = 0u; mine = 0u;
#pragma unroll
        for (unsigned j = 0; j < 16; ++j) { const unsigned c = xb_ld(&bar[XB_XCNT(j)]); sum += c; cnt += (c > 0u) ? 1u : 0u; mine = (j == x) ? c : mine; }
        if (sum == G) break;
        __builtin_amdgcn_s_sleep(1);
        if ((++sp & 255u) == 0u) { if (xb_ld(&bar[XB_TMO])) break; if (sp > XB_SPIN_CAP) { atomicAdd(&bar[XB_TMO], 1u); break; } }
    }
    nloc = mine > 0u ? mine : 1u; nx = cnt > 0u ? cnt : 1u;
}

__device__ __forceinline__ void xcd_barrier(const XcdBarrier& b) {
    asm volatile("s_waitcnt vmcnt(0)" ::: "memory");
    __syncthreads();
    if (threadIdx.x == 0) {
        unsigned* bar = b.bar;
        __builtin_amdgcn_s_waitcnt(0);
        unsigned nloc = b.st[0], nx = b.st[1];
        if (nloc == 0u) { xcd_barrier_complete(bar, b.x, nloc, nx); b.st[0] = nloc; b.st[1] = nx; }
        const unsigned old = xb_add(&bar[XB_XSUB(b.x)], 1u);
        const unsigned gen = old / nloc;
        if (old + 1u == (gen + 1u) * nloc) {
            __builtin_amdgcn_fence(__ATOMIC_RELEASE, "agent");
            asm volatile("s_waitcnt vmcnt(0)" ::: "memory");
            const unsigned og = xb_add(&bar[XB_TOP], 1u);
            const unsigned tg = og / nx;
            if (og + 1u == (tg + 1u) * nx) xb_add(&bar[XB_TOPGEN], 1u);
            else XB_SPIN(xb_ld(&bar[XB_TOPGEN]) == tg, bar);
            __builtin_amdgcn_fence(__ATOMIC_ACQUIRE, "agent");
            xb_add(&bar[XB_XGEN(b.x)], 1u);
            asm volatile("s_waitcnt vmcnt(0)" ::: "memory");
        } else {
            XB_SPIN(xb_ld(&bar[XB_XGEN(b.x)]) == gen, bar);
            __builtin_amdgcn_fence(__ATOMIC_ACQUIRE, "agent");
            asm volatile("s_waitcnt vmcnt(0)" ::: "memory");
        }
    }
    __syncthreads();
}

__device__ __forceinline__ float wave_sum(float v) {
#pragma unroll
    for (int o = 1; o < 64; o <<= 1) v += __shfl_xor(v, o);
    return v;
}
__device__ __forceinline__ void p0_transpose_item(const float* W, int K, int N, bf16* WT, bool permute, LAS float* scr, int item, int lane) {
    const int nblk = N / 32, kb = item / nblk, nb = item % nblk, k0 = 64 * kb, n0 = 32 * nb;
    int d0 = n0; if (permute) { const int a = n0 & 255; d0 = (n0 & ~255) + 128 * ((a >> 5) & 1) + 32 * (a >> 6); }
#pragma unroll 8
    for (int i = 0; i < 32; ++i) { const int kk = 2 * i + (lane >> 5); scr[kk * 33 + (lane & 31)] = W[(size_t)(k0 + kk) * N + n0 + (lane & 31)]; }
    LDS_WAIT(); asm volatile("" ::: "memory");
    const int c = lane & 7;
#pragma unroll
    for (int j = 0; j < 4; ++j) { const int n = (lane >> 3) + 8 * j; const LAS float* s = scr + (8 * c) * 33 + n;
        v4u o; o.x = pk2(s[0 * 33], s[1 * 33]); o.y = pk2(s[2 * 33], s[3 * 33]); o.z = pk2(s[4 * 33], s[5 * 33]); o.w = pk2(s[6 * 33], s[7 * 33]);
        *(GAS v4u*)(WT + (size_t)(d0 + n) * K + k0 + 8 * c) = o; }
    LDS_WAIT(); asm volatile("" ::: "memory");
}
__device__ __forceinline__ void rms_row_to_bf16(const float* xrow, const float* g, bf16* orow, int lane) {
    const GAS f32x4* xr = (const GAS f32x4*)xrow + lane; const GAS f32x4* gr = (const GAS f32x4*)g + lane;
    f32x4 v[4]; float s = 0.f;
#pragma unroll
    for (int j = 0; j < 4; ++j) { v[j] = xr[64 * j]; s += (v[j].x * v[j].x + v[j].y * v[j].y) + (v[j].z * v[j].z + v[j].w * v[j].w); }
    const float rs = rsqrtf(wave_sum(s) * (1.f / DM) + EPS);
    GAS unsigned long long* o8 = (GAS unsigned long long*)orow + lane;
#pragma unroll
    for (int j = 0; j < 4; ++j) { const f32x4 gg = gr[64 * j]; const f32x4 y = v[j] * rs * gg;
        o8[64 * j] = (unsigned long long)pk2(y.x, y.y) | ((unsigned long long)pk2(y.z, y.w) << 32); }
}
__device__ __forceinline__ int t5_bucket(int n) {
    if (n < 16) return n;
    int b = 16;
    b += (n >= 19); b += (n >= 21); b += (n >= 24); b += (n >= 27); b += (n >= 31); b += (n >= 35); b += (n >= 40); b += (n >= 46);
    b += (n >= 52); b += (n >= 59); b += (n >= 67); b += (n >= 77); b += (n >= 87); b += (n >= 99); b += (n >= 113);
    return b;
}

typedef float f32x16 __attribute__((ext_vector_type(16)));
typedef float f32x2 __attribute__((ext_vector_type(2)));
typedef unsigned u32x2 __attribute__((ext_vector_type(2)));
typedef unsigned u32x4 __attribute__((ext_vector_type(4)));
__device__ __forceinline__ float bf_lo(unsigned w) { return __uint_as_float(w << 16); }
__device__ __forceinline__ float bf_hi(unsigned w) { return __uint_as_float(w & 0xffff0000u); }
__device__ __forceinline__ unsigned pkbf(float lo, float hi) { return pg8::cvt_pk_bf16(lo, hi); }
__device__ __forceinline__ float ex2(float x) { return __builtin_amdgcn_exp2f(x); }
template <int CTRL> __device__ __forceinline__ float dppf(float x) { return __builtin_bit_cast(float, __builtin_amdgcn_mov_dpp(__builtin_bit_cast(int, x), CTRL, 0xf, 0xf, true)); }
__device__ __forceinline__ float sum16(float v) { v += dppf<0xB1>(v); v += dppf<0x4E>(v); v += dppf<0x141>(v); v += dppf<0x128>(v); return v; }
__device__ __forceinline__ float bc_lo(float x) { auto r = __builtin_amdgcn_permlane32_swap(__float_as_uint(x), __float_as_uint(x), false, false); return __uint_as_float(r[0]); }
__device__ __forceinline__ float bc_hi(float x) { auto r = __builtin_amdgcn_permlane32_swap(__float_as_uint(x), __float_as_uint(x), false, false); return __uint_as_float(r[1]); }
__device__ __forceinline__ void cfma(float& xr, float& xi, float ar, float ai, float br, float bi) { xr = fmaf(ar, br, fmaf(-ai, bi, xr)); xi = fmaf(ar, bi, fmaf(ai, br, xi)); }
__device__ __forceinline__ float gelu_tanh_f(float x) { const float t = 1.5957691216057308f * (x + 0.044715f * x * x * x); return x * __builtin_amdgcn_rcpf(1.0f + __expf(-t)); }

constexpr size_t OFF_TP = 4096, OFF_TA256 = OFF_TP + 65536, OFF_TBF = OFF_TA256 + 16384, OFF_TBB = OFF_TBF + 262144, OFF_TCC = OFF_TBB + 131072, OFF_TEND = OFF_TCC + 131072;
static_assert(OFF_TEND <= (1u << 20), "tables fit");
constexpr size_t WS_KS = 15 * MiB, WS_VS = 13 * MiB;
constexpr size_t WS_PML = WS_PART + 8 * MiB;
constexpr int BT_LDS_OFF = 114688;
constexpr int HROW = 68;

template <bool FULL> __device__ __forceinline__ void ssm_scan_state(f32x16& xr, f32x16& xi, const float (&pw)[8], float& cr, float& ci, bool hi_half) {
#pragma unroll
    for (int i = 0; i < 4; ++i)
#pragma unroll
        for (int j = 1; j < 4; ++j) { float a = xr[4 * i + j], b = xi[4 * i + j]; cfma(a, b, pw[0], pw[1], xr[4 * i + j - 1], xi[4 * i + j - 1]); xr[4 * i + j] = a; xi[4 * i + j] = b; }
    float cinr[4], cini[4];
#pragma unroll
    for (int i = 0; i < 4; ++i) {
        float t0r = xr[4 * i + 3], t0i = xi[4 * i + 3]; cfma(t0r, t0i, pw[6], pw[7], cr, ci);
        const float sr = bc_lo(t0r), si = bc_lo(t0i);
        cinr[i] = hi_half ? sr : cr; cini[i] = hi_half ? si : ci;
        float t1r = xr[4 * i + 3], t1i = xi[4 * i + 3]; cfma(t1r, t1i, pw[6], pw[7], sr, si);
        cr = bc_hi(t1r); ci = bc_hi(t1i);
    }
    if (FULL) {
#pragma unroll
        for (int i = 0; i < 4; ++i)
#pragma unroll
            for (int j = 0; j < 4; ++j) { float a = xr[4 * i + j], b = xi[4 * i + j]; cfma(a, b, pw[2 * j], pw[2 * j + 1], cinr[i], cini[i]); xr[4 * i + j] = a; xi[4 * i + j] = b; }
    }
}

template <bool FULL> __device__ __forceinline__ void ssm_chunk(int b, int chunk, int g, const unsigned char* tab, const bf16* U, float* E, const float* dsk, bf16* Z, float* out, int wmask, LAS unsigned* Hs, int lane) {
    const int r = lane & 31, hh = lane >> 5;
    bf16x8 Bf[4];
#pragma unroll
    for (int X = 0; X < 4; ++X) Bf[X] = *(const bf16x8*)(tab + OFF_TBB + ((size_t)(g * 4 + X) * 64 + lane) * 16);
    float pwl[8], pwh[8];
    { const f32x4* p = (const f32x4*)(tab + OFF_TP + (size_t)(g * 64 + r) * 32); const f32x4 a = p[0], c = p[1]; pwl[0] = a.x; pwl[1] = a.y; pwl[2] = a.z; pwl[3] = a.w; pwl[4] = c.x; pwl[5] = c.y; pwl[6] = c.z; pwl[7] = c.w; }
    { const f32x4* p = (const f32x4*)(tab + OFF_TP + (size_t)(g * 64 + 32 + r) * 32); const f32x4 a = p[0], c = p[1]; pwh[0] = a.x; pwh[1] = a.y; pwh[2] = a.z; pwh[3] = a.w; pwh[4] = c.x; pwh[5] = c.y; pwh[6] = c.z; pwh[7] = c.w; }
    float clr = 0.f, cli = 0.f, chr = 0.f, chi = 0.f;
    bf16x8 Cf[4]; f32x4 dv = {0.f, 0.f, 0.f, 0.f};
    if (FULL) {
        const f32x2 al = *(const f32x2*)(tab + OFF_TA256 + (size_t)(g * 64 + r) * 8), ah = *(const f32x2*)(tab + OFF_TA256 + (size_t)(g * 64 + 32 + r) * 8);
        for (int j = 0; j < chunk; ++j) {
            const float* e = E + ((size_t)((b * 32 + j) * 32 + g) * 64) * 2;
            const f32x2 el = *(const f32x2*)(e + 2 * r), eh = *(const f32x2*)(e + 2 * (32 + r));
            float nr = el.x, ni = el.y; cfma(nr, ni, al.x, al.y, clr, cli); clr = nr; cli = ni;
            float mr = eh.x, mi = eh.y; cfma(mr, mi, ah.x, ah.y, chr, chi); chr = mr; chi = mi;
        }
#pragma unroll
        for (int s = 0; s < 4; ++s) Cf[s] = *(const bf16x8*)(tab + OFF_TCC + ((size_t)(g * 4 + s) * 64 + lane) * 16);
        dv = *(const f32x4*)(dsk + g * 16 + 4 * (lane >> 4));
    }
    const size_t row_c = (size_t)b * SEQ + (size_t)chunk * 256;
    for (int tile = 0; tile < 8; ++tile) {
        const size_t row0 = row_c + tile * 32;
        const bf16x8 uf = *(const bf16x8*)(U + (row0 + r) * DH + 16 * g + 8 * hh);
        const f32x16 zero = {};
        f32x16 X0 = __builtin_amdgcn_mfma_f32_32x32x16_bf16(uf, Bf[0], zero, 0, 0, 0);
        f32x16 X1 = __builtin_amdgcn_mfma_f32_32x32x16_bf16(uf, Bf[1], zero, 0, 0, 0);
        f32x16 X2 = __builtin_amdgcn_mfma_f32_32x32x16_bf16(uf, Bf[2], zero, 0, 0, 0);
        f32x16 X3 = __builtin_amdgcn_mfma_f32_32x32x16_bf16(uf, Bf[3], zero, 0, 0, 0);
        ssm_scan_state<FULL>(X0, X2, pwl, clr, cli, hh != 0);
        ssm_scan_state<FULL>(X1, X3, pwh, chr, chi, hh != 0);
        if (FULL) {
#pragma unroll
            for (int q = 0; q < 16; ++q) { const int t = (q & 3) + 8 * (q >> 2) + 4 * hh;
                Hs[t * HROW + r] = pkbf(X0[q], X2[q]); Hs[t * HROW + 32 + r] = pkbf(X1[q], X3[q]); }
            asm volatile("s_waitcnt lgkmcnt(0)" ::: "memory");
#pragma unroll
            for (int nb = 0; nb < 2; ++nb) {
                f32x4 acc = {0.f, 0.f, 0.f, 0.f};
#pragma unroll
                for (int s = 0; s < 4; ++s) { const bf16x8 hf = *(const LAS bf16x8*)(Hs + (16 * nb + (lane & 15)) * HROW + 16 * s + 4 * (lane >> 4));
                    acc = __builtin_amdgcn_mfma_f32_16x16x32_bf16(Cf[s], hf, acc, 0, 0, 0); }
                const size_t row = row0 + 16 * nb + (lane & 15); const int col = 16 * g + 4 * (lane >> 4);
                const u32x2 uw = *(const u32x2*)(U + row * DH + col);
                const float y0 = acc[0] + dv[0] * bf_lo(uw.x), y1 = acc[1] + dv[1] * bf_hi(uw.x), y2 = acc[2] + dv[2] * bf_lo(uw.y), y3 = acc[3] + dv[3] * bf_hi(uw.y);
                u32x2 zw; zw.x = pkbf(gelu_tanh_f(y0), gelu_tanh_f(y1)); zw.y = pkbf(gelu_tanh_f(y2), gelu_tanh_f(y3));
                *(u32x2*)(Z + row * DH + col) = zw;
            }
            asm volatile("s_waitcnt lgkmcnt(0)" ::: "memory");
        }
    }
    if (!FULL) {
        if (hh == 0) { float* e = E + ((size_t)((b * 32 + chunk) * 32 + g) * 64) * 2; *(f32x2*)(e + 2 * r) = (f32x2){clr, cli}; *(f32x2*)(e + 2 * (32 + r)) = (f32x2){chr, chi}; }
    } else if (chunk == 31 && (wmask & 2) && hh == 0) {
        const int o = (b * 32 + g) * 64;
        out[O_SRP + o + r] = clr; out[O_SIP + o + r] = cli; out[O_SRP + o + 32 + r] = chr; out[O_SIP + o + 32 + r] = chi;
    }
}

__device__ __forceinline__ void ssm_sample_item(int b, int g, const unsigned char* tab, const bf16* U, const float* h0re, const float* h0im, const float* cre, const float* cim, const float* dsk,
                                                bf16* Z, float* out, int wmask, int p) {
    const f32x2 a1 = *(const f32x2*)(tab + OFF_TP + (size_t)(g * 64 + p) * 32);
    float bbr[16], bbi[16], cr[16], ci[16];
    { const f32x4* t = (const f32x4*)(tab + OFF_TBF + (size_t)(g * 64 + p) * 128);
#pragma unroll
      for (int k = 0; k < 4; ++k) { const f32x4 x = t[k], y = t[4 + k]; bbr[4 * k] = x.x; bbr[4 * k + 1] = x.y; bbr[4 * k + 2] = x.z; bbr[4 * k + 3] = x.w; bbi[4 * k] = y.x; bbi[4 * k + 1] = y.y; bbi[4 * k + 2] = y.z; bbi[4 * k + 3] = y.w; } }
#pragma unroll
    for (int c = 0; c < 16; ++c) { cr[c] = cre[(g * 16 + c) * 64 + p]; ci[c] = cim[(g * 16 + c) * 64 + p]; }
    float hr = h0re[(b * 32 + g) * 64 + p], hi = h0im[(b * 32 + g) * 64 + p];
    const float dd = dsk[g * 16 + (p & 15)];
    for (int t = 0; t < 4; ++t) {
        const size_t row = (size_t)MP + b * 4 + t;
        const u32x4 w0 = *(const u32x4*)(U + row * DH + 16 * g), w1 = *(const u32x4*)(U + row * DH + 16 * g + 8);
        float u[16];
        u[0] = bf_lo(w0.x); u[1] = bf_hi(w0.x); u[2] = bf_lo(w0.y); u[3] = bf_hi(w0.y); u[4] = bf_lo(w0.z); u[5] = bf_hi(w0.z); u[6] = bf_lo(w0.w); u[7] = bf_hi(w0.w);
        u[8] = bf_lo(w1.x); u[9] = bf_hi(w1.x); u[10] = bf_lo(w1.y); u[11] = bf_hi(w1.y); u[12] = bf_lo(w1.z); u[13] = bf_hi(w1.z); u[14] = bf_lo(w1.w); u[15] = bf_hi(w1.w);
        float ur = 0.f, ui = 0.f;
#pragma unroll
        for (int c = 0; c < 16; ++c) { ur = fmaf(bbr[c], u[c], ur); ui = fmaf(bbi[c], u[c], ui); }
        cfma(ur, ui, a1.x, a1.y, hr, hi); hr = ur; hi = ui;
        float yv = 0.f, uc = 0.f;
#pragma unroll
        for (int c = 0; c < 16; ++c) { const float s = wave_sum(cr[c] * hr - ci[c] * hi); if (p == c) { yv = s; uc = u[c]; } }
        if (p < 16) { const float z = gelu_tanh_f(yv + dd * uc); Z[row * DH + 16 * g + p] = (bf16)(pkbf(z, z) & 0xffffu); }
    }
    if (wmask & 4) { out[O_SRS + (b * 32 + g) * 64 + p] = hr; out[O_SIS + (b * 32 + g) * 64 + p] = hi; }
}

struct DecAcc { float m, l; f32x4 o0[4], o1[4]; };
template <int Q> __device__ __forceinline__ float quad_bc(float x) { return dppf<Q * 0x55>(x); }
__device__ __forceinline__ void dec_key(DecAcc& A, const f32x4 (&qv)[4], const f32x4 kv, const f32x4 v0, const f32x4 v1, bool near, int key, const float* bt, bool b0, bool b1, int qi_l) {
    float d[4];
#pragma unroll
    for (int qi = 0; qi < 4; ++qi) d[qi] = fmaf(kv.w, qv[qi].w, fmaf(kv.z, qv[qi].z, fmaf(kv.y, qv[qi].y, kv.x * qv[qi].x)));
    const float ka = b0 ? d[1] : d[0], sa = b0 ? d[0] : d[1], kb = b0 ? d[3] : d[2], sb = b0 ? d[2] : d[3];
    const float ra = ka + dppf<0xB1>(sa), rb = kb + dppf<0xB1>(sb);
    const float k2 = b1 ? rb : ra, s2 = b1 ? ra : rb;
    float s = k2 + dppf<0x4E>(s2);
    s += dppf<0x124>(s); s += dppf<0x128>(s);
    if (near) { const int dd = 128 + qi_l - key; s += bt[dd > 127 ? 127 : dd]; }
    if (__any(s > A.m + 8.0f)) {
        const float mn = fmaxf(A.m, s), a = ex2(A.m - mn); A.l *= a; A.m = mn;
        const float a0 = quad_bc<0>(a), a1 = quad_bc<1>(a), a2 = quad_bc<2>(a), a3 = quad_bc<3>(a);
        A.o0[0] = A.o0[0] * a0; A.o1[0] = A.o1[0] * a0; A.o0[1] = A.o0[1] * a1; A.o1[1] = A.o1[1] * a1; A.o0[2] = A.o0[2] * a2; A.o1[2] = A.o1[2] * a2; A.o0[3] = A.o0[3] * a3; A.o1[3] = A.o1[3] * a3;
    }
    const float p = ex2(s - A.m); A.l += p;
    const float p0 = quad_bc<0>(p), p1 = quad_bc<1>(p), p2 = quad_bc<2>(p), p3 = quad_bc<3>(p);
    A.o0[0] = A.o0[0] + v0 * p0; A.o1[0] = A.o1[0] + v1 * p0; A.o0[1] = A.o0[1] + v0 * p1; A.o1[1] = A.o1[1] + v1 * p1;
    A.o0[2] = A.o0[2] + v0 * p2; A.o1[2] = A.o1[2] + v1 * p2; A.o0[3] = A.o0[3] + v0 * p3; A.o1[3] = A.o1[3] + v1 * p3;
}
__device__ __forceinline__ void decode_item(int b, int h, int sp, const float* QS, const float* ck, const float* cv, const int* pt, const float* bt, float* PO, float* PML, int lane) {
    const int hh = lane >> 5, cg = (lane >> 4) & 1, i16 = lane & 15;
    f32x4 qv[4];
#pragma unroll
    for (int qi = 0; qi < 4; ++qi) qv[qi] = *(const f32x4*)(QS + (size_t)(b * 4 + qi) * DH + h * 128 + cg * 64 + 4 * i16);
    DecAcc A;
#pragma unroll
    for (int qi = 0; qi < 4; ++qi) { A.o0[qi] = (f32x4){0.f, 0.f, 0.f, 0.f}; A.o1[qi] = (f32x4){0.f, 0.f, 0.f, 0.f}; }
    A.m = -1e30f; A.l = 0.f;
    const bool b0 = (lane & 1) != 0, b1 = (lane & 2) != 0; const int qi_l = lane & 3;
    int pg[4];
#pragma unroll
    for (int i = 0; i < 4; ++i) pg[i] = __builtin_amdgcn_readfirstlane(pt[b * NPAGES + sp * 4 + i]);
    const size_t koff = (size_t)h * 128 + cg * 64 + 4 * i16 + (size_t)hh * 512, voff = (size_t)h * 128 + 4 * i16 + (size_t)hh * 512;
    f32x4 kA[2], vA[2], wA[2], kB[2], vB[2], wB[2], kC[2], vC[2], wC[2], kD[2], vD[2], wD[2];
#define DEC_LOAD(KQ, VA, VC, g) do { const int pgi_ = (g) >> 5; const int pgn_ = pgi_ == 0 ? pg[0] : pgi_ == 1 ? pg[1] : pgi_ == 2 ? pg[2] : pg[3]; \
        const float* kb_ = ck + (size_t)pgn_ * (PAGE * 512) + koff + (size_t)((g) & 31) * 2048; const float* vb_ = cv + (size_t)pgn_ * (PAGE * 512) + voff + (size_t)((g) & 31) * 2048; \
        _Pragma("unroll") for (int u = 0; u < 2; ++u) { KQ[u] = __builtin_nontemporal_load((const f32x4*)(kb_ + u * 1024)); VA[u] = __builtin_nontemporal_load((const f32x4*)(vb_ + u * 1024)); \
            VC[u] = __builtin_nontemporal_load((const f32x4*)(vb_ + u * 1024 + 64)); } } while (0)
#define DEC_MATH(KQ, VA, VC, g) do { const bool near_ = (sp == 3) && ((g) >> 5) == 3; const int it0_ = ((g) & 31) * 2; \
        _Pragma("unroll") for (int u = 0; u < 2; ++u) dec_key(A, qv, KQ[u], VA[u], VC[u], near_, 2 * (it0_ + u) + hh, bt, b0, b1, qi_l); } while (0)
    DEC_LOAD(kA, vA, wA, 0); DEC_LOAD(kB, vB, wB, 1); DEC_LOAD(kC, vC, wC, 2);
    for (int g = 0; g < 128; g += 4) {
        DEC_LOAD(kD, vD, wD, g + 3);
        DEC_MATH(kA, vA, wA, g);
        if (g + 4 < 128) DEC_LOAD(kA, vA, wA, g + 4);
        DEC_MATH(kB, vB, wB, g + 1);
        if (g + 5 < 128) DEC_LOAD(kB, vB, wB, g + 5);
        DEC_MATH(kC, vC, wC, g + 2);
        if (g + 6 < 128) DEC_LOAD(kC, vC, wC, g + 6);
        DEC_MATH(kD, vD, wD, g + 3);
    }
#undef DEC_LOAD
#undef DEC_MATH
    {
        const float mo = __shfl_xor(A.m, 32), lo = __shfl_xor(A.l, 32), mn = fmaxf(A.m, mo), a = ex2(A.m - mn), ao = ex2(mo - mn);
        A.l = A.l * a + lo * ao; A.m = mn;
        float aq[4], aoq[4];
        aq[0] = quad_bc<0>(a); aq[1] = quad_bc<1>(a); aq[2] = quad_bc<2>(a); aq[3] = quad_bc<3>(a);
        aoq[0] = quad_bc<0>(ao); aoq[1] = quad_bc<1>(ao); aoq[2] = quad_bc<2>(ao); aoq[3] = quad_bc<3>(ao);
#pragma unroll
        for (int qi = 0; qi < 4; ++qi)
#pragma unroll
            for (int e = 0; e < 4; ++e) { A.o0[qi][e] = A.o0[qi][e] * aq[qi] + __shfl_xor(A.o0[qi][e], 32) * aoq[qi]; A.o1[qi][e] = A.o1[qi][e] * aq[qi] + __shfl_xor(A.o1[qi][e], 32) * aoq[qi]; }
    }
    if (hh == 0) {
#pragma unroll
        for (int qi = 0; qi < 4; ++qi) { const size_t pi = (size_t)((((b * 4 + h) * 4 + sp) * 2 + cg) * 4 + qi);
            *(f32x4*)(PO + pi * 128 + 4 * i16) = A.o0[qi]; *(f32x4*)(PO + pi * 128 + 64 + 4 * i16) = A.o1[qi]; }
        if (i16 < 4) { const size_t pi = (size_t)((((b * 4 + h) * 4 + sp) * 2 + cg) * 4 + i16); PML[2 * pi] = A.m; PML[2 * pi + 1] = A.l; }
    }
}

__device__ __forceinline__ void combine_sample(int sr, int h, const float* QS, const float* KS, const float* VS, const float* PO, const float* PML, const float* bt, float lam, const float* subg,
                                               const bf16* GA, bf16* A2, int lane) {
    const int b = sr >> 2, qi = sr & 3;
    float oc[2][2];
#pragma unroll
    for (int c = 0; c < 2; ++c) {
        const float qd = QS[(size_t)sr * DH + h * 128 + c * 64 + lane];
        float sj[4];
#pragma unroll
        for (int j = 0; j < 4; ++j) { const float kd = KS[(size_t)(b * 4 + j) * DH + h * 128 + c * 64 + lane]; const float s = wave_sum(qd * kd); sj[j] = j <= qi ? s + bt[qi - j] : -1e30f; }
        float mp[4], lp[4]; float M = fmaxf(fmaxf(sj[0], sj[1]), fmaxf(sj[2], sj[3]));
#pragma unroll
        for (int sp = 0; sp < 4; ++sp) { const size_t pi = (size_t)((((b * 4 + h) * 4 + sp) * 2 + c) * 4 + qi); mp[sp] = PML[2 * pi]; lp[sp] = PML[2 * pi + 1]; M = fmaxf(M, mp[sp]); }
        float Lsum = 0.f, o0 = 0.f, o1 = 0.f;
#pragma unroll
        for (int sp = 0; sp < 4; ++sp) { const size_t pi = (size_t)((((b * 4 + h) * 4 + sp) * 2 + c) * 4 + qi); const float w = ex2(mp[sp] - M); Lsum += lp[sp] * w;
            const f32x2 po = *(const f32x2*)(PO + pi * 128 + 2 * lane); o0 += po.x * w; o1 += po.y * w; }
#pragma unroll
        for (int j = 0; j < 4; ++j) { const float w = j <= qi ? ex2(sj[j] - M) : 0.f; Lsum += w; const f32x2 vv = *(const f32x2*)(VS + (size_t)(b * 4 + j) * DH + h * 128 + 2 * lane); o0 += vv.x * w; o1 += vv.y * w; }
        const float inv = 1.0f / Lsum; oc[c][0] = o0 * inv; oc[c][1] = o1 * inv;
    }
    const float d0 = oc[0][0] - lam * oc[1][0], d1 = oc[0][1] - lam * oc[1][1];
    const float rs = rsqrtf(wave_sum(d0 * d0 + d1 * d1) * (1.0f / 128.0f) + EPS);
    const size_t row = (size_t)MP + sr;
    const unsigned gw = *(const unsigned*)(GA + row * DH + h * 128 + 2 * lane);
    const f32x2 sg = *(const f32x2*)(subg + 2 * lane);
    *(unsigned*)(A2 + row * DM + h * 128 + 2 * lane) = pkbf(d0 * rs * sg.x * 0.8f * bf_lo(gw), d1 * rs * sg.y * 0.8f * bf_hi(gw));
}
__device__ __forceinline__ void combine_prompt_row(size_t row, const bf16* Op, const bf16* GA, float lam, const f32x4 sg0, const f32x4 sg1, bf16* A2, int lane) {
    const int h = lane >> 4, e0 = 8 * (lane & 15);
    const u32x4 a = *(const u32x4*)(Op + row * DM + h * 256 + e0), bq = *(const u32x4*)(Op + row * DM + h * 256 + 128 + e0), gq = *(const u32x4*)(GA + row * DH + h * 128 + e0);
    float d[8];
    d[0] = bf_lo(a.x) - lam * bf_lo(bq.x); d[1] = bf_hi(a.x) - lam * bf_hi(bq.x); d[2] = bf_lo(a.y) - lam * bf_lo(bq.y); d[3] = bf_hi(a.y) - lam * bf_hi(bq.y);
    d[4] = bf_lo(a.z) - lam * bf_lo(bq.z); d[5] = bf_hi(a.z) - lam * bf_hi(bq.z); d[6] = bf_lo(a.w) - lam * bf_lo(bq.w); d[7] = bf_hi(a.w) - lam * bf_hi(bq.w);
    float ss = 0.f;
#pragma unroll
    for (int e = 0; e < 8; ++e) ss += d[e] * d[e];
    const float rs = rsqrtf(sum16(ss) * (1.0f / 128.0f) + EPS) * 0.8f;
    u32x4 o;
    o.x = pkbf(d[0] * rs * sg0.x * bf_lo(gq.x), d[1] * rs * sg0.y * bf_hi(gq.x)); o.y = pkbf(d[2] * rs * sg0.z * bf_lo(gq.y), d[3] * rs * sg0.w * bf_hi(gq.y));
    o.z = pkbf(d[4] * rs * sg1.x * bf_lo(gq.z), d[5] * rs * sg1.y * bf_hi(gq.z)); o.w = pkbf(d[6] * rs * sg1.z * bf_lo(gq.w), d[7] * rs * sg1.w * bf_hi(gq.w));
    *(u32x4*)(A2 + row * DM + h * 128 + e0) = o;
}

__device__ __forceinline__ const void* ldsarg(LAS unsigned char* L, int i) {
    const LAS unsigned* p = (const LAS unsigned*)(L + LDSCTL_OFF) + 2 * i;
    const unsigned lo = __builtin_amdgcn_readfirstlane(p[0]), hi = __builtin_amdgcn_readfirstlane(p[1]);
    return (const void*)(((unsigned long long)hi << 32) | lo);
}
constexpr int RED_ROW = 68;
template <int K> __device__ __forceinline__ f32x4 coop_tile(const bf16* W0, const bf16* W1, const bf16* X, LAS float* red, int wave, int lane) {
    constexpr int KS = K / 8, NI = KS / 64;
    const int r = lane & 31, hh = lane >> 5;
    const bf16* wa = W0 + (size_t)r * K + wave * KS + 8 * hh; const bf16* wb = W1 + (size_t)r * K + wave * KS + 8 * hh; const bf16* xa = X + (size_t)r * K + wave * KS + 8 * hh;
    bf16x8 a0[NI][4], a1[NI][4], bb[NI][4];
#pragma unroll
    for (int i = 0; i < NI; ++i)
#pragma unroll
        for (int s = 0; s < 4; ++s) { a0[i][s] = *(const bf16x8*)(wa + i * 64 + 16 * s); a1[i][s] = *(const bf16x8*)(wb + i * 64 + 16 * s); bb[i][s] = *(const bf16x8*)(xa + i * 64 + 16 * s); }
    __builtin_amdgcn_sched_barrier(0);
    f32x16 D0 = {}, D1 = {};
#pragma unroll
    for (int i = 0; i < NI; ++i)
#pragma unroll
        for (int s = 0; s < 4; ++s) { D0 = __builtin_amdgcn_mfma_f32_32x32x16_bf16(a0[i][s], bb[i][s], D0, 0, 0, 0); D1 = __builtin_amdgcn_mfma_f32_32x32x16_bf16(a1[i][s], bb[i][s], D1, 0, 0, 0); }
    LAS float* mine = red + (wave * 32 + r) * RED_ROW + 4 * hh;
#pragma unroll
    for (int q4 = 0; q4 < 4; ++q4) {
        *(LAS f32x4*)(mine + 8 * q4) = (f32x4){D0[4 * q4], D0[4 * q4 + 1], D0[4 * q4 + 2], D0[4 * q4 + 3]};
        *(LAS f32x4*)(mine + 32 + 8 * q4) = (f32x4){D1[4 * q4], D1[4 * q4 + 1], D1[4 * q4 + 2], D1[4 * q4 + 3]};
    }
    __syncthreads();
    const int token = (wave * 64 + lane) >> 4, col4 = lane & 15;
    f32x4 acc = {0.f, 0.f, 0.f, 0.f};
#pragma unroll
    for (int w = 0; w < 8; ++w) acc = acc + *(const LAS f32x4*)(red + (w * 32 + token) * RED_ROW + 4 * col4);
    __syncthreads();
    return acc;
}
__device__ __forceinline__ void sample_inproj_tile(int j, int mb, const bf16* WinT, const bf16* XN, const float* qg, const float* kg, float* QS, float* KS, float* VS, bf16* GA, bf16* U, bf16* GS, float* out, int wmask,
                                                   LAS float* red, int wave, int lane) {
    const int n0 = 64 * j, pn = n0 >> 8, wc = (n0 & 255) >> 6, R0 = 256 * pn + 32 * wc;
    f32x4 v = coop_tile<DM>(WinT + (size_t)R0 * DM, WinT + (size_t)(R0 + 128) * DM, XN + (size_t)(MP + 32 * mb) * DM, red, wave, lane);
    const int kind = j >> 3, srow = 32 * mb + ((wave * 64 + lane) >> 4), d = 4 * (lane & 15);
    const size_t o = (size_t)srow * DH + 64 * (j & 7) + d;
    if (kind <= 1) {
        const float ss = sum16((v.x * v.x + v.y * v.y) + (v.z * v.z + v.w * v.w));
        const float rs = rsqrtf(ss * (1.0f / 64.0f) + EPS) * (kind == 0 ? C2 : 1.0f);
        const f32x4 g = *(const f32x4*)((kind == 0 ? qg : kg) + d);
        v = v * rs * g;
        if (kind == 0) *(f32x4*)(QS + o) = v;
        else { *(f32x4*)(KS + o) = v; if (wmask & 1) *(f32x4*)(out + O_KS + o) = v; }
    } else if (kind == 2) { *(f32x4*)(VS + o) = v; if (wmask & 1) *(f32x4*)(out + O_VS + o) = v; }
    else {
        if (kind != 4) { v.x = pg8::silu_f(v.x); v.y = pg8::silu_f(v.y); v.z = pg8::silu_f(v.z); v.w = pg8::silu_f(v.w); }
        bf16* dst = kind == 3 ? GA : (kind == 4 ? U : GS);
        u32x2 w; w.x = pkbf(v.x, v.y); w.y = pkbf(v.z, v.w);
        *(u32x2*)(dst + (size_t)MP * DH + o) = w;
    }
}
__device__ __forceinline__ void sample_glu_tile(int j, int mb, const bf16* WgluT, const bf16* Z, const bf16* GS, const float* bglu, bf16* A2, LAS float* red, int wave, int lane) {
    const f32x4 v = coop_tile<DH>(WgluT + (size_t)(64 * j) * DH, WgluT + (size_t)(64 * j + 32) * DH, Z + (size_t)(MP + 32 * mb) * DH, red, wave, lane);
    const size_t row = (size_t)MP + 32 * mb + ((wave * 64 + lane) >> 4); const int col = 64 * j + 4 * (lane & 15);
    const f32x4 bv = *(const f32x4*)(bglu + col);
    const u32x2 zz = *(const u32x2*)(Z + row * DH + col), gg = *(const u32x2*)(GS + row * DH + col);
    const float o0 = bf_lo(zz.x) * pg8::sigmoid_f(v.x + bv.x) * bf_lo(gg.x), o1 = bf_hi(zz.x) * pg8::sigmoid_f(v.y + bv.y) * bf_hi(gg.x);
    const float o2 = bf_lo(zz.y) * pg8::sigmoid_f(v.z + bv.z) * bf_lo(gg.y), o3 = bf_hi(zz.y) * pg8::sigmoid_f(v.w + bv.w) * bf_hi(gg.y);
    u32x2 w; w.x = pkbf(o0, o1); w.y = pkbf(o2, o3);
    *(u32x2*)(A2 + row * DM + DH + col) = w;
}
__device__ __forceinline__ void sample_out_tile(int j, int mb, const bf16* WoutT, const bf16* A2, const float* xs, float* out, int wmask, LAS float* red, int wave, int lane) {
    const f32x4 v = coop_tile<DM>(WoutT + (size_t)(64 * j) * DM, WoutT + (size_t)(64 * j + 32) * DM, A2 + (size_t)(MP + 32 * mb) * DM, red, wave, lane);
    if (!(wmask & 8)) return;
    const size_t srow = (size_t)32 * mb + ((wave * 64 + lane) >> 4); const int col = 64 * j + 4 * (lane & 15);
    const f32x4 xv = *(const f32x4*)(xs + srow * DM + col);
    *(f32x4*)(out + O_YS + srow * DM + col) = xv + v;
}

__device__ __forceinline__ int opaque_lane() { int l = threadIdx.x & 63; asm volatile("" : "+v"(l)); return l; }
__device__ __forceinline__ unsigned char* opaque_ptr(unsigned char* p) { GAS unsigned char* g = (GAS unsigned char*)p; asm volatile("" : "+s"(g)); return (unsigned char*)g; }
#ifndef PROBE_SEG
#define PROBE_SEG 0
#endif
#define SEG_BEGIN(id) unsigned long long seg_t0_##id = 0; if (PROBE_SEG == (id)) { __syncthreads(); seg_t0_##id = __builtin_amdgcn_s_memrealtime(); }
#define SEG_END(id) if (PROBE_SEG == (id)) { __syncthreads(); const unsigned long long t1_ = __builtin_amdgcn_s_memrealtime(), d_ = 4ull * (t1_ - seg_t0_##id); while (__builtin_amdgcn_s_memrealtime() - t1_ < d_) __builtin_amdgcn_s_sleep(8); __syncthreads(); }
struct Args { const void* in[28]; float* out; unsigned char* ws; int wmask; int pad; };

__global__ void __launch_bounds__(NWAVES * 64, 2) hymba_fwd(Args args) {
    extern __shared__ __attribute__((aligned(16))) unsigned char lds[];
    LAS unsigned char* const L = (LAS unsigned char*)lds;
    volatile LAS unsigned* const MISC = (volatile LAS unsigned*)(L + MISC_OFF);
    const int tid = threadIdx.x, lane = tid & 63, wave = __builtin_amdgcn_readfirstlane(tid >> 6);
    const int G = gridDim.x; const int bx = blockIdx.x; const int vcu = (G % 8 == 0) ? (bx % 8) * (G / 8) + bx / 8 : bx;
    const int gw = vcu * NWAVES + wave, NGW = G * NWAVES;
    for (int u = tid; u < (LDS_BYTES - LDSCTL_OFF) / 4; u += NWAVES * 64) ((LAS unsigned*)(L + LDSCTL_OFF))[u] = 0u;
    __syncthreads();
#define LARG(i) (args.in[(i)])
#define IN_F(i) ((const float*)LARG(i))
#define WS_PTR opaque_ptr(args.ws)
#define OUT_PTR (args.out)
    XcdBarrier bar = xcd_barrier_post((unsigned*)((gu32*)(WS_PTR + WS_CTL) + CW_BAR), MISC + 8);

    {
        unsigned char* const ws = WS_PTR; unsigned char* const tab = ws + WS_TAB; float* const TAB = (float*)tab;
        const float* x_prompt = IN_F(0); const float* x_sample = IN_F(1); const float* norm_g = IN_F(7); const float* w_in = IN_F(8);
        const float* lq1 = IN_F(11); const float* lk1 = IN_F(12); const float* lq2 = IN_F(13); const float* lk2 = IN_F(14); const float* rel_bias = IN_F(16);
        const float* a_re = IN_F(17); const float* a_im = IN_F(18); const float* log_dt = IN_F(19); const float* b_re = IN_F(20); const float* b_im = IN_F(21); const float* c_re = IN_F(22); const float* c_im = IN_F(23);
        const float* w_glu = IN_F(25); const float* w_out = IN_F(27);
        bf16* const WinT = (bf16*)(ws + WS_WIN); bf16* const WoutT = (bf16*)(ws + WS_WOUT); bf16* const WgluT = (bf16*)(ws + WS_WGLU); bf16* const XN = (bf16*)(ws + WS_XN);
        LAS float* scr = (LAS float*)(L + RING_OFF + wave * 16384);
        SEG_BEGIN(1)
        constexpr int I_IN = (DM / 64) * (NIN / 32), I_OUT = (DM / 64) * (DM / 32), I_GLU = (DH / 64) * (DH / 32);
        constexpr int I_T = I_IN + I_OUT + I_GLU, I_ROWS = I_T + MT, I_ALL = I_ROWS + 2 + 32;
        for (int it = gw; it < I_ALL; it += NGW) {
            int r = it;
            if (r < I_IN) { p0_transpose_item(w_in, DM, NIN, WinT, true, scr, r, lane); continue; } r -= I_IN;
            if (r < I_OUT) { p0_transpose_item(w_out, DM, DM, WoutT, false, scr, r, lane); continue; } r -= I_OUT;
            if (r < I_GLU) { p0_transpose_item(w_glu, DH, DH, WgluT, false, scr, r, lane); continue; } r -= I_GLU;
            if (r < MT) { const float* xr = r < MP ? x_prompt + (size_t)r * DM : x_sample + (size_t)(r - MP) * DM; rms_row_to_bf16(xr, norm_g, XN + (size_t)r * DM, lane); continue; } r -= MT;
            if (r == 0) {
                const float s1 = wave_sum(lq1[lane] * lk1[lane]), s2 = wave_sum(lq2[lane] * lk2[lane]);
                if (lane == 0) TAB[TB_LAM] = expf(s1) - expf(s2) + 0.2f;
            } else if (r == 1) {
                for (int i = lane; i < 512; i += 64) { const int h = i >> 7, d = i & 127; TAB[TB_BIAS + i] = (rel_bias[t5_bucket(d) * 4 + h] - rel_bias[31 * 4 + h]) * LOG2E; }
            } else {
                const int g = r - 2, p = lane;
                const float ar = a_re[g * 64 + p], ai = a_im[g * 64 + p], dt = expf(log_dt[g]);
                const float mag = expf(ar * dt), abr = mag * cosf(ai * dt), abi = mag * sinf(ai * dt);
                const float nr = abr - 1.0f, den = ar * ar + ai * ai;
                const float cfr = (nr * ar + abi * ai) / den, cfi = (abi * ar - nr * ai) / den;
                float pr[4], pi_[4]; pr[0] = abr; pi_[0] = abi;
                pr[1] = abr * abr - abi * abi; pi_[1] = 2.0f * abr * abi;
                pr[2] = pr[1] * abr - pi_[1] * abi; pi_[2] = pr[1] * abi + pi_[1] * abr;
                pr[3] = pr[1] * pr[1] - pi_[1] * pi_[1]; pi_[3] = 2.0f * pr[1] * pi_[1];
                float* tp = (float*)(tab + OFF_TP) + (size_t)(g * 64 + p) * 8;
#pragma unroll
                for (int k = 0; k < 4; ++k) { tp[2 * k] = pr[k]; tp[2 * k + 1] = pi_[k]; }
                float qr = pr[3], qi = pi_[3];
#pragma unroll
                for (int k = 0; k < 6; ++k) { const float t = qr * qr - qi * qi; qi = 2.0f * qr * qi; qr = t; }
                float* ta = (float*)(tab + OFF_TA256) + (size_t)(g * 64 + p) * 2; ta[0] = qr; ta[1] = qi;
                float bbr[16], bbi[16];
#pragma unroll
                for (int c = 0; c < 16; ++c) { const float br = b_re[(g * 64 + p) * 16 + c], bi = b_im[(g * 64 + p) * 16 + c]; bbr[c] = cfr * br - cfi * bi; bbi[c] = cfr * bi + cfi * br; }
                float* tb = (float*)(tab + OFF_TBF) + (size_t)(g * 64 + p) * 32;
#pragma unroll
                for (int c = 0; c < 16; ++c) { tb[c] = bbr[c]; tb[16 + c] = bbi[c]; }
                const int hi = p >> 5, rr = p & 31;
#pragma unroll
                for (int hh = 0; hh < 2; ++hh) {
                    v4u wr_, wi_;
                    wr_.x = pk2(bbr[8 * hh + 0], bbr[8 * hh + 1]); wr_.y = pk2(bbr[8 * hh + 2], bbr[8 * hh + 3]); wr_.z = pk2(bbr[8 * hh + 4], bbr[8 * hh + 5]); wr_.w = pk2(bbr[8 * hh + 6], bbr[8 * hh + 7]);
                    wi_.x = pk2(bbi[8 * hh + 0], bbi[8 * hh + 1]); wi_.y = pk2(bbi[8 * hh + 2], bbi[8 * hh + 3]); wi_.z = pk2(bbi[8 * hh + 4], bbi[8 * hh + 5]); wi_.w = pk2(bbi[8 * hh + 6], bbi[8 * hh + 7]);
                    *(v4u*)(tab + OFF_TBB + ((size_t)(g * 4 + 0 + hi) * 64 + rr + 32 * hh) * 16) = wr_;
                    *(v4u*)(tab + OFF_TBB + ((size_t)(g * 4 + 2 + hi) * 64 + rr + 32 * hh) * 16) = wi_;
                }
                const int cc = lane & 15, kq = lane >> 4;
#pragma unroll
                for (int s = 0; s < 4; ++s) {
                    float v[8];
#pragma unroll
                    for (int j = 0; j < 8; ++j) { const int k = 32 * s + 8 * kq + j, pp = k >> 1; v[j] = (k & 1) ? -c_im[(g * 16 + cc) * 64 + pp] : c_re[(g * 16 + cc) * 64 + pp]; }
                    v4u w; w.x = pk2(v[0], v[1]); w.y = pk2(v[2], v[3]); w.z = pk2(v[4], v[5]); w.w = pk2(v[6], v[7]);
                    *(v4u*)(tab + OFF_TCC + ((size_t)(g * 4 + s) * 64 + lane) * 16) = w;
                }
            }
        }
        SEG_END(1)
    }
    xcd_barrier(bar);

    {
        unsigned char* const ws = WS_PTR; float* const out = OUT_PTR; const int wmask = args.wmask;
        const float* q_norm_g = IN_F(9); const float* k_norm_g = IN_F(10);
        bf16* const WinT = (bf16*)(ws + WS_WIN); bf16* const XN = (bf16*)(ws + WS_XN); bf16* const Qp = (bf16*)(ws + WS_Q); bf16* const Kp = (bf16*)(ws + WS_Q + 16 * MiB); bf16* const Vp = (bf16*)(ws + WS_K);
        bf16* const GA = (bf16*)(ws + WS_GA); bf16* const U = (bf16*)(ws + WS_U); bf16* const GS = (bf16*)(ws + WS_GS);
        float* const QS = (float*)(ws + WS_QS); float* const KS = (float*)(ws + WS_KS); float* const VS = (float*)(ws + WS_VS);
        pg8::Gemm g{XN, WinT, MP, NIN, DM}; pg8::StaticOrder S; S.init(MP, NIN, G, bx);
        pg8::EpiInProj E1{out, Qp, Kp, Vp, GA, U, GS, QS, KS, VS, q_norm_g, k_norm_g, wmask};
        SEG_BEGIN(2)
        pg8::gemm_phase<pg8::EpiInProj, pg8::StaticOrder, true, true>(L + RING_OFF, g, S, E1);
        for (int it = vcu; it < 768; it += G) sample_inproj_tile(it % 48, it / 48, WinT, XN, q_norm_g, k_norm_g, QS, KS, VS, GA, U, GS, out, wmask, (LAS float*)(L + RING_OFF), wave, opaque_lane());
        SEG_END(2)
    }
    xcd_barrier(bar);

    {
        unsigned char* const ws = WS_PTR; unsigned char* const tab = ws + WS_TAB; float* const TAB = (float*)tab;
        bf16* const Qp = (bf16*)(ws + WS_Q); bf16* const Kp = (bf16*)(ws + WS_Q + 16 * MiB); bf16* const Vp = (bf16*)(ws + WS_K); bf16* const Op = (bf16*)(ws + WS_V);
        static_assert(attn_body::ATTN_LDS_BYTES <= BT_LDS_OFF && BT_LDS_OFF + 2048 <= RING_BYTES, "attention LDS map");
        LAS float* btab = (LAS float*)(L + RING_OFF + BT_LDS_OFF);
        for (int i = tid; i < 512; i += NWAVES * 64) btab[i] = TAB[TB_BIAS + i];
        __syncthreads();
        const attn_body::AttnTensors AT{(const attn_body::bf16*)Qp, (const attn_body::bf16*)Kp, (const attn_body::bf16*)Vp, (attn_body::bf16*)Op};
        const attn_body::StaticOrder S((int)G, (int)bx);
        const int kslot = vcu % 3;
        for (int i = 0; i < 3; ++i) {
            if (i == kslot) {
                unsigned char* const wsd = WS_PTR; const float* cache_k = IN_F(2); const float* cache_v = IN_F(3); const int* page_table = (const int*)LARG(6);
                float* const QS = (float*)(wsd + WS_QS); float* const PO = (float*)(wsd + WS_PART); float* const PML = (float*)(wsd + WS_PML); const float* TABd = (const float*)(wsd + WS_TAB);
                SEG_BEGIN(4)
                for (int it = gw; it < 2048; it += NGW) {
                    const int wg = it >> 3, wv = it & 7, b = wg >> 1, h = wv & 3, sp = (wg & 1) * 2 + (wv >> 2);
                    decode_item(b, h, sp, QS, cache_k, cache_v, page_table, TABd + TB_BIAS + h * 128, PO, PML, opaque_lane());
                }
                SEG_END(4)
            }
            attn_body::AttnUnit au;
            SEG_BEGIN(3)
            if (S.next(i, au)) attn_body::attn_unit<8>(au.bh / attn_body::NHEAD, au.bh % attn_body::NHEAD, au.qb, AT.Q, AT.K, AT.V, AT.O, (char*)lds + RING_OFF, (attn_body::lds_cfp)btab);
            SEG_END(3)
        }
        unsigned char* const wse = WS_PTR; unsigned char* const tabe = wse + WS_TAB;
        float* const out = OUT_PTR; const int wmask = args.wmask; const float* st_re = IN_F(4); const float* st_im = IN_F(5);
        const float* c_re = IN_F(22); const float* c_im = IN_F(23); const float* d_skip = IN_F(24);
        bf16* const U = (bf16*)(wse + WS_U); bf16* const Z = (bf16*)(wse + WS_Z); float* const E = (float*)(wse + WS_E);
        SEG_BEGIN(5)
        for (int it = gw; it < 4096; it += NGW) ssm_sample_item(it >> 5, it & 31, tabe, U, st_re, st_im, c_re, c_im, d_skip, Z, out, wmask, opaque_lane());
        for (int it = gw; it < 2048; it += NGW) ssm_chunk<false>(it >> 10, (it >> 5) & 31, it & 31, tabe, U, E, d_skip, Z, out, wmask, (LAS unsigned*)nullptr, opaque_lane());
        SEG_END(5)
    }
    xcd_barrier(bar);

    {
        unsigned char* const ws = WS_PTR; unsigned char* const tab = ws + WS_TAB; float* const TAB = (float*)tab; float* const out = OUT_PTR; const int wmask = args.wmask;
        const float* subln_g = IN_F(15); const float* d_skip = IN_F(24);
        bf16* const Op = (bf16*)(ws + WS_V); bf16* const GA = (bf16*)(ws + WS_GA); bf16* const U = (bf16*)(ws + WS_U); bf16* const Z = (bf16*)(ws + WS_Z); bf16* const A2 = (bf16*)(ws + WS_A2);
        float* const QS = (float*)(ws + WS_QS); float* const KS = (float*)(ws + WS_KS); float* const VS = (float*)(ws + WS_VS);
        float* const E = (float*)(ws + WS_E); float* const PO = (float*)(ws + WS_PART); float* const PML = (float*)(ws + WS_PML);
        SEG_BEGIN(6)
        const float lam = TAB[TB_LAM];
        LAS unsigned* Hs = (LAS unsigned*)(L + RING_OFF + wave * 16384);
        for (int it = gw; it < 2048; it += NGW) ssm_chunk<true>(it >> 10, (it >> 5) & 31, it & 31, tab, U, E, d_skip, Z, out, wmask, Hs, opaque_lane());
        { const int ln = opaque_lane(); const f32x4 sg0 = *(const f32x4*)(subln_g + 8 * (ln & 15)), sg1 = *(const f32x4*)(subln_g + 8 * (ln & 15) + 4);
          for (int row = gw; row < MP; row += NGW) combine_prompt_row((size_t)row, Op, GA, lam, sg0, sg1, A2, ln); }
        for (int it = gw; it < 2048; it += NGW) combine_sample(it >> 2, it & 3, QS, KS, VS, PO, PML, TAB + TB_BIAS + (it & 3) * 128, lam, subln_g, GA, A2, opaque_lane());
        SEG_END(6)
    }
    xcd_barrier(bar);

    {
        unsigned char* const ws = WS_PTR; const float* b_glu = IN_F(26);
        bf16* const WgluT = (bf16*)(ws + WS_WGLU); bf16* const GS = (bf16*)(ws + WS_GS); bf16* const Z = (bf16*)(ws + WS_Z); bf16* const A2 = (bf16*)(ws + WS_A2);
        pg8::Gemm g{Z, WgluT, MP, DH, DH}; pg8::StaticOrder S; S.init(MP, DH, G, bx);
        pg8::EpiGlu E4{Z, GS, b_glu, A2};
        SEG_BEGIN(7)
        pg8::gemm_phase<pg8::EpiGlu, pg8::StaticOrder, true, true>(L + RING_OFF, g, S, E4);
        if (bx >= 128) { for (int it = bx - 128; it < 128; it += G - 128) sample_glu_tile(it & 7, it >> 3, WgluT, Z, GS, b_glu, A2, (LAS float*)(L + RING_OFF), wave, opaque_lane()); }
        SEG_END(7)
    }
    xcd_barrier(bar);

    {
        unsigned char* const ws = WS_PTR; float* const out = OUT_PTR; const int wmask = args.wmask;
        const float* x_prompt = IN_F(0); const float* x_sample = IN_F(1);
        bf16* const WoutT = (bf16*)(ws + WS_WOUT); bf16* const A2 = (bf16*)(ws + WS_A2);
        pg8::Gemm g{A2, WoutT, MP, DM, DM}; pg8::StaticOrder S; S.init(MP, DM, G, bx);
        pg8::EpiOut E5{x_prompt, x_sample, out, wmask};
        SEG_BEGIN(8)
        pg8::gemm_phase<pg8::EpiOut, pg8::StaticOrder, true, true>(L + RING_OFF, g, S, E5);
        for (int it = vcu; it < 256; it += G) sample_out_tile(it & 15, it >> 4, WoutT, A2, x_sample, out, wmask, (LAS float*)(L + RING_OFF), wave, opaque_lane());
        SEG_END(8)
    }
}

#ifndef MODE
#define MODE 1
#endif
#ifndef WMASK
#define WMASK 31
#endif
#if MODE != 1
#ifndef NV_STOP
#define NV_STOP 99
#endif
namespace nv {
constexpr size_t NV_BASE = 320ull << 20;
constexpr size_t NV_XN = NV_BASE, NV_H = NV_XN + (size_t)MT * DM * 4, NV_Q = NV_H + (size_t)MT * NIN * 4, NV_K = NV_Q + (size_t)MT * DH * 4, NV_V = NV_K + (size_t)MT * DH * 4,
                 NV_O = NV_V + (size_t)MT * DH * 4, NV_Y = NV_O + (size_t)MT * DM * 4, NV_Z = NV_Y + (size_t)MT * DH * 4, NV_T = NV_Z + (size_t)MT * DH * 4, NV_A2 = NV_T + (size_t)MT * DH * 4,
                 NV_END = NV_A2 + (size_t)MT * DM * 4;
__device__ __forceinline__ float wsum(float v) {
#pragma unroll
    for (int o = 1; o < 64; o <<= 1) v += __shfl_xor(v, o);
    return v;
}
__device__ __forceinline__ float wmax(float v) {
#pragma unroll
    for (int o = 1; o < 64; o <<= 1) v = fmaxf(v, __shfl_xor(v, o));
    return v;
}
__device__ __forceinline__ int bucket(int n) {
    if (n < 16) return n;
    int b = 16;
    b += (n >= 19); b += (n >= 21); b += (n >= 24); b += (n >= 27); b += (n >= 31); b += (n >= 35); b += (n >= 40); b += (n >= 46);
    b += (n >= 52); b += (n >= 59); b += (n >= 67); b += (n >= 77); b += (n >= 87); b += (n >= 99); b += (n >= 113);
    return b;
}
__global__ void k_rms(const float* xp, const float* xs, const float* g, float* XN) {
    const int row = blockIdx.x, lane = threadIdx.x;
    const float* x = row < MP ? xp + (size_t)row * DM : xs + (size_t)(row - MP) * DM;
    float s = 0.f;
    for (int i = lane; i < DM; i += 64) s += x[i] * x[i];
    const float rs = rsqrtf(wsum(s) / DM + EPS);
    for (int i = lane; i < DM; i += 64) XN[(size_t)row * DM + i] = x[i] * rs * g[i];
}
__global__ void k_gemm(const float* A, const float* B, float* C, const float* R, int M, int N, int K) {
    __shared__ float As[16][65], Bs[16][65];
    const int tx = threadIdx.x & 15, ty = threadIdx.x >> 4, m0 = blockIdx.y * 64, n0 = blockIdx.x * 64;
    float acc[4][4] = {};
    for (int k0 = 0; k0 < K; k0 += 16) {
        for (int i = threadIdx.x; i < 1024; i += 256) { const int r = i >> 4, c = i & 15; As[c][r] = A[(size_t)(m0 + r) * K + k0 + c]; }
        for (int i = threadIdx.x; i < 1024; i += 256) { const int r = i >> 6, c = i & 63; Bs[r][c] = B[(size_t)(k0 + r) * N + n0 + c]; }
        __syncthreads();
#pragma unroll
        for (int k = 0; k < 16; ++k) {
            float a[4], b[4];
#pragma unroll
            for (int i = 0; i < 4; ++i) { a[i] = As[k][ty * 4 + i]; b[i] = Bs[k][tx * 4 + i]; }
#pragma unroll
            for (int i = 0; i < 4; ++i)
#pragma unroll
                for (int j = 0; j < 4; ++j) acc[i][j] += a[i] * b[j];
        }
        __syncthreads();
    }
    for (int i = 0; i < 4; ++i)
        for (int j = 0; j < 4; ++j) { const size_t o = (size_t)(m0 + ty * 4 + i) * N + n0 + tx * 4 + j; C[o] = acc[i][j] + (R ? R[o] : 0.f); }
}
__global__ void k_post(const float* H, const float* qg, const float* kg, float* Q, float* Kn, float* Vn, float* out) {
    const int row = blockIdx.x / 24, j = blockIdx.x % 24, d = threadIdx.x;
    const float v = H[(size_t)row * NIN + j * 64 + d];
    if (j < 16) {
        const float rs = rsqrtf(wsum(v * v) / 64.f + EPS);
        if (j < 8) Q[(size_t)row * DH + j * 64 + d] = v * rs * qg[d] * 0.125f;
        else { const float k = v * rs * kg[d]; const int c = (j - 8) * 64 + d; Kn[(size_t)row * DH + c] = k;
               if (row < MP) out[O_KP + (size_t)row * DH + c] = k; else out[O_KS + (size_t)(row - MP) * DH + c] = k; }
    } else { const int c = (j - 16) * 64 + d; Vn[(size_t)row * DH + c] = v;
             if (row < MP) out[O_VP + (size_t)row * DH + c] = v; else out[O_VS + (size_t)(row - MP) * DH + c] = v; }
}
__global__ void k_attn(const float* Q, const float* Kn, const float* Vn, const float* ck, const float* cv, const int* pt, const float* rel_bias, float* O) {
    const int id = blockIdx.x, row = id >> 3, h = (id >> 1) & 3, c = id & 1, lane = threadIdx.x;
    float q[64];
#pragma unroll
    for (int d = 0; d < 64; ++d) q[d] = Q[(size_t)row * DH + h * 128 + c * 64 + d];
    int nkeys, qpos, b;
    const bool samp = row >= MP;
    if (!samp) { b = row / SEQ; qpos = row % SEQ; nkeys = qpos + 1; }
    else { b = (row - MP) >> 2; qpos = PAST + ((row - MP) & 3); nkeys = qpos + 1; }
    float m = -1e30f, l = 0.f, o0 = 0.f, o1 = 0.f;
    for (int t0 = 0; t0 < nkeys; t0 += 64) {
        const int kk = t0 + lane; const bool valid = kk < nkeys;
        const float* kp;
        if (!samp) kp = Kn + (size_t)(b * SEQ + (valid ? kk : 0)) * DH + h * 128 + c * 64;
        else if (kk < PAST) { const int pg = pt[b * NPAGES + (kk >> 7)]; kp = ck + ((size_t)(pg * PAGE + (kk & 127)) * 4 + h) * 128 + c * 64; }
        else kp = Kn + (size_t)(MP + b * 4 + (valid ? kk - PAST : 0)) * DH + h * 128 + c * 64;
        float s = 0.f;
#pragma unroll
        for (int d = 0; d < 64; ++d) s += q[d] * kp[d];
        s += rel_bias[bucket(valid ? qpos - kk : 0) * 4 + h];
        if (!valid) s = -1e30f;
        const float mn = fmaxf(m, wmax(s)), alpha = expf(m - mn), p = valid ? expf(s - mn) : 0.f;
        l = l * alpha + wsum(p); o0 *= alpha; o1 *= alpha; m = mn;
        const int cnt = min(64, nkeys - t0);
        for (int j = 0; j < cnt; ++j) {
            const float pj = __shfl(p, j); const int kj = t0 + j;
            const float* vp;
            if (!samp) vp = Vn + (size_t)(b * SEQ + kj) * DH + h * 128;
            else if (kj < PAST) { const int pg = pt[b * NPAGES + (kj >> 7)]; vp = cv + ((size_t)(pg * PAGE + (kj & 127)) * 4 + h) * 128; }
            else vp = Vn + (size_t)(MP + b * 4 + kj - PAST) * DH + h * 128;
            o0 += pj * vp[lane]; o1 += pj * vp[lane + 64];
        }
    }
    float* op = O + (size_t)row * DM + (h * 2 + c) * 128;
    op[lane] = o0 / l; op[lane + 64] = o1 / l;
}
__global__ void k_ssm(const float* H, int row0, int L, const float* h0re, const float* h0im, const float* are, const float* aim, const float* ldt,
                      const float* bre, const float* bim, const float* cre, const float* cim, const float* dsk, float* Y, float* ore, float* oim) {
    const int b = blockIdx.x >> 5, g = blockIdx.x & 31, p = threadIdx.x;
    const float ar = are[g * 64 + p], ai = aim[g * 64 + p], dt = expf(ldt[g]);
    const float mag = expf(ar * dt), abr = mag * cosf(ai * dt), abi = mag * sinf(ai * dt);
    const float nr = abr - 1.0f, den = ar * ar + ai * ai;
    const float cfr = (nr * ar + abi * ai) / den, cfi = (abi * ar - nr * ai) / den;
    float bbr[16], bbi[16], cr[16], ci[16];
#pragma unroll
    for (int c = 0; c < 16; ++c) { const float br = bre[(g * 64 + p) * 16 + c], bi = bim[(g * 64 + p) * 16 + c];
        bbr[c] = cfr * br - cfi * bi; bbi[c] = cfr * bi + cfi * br; cr[c] = cre[(g * 16 + c) * 64 + p]; ci[c] = cim[(g * 16 + c) * 64 + p]; }
    float hr = h0re ? h0re[(b * 32 + g) * 64 + p] : 0.f, hi = h0im ? h0im[(b * 32 + g) * 64 + p] : 0.f;
    for (int t = 0; t < L; ++t) {
        const size_t row = (size_t)row0 + (size_t)b * L + t;
        const float* u = H + row * NIN + 2048 + g * 16;
        float ur = 0.f, ui = 0.f;
#pragma unroll
        for (int c = 0; c < 16; ++c) { ur += bbr[c] * u[c]; ui += bbi[c] * u[c]; }
        const float nhr = abr * hr - abi * hi + ur, nhi = abr * hi + abi * hr + ui; hr = nhr; hi = nhi;
        float yv = 0.f;
#pragma unroll
        for (int c = 0; c < 16; ++c) { const float s = wsum(cr[c] * hr - ci[c] * hi); if (p == c) yv = s; }
        if (p < 16) Y[row * DH + g * 16 + p] = yv + dsk[g * 16 + p] * u[p];
    }
    ore[(b * 32 + g) * 64 + p] = hr; oim[(b * 32 + g) * 64 + p] = hi;
}
__device__ __forceinline__ float gelu_tanh(float x) { return 0.5f * x * (1.0f + tanhf(0.7978845608028654f * (x + 0.044715f * x * x * x))); }
__device__ __forceinline__ float silu(float x) { return x / (1.0f + expf(-x)); }
__global__ void k_fin1(const float* O, const float* H, const float* Y, const float* lq1, const float* lk1, const float* lq2, const float* lk2, const float* subg, float* A2, float* Z) {
    const int row = blockIdx.x, lane = threadIdx.x;
    const float lam = expf(wsum(lq1[lane] * lk1[lane])) - expf(wsum(lq2[lane] * lk2[lane])) + 0.2f;
    for (int h = 0; h < 4; ++h) {
        const float* o1 = O + (size_t)row * DM + (h * 2) * 128; const float* o2 = o1 + 128;
        const float a = o1[lane] - lam * o2[lane], bb = o1[lane + 64] - lam * o2[lane + 64];
        const float rs = rsqrtf(wsum(a * a + bb * bb) / 128.f + EPS);
        const float* ga = H + (size_t)row * NIN + 1536 + h * 128;
        A2[(size_t)row * DM + h * 128 + lane] = a * rs * subg[lane] * 0.8f * silu(ga[lane]);
        A2[(size_t)row * DM + h * 128 + lane + 64] = bb * rs * subg[lane + 64] * 0.8f * silu(ga[lane + 64]);
    }
    for (int i = lane; i < DH; i += 64) Z[(size_t)row * DH + i] = gelu_tanh(Y[(size_t)row * DH + i]);
}
__global__ void k_fin2(const float* Z, const float* T, const float* bglu, const float* H, float* A2) {
    const size_t i = (size_t)blockIdx.x * 256 + threadIdx.x; const size_t row = i / DH; const int j = (int)(i % DH);
    A2[row * DM + 512 + j] = Z[i] / (1.0f + expf(-(T[i] + bglu[j]))) * silu(H[row * NIN + 2560 + j]);
}
static void launch(void* const* d_in, float* out, unsigned char* ws, hipStream_t st) {
    const float* xp = (const float*)d_in[0]; const float* xs = (const float*)d_in[1];
    float *XN = (float*)(ws + NV_XN), *H = (float*)(ws + NV_H), *Q = (float*)(ws + NV_Q), *Kn = (float*)(ws + NV_K), *Vn = (float*)(ws + NV_V), *O = (float*)(ws + NV_O),
          *Y = (float*)(ws + NV_Y), *Z = (float*)(ws + NV_Z), *T = (float*)(ws + NV_T), *A2 = (float*)(ws + NV_A2);
#if NV_STOP >= 1
    k_rms<<<MT, 64, 0, st>>>(xp, xs, (const float*)d_in[7], XN);
#endif
#if NV_STOP >= 2
    k_gemm<<<dim3(NIN / 64, MT / 64), 256, 0, st>>>(XN, (const float*)d_in[8], H, nullptr, MT, NIN, DM);
#endif
#if NV_STOP >= 3
    k_post<<<MT * 24, 64, 0, st>>>(H, (const float*)d_in[9], (const float*)d_in[10], Q, Kn, Vn, out);
#endif
#if NV_STOP >= 4
    k_attn<<<MT * 8, 64, 0, st>>>(Q, Kn, Vn, (const float*)d_in[2], (const float*)d_in[3], (const int*)d_in[6], (const float*)d_in[16], O);
#endif
#if NV_STOP >= 5
    k_ssm<<<NB * 32, 64, 0, st>>>(H, 0, SEQ, nullptr, nullptr, (const float*)d_in[17], (const float*)d_in[18], (const float*)d_in[19], (const float*)d_in[20], (const float*)d_in[21],
                                 (const float*)d_in[22], (const float*)d_in[23], (const float*)d_in[24], Y, out + O_SRP, out + O_SIP);
#endif
#if NV_STOP >= 6
    k_ssm<<<128 * 32, 64, 0, st>>>(H, MP, 4, (const float*)d_in[4], (const float*)d_in[5], (const float*)d_in[17], (const float*)d_in[18], (const float*)d_in[19], (const float*)d_in[20], (const float*)d_in[21],
                                  (const float*)d_in[22], (const float*)d_in[23], (const float*)d_in[24], Y, out + O_SRS, out + O_SIS);
#endif
#if NV_STOP >= 7
    k_fin1<<<MT, 64, 0, st>>>(O, H, Y, (const float*)d_in[11], (const float*)d_in[12], (const float*)d_in[13], (const float*)d_in[14], (const float*)d_in[15], A2, Z);
#endif
#if NV_STOP >= 8
    k_gemm<<<dim3(DH / 64, MT / 64), 256, 0, st>>>(Z, (const float*)d_in[25], T, nullptr, MT, DH, DH);
#endif
#if NV_STOP >= 9
    k_fin2<<<MT * DH / 256, 256, 0, st>>>(Z, T, (const float*)d_in[26], H, A2);
#endif
#if NV_STOP >= 10
    k_gemm<<<dim3(DM / 64, MP / 64), 256, 0, st>>>(A2, (const float*)d_in[27], out + O_YP, xp, MP, DM, DM);
#endif
#if NV_STOP >= 11
    k_gemm<<<dim3(DM / 64, MS / 64), 256, 0, st>>>(A2 + (size_t)MP * DM, (const float*)d_in[27], out + O_YS, xs, MS, DM, DM);
#endif
}
}
#endif

extern "C" void kernel_launch(void* const* d_in, const int* in_sizes, int n_in, void* d_out, int out_size, void* d_ws, size_t ws_size, hipStream_t stream) {
    static int grid = 0;
    if (grid == 0) {
        if (n_in != 28 || out_size != (int)O_END || ws_size < (size_t)(1024ull << 20)) { fprintf(stderr, "kernel_launch: unexpected shapes (n_in %d out %d ws %zu)\n", n_in, out_size, ws_size); grid = -1; return; }
        int dev = 0, cus = 0, per_cu = 0;
        if (hipGetDevice(&dev) != hipSuccess || hipDeviceGetAttribute(&cus, hipDeviceAttributeMultiprocessorCount, dev) != hipSuccess) { grid = -1; return; }
        if (hipFuncSetAttribute((const void*)hymba_fwd, hipFuncAttributeMaxDynamicSharedMemorySize, LDS_BYTES) != hipSuccess) { fprintf(stderr, "kernel_launch: hipFuncSetAttribute failed\n"); grid = -1; return; }
        if (hipOccupancyMaxActiveBlocksPerMultiprocessor(&per_cu, (const void*)hymba_fwd, NWAVES * 64, LDS_BYTES) != hipSuccess || per_cu < 1)
            fprintf(stderr, "kernel_launch: occupancy query reports %d workgroups per CU\n", per_cu);
        (void)hipGetLastError();
        grid = cus;
    }
    if (grid < 0) return;
#if MODE != 1
    nv::launch(d_in, (float*)d_out, (unsigned char*)d_ws, stream);
#endif
#if MODE == 0
    return;
#endif
    if (hipMemsetAsync((char*)d_ws + WS_CTL, 0, CTL_ZERO_BYTES, stream) != hipSuccess) return;
    Args a{};
    for (int i = 0; i < 28; ++i) a.in[i] = d_in[i];
    a.out = (float*)d_out; a.ws = (unsigned char*)d_ws; a.wmask = (MODE == 1) ? 31 : WMASK;
    hipLaunchKernelGGL(hymba_fwd, dim3(grid), dim3(NWAVES * 64), LDS_BYTES, stream, a);
}
```

```cpp
#include <hip/hip_runtime.h>
#include <hip/hip_bf16.h>
#include <cstdio>
#include <cstdint>
#include <cmath>

constexpr int DM = 1024, SEQ = 8192, NB = 2, MP = NB * SEQ, MS = 512, MT = MP + MS;
constexpr int NIN = 3072, DH = 512;
constexpr int NPAGES = 16, PAGE = 128, PAST = 2048;
constexpr float EPS = 1e-6f, LOG2E = 1.4426950408889634f;
constexpr float C2 = 0.125f * LOG2E;
constexpr size_t O_YP = 0, O_YS = 16777216, O_KP = 17301504, O_VP = 25690112, O_KS = 34078720, O_VS = 34340864,
                 O_SRP = 34603008, O_SIP = 34607104, O_SRS = 34611200, O_SIS = 34873344, O_END = 35135488;

namespace pg8 {
#define PG8_LAS __attribute__((address_space(3)))
typedef unsigned short bf16_t;
typedef short bf16x8 __attribute__((ext_vector_type(8)));
typedef float f32x4 __attribute__((ext_vector_type(4)));
typedef unsigned u32x4 __attribute__((ext_vector_type(4)));
constexpr int BM = 256, BK = 64, HALF = 128, HTB = HALF * BK * 2  , STAGE_BYTES = 8 * HTB, NXCD = 8, WGM = 8;

__host__ __device__ __forceinline__ int lds_byte(int r, int c) { const int st = (r >> 4) * 2 + (c >> 5), rr = r & 15, cc = c & 31, ob = rr * 64 + cc * 2; return st * 1024 + (ob ^ (((ob >> 9) & 1) << 5)); }
__host__ __device__ __forceinline__ void stage_rc(int b, int& R, int& C) { const int st = b / 1024, sb = b % 1024, swz = sb ^ (((sb >> 9) & 1) << 5); R = (st >> 1) * 16 + swz / 64; C = (st & 1) * 32 + (swz % 64) / 2; }
__host__ __device__ __forceinline__ int perm32(int rho) { const int n = rho >> 4, i = rho & 15; return 8 * (i >> 2) + 4 * n + (i & 3); }

struct Unit { int pm, pn; };
struct Gemm { const bf16_t* A; const bf16_t* Bt; int M, N, K; };

struct StaticOrder {
    int nM, nN, nwg, G, c;
    __host__ __device__ void init(int M, int N, int G_, int c_) { nM = M / BM; nN = N / BM; nwg = nM * nN; G = G_; c = c_; }
    __host__ __device__ bool next(int i, Unit& u) const {
        const long L = (long)i * G + c; if (L >= nwg) return false;
        int wgid = (int)L; { const int q = nwg / NXCD, r = nwg % NXCD, xcd = wgid % NXCD, off = wgid / NXCD; wgid = (xcd < r ? xcd * (q + 1) : r * (q + 1) + (xcd - r) * q) + off; }
        const int nig = WGM * nN, gid = wgid / nig, fm = gid * WGM, gsz = (nM - fm) < WGM ? (nM - fm) : WGM;
        u.pm = fm + ((wgid % nig) % gsz); u.pn = (wgid % nig) / gsz; return true;
    }
    __device__ __forceinline__ void a_ready(const Unit&) const {}
    __device__ __forceinline__ void done(const Unit&) const {}
};
__device__ __forceinline__ unsigned cvt_pk_bf16(float lo, float hi) { unsigned r; asm volatile("v_cvt_pk_bf16_f32 %0, %1, %2" : "=v"(r) : "v"(lo), "v"(hi)); return r; }
typedef float f32x2 __attribute__((ext_vector_type(2)));

__device__ __forceinline__ float silu_f(float x) { return x * __builtin_amdgcn_rcpf(1.0f + __expf(-x)); }
__device__ __forceinline__ float sigmoid_f(float x) { return __builtin_amdgcn_rcpf(1.0f + __expf(-x)); }
__device__ __forceinline__ u32x4 pack8(const f32x4 a, const f32x4 b) { u32x4 w; w.x = cvt_pk_bf16(a[0], a[1]); w.y = cvt_pk_bf16(a[2], a[3]); w.z = cvt_pk_bf16(b[0], b[1]); w.w = cvt_pk_bf16(b[2], b[3]); return w; }

struct EpiInProj {
    static constexpr bool PERM = true, AFTER_DRAIN = false;
    float* out; bf16_t *Qp, *Kp, *Vp, *GA, *U, *GS; float *QS, *KS, *VS; const float *qg, *kg; int wmask;
    __device__ __forceinline__ void operator()(const f32x4 (&acc)[2][2][4][2], const Unit& u, int wr, int wc, int fr, int fq) const {
        const int kind = u.pn >> 1, half = u.pn & 1;
        const int rowb = u.pm * BM + wr * 64 + fr;
        const int cc = 64 * wc + 8 * fq;
        if (kind <= 1) {
            const float* gsrc = kind == 0 ? qg : kg;
            f32x4 g[2][2];
#pragma unroll
            for (int bj = 0; bj < 2; ++bj)
#pragma unroll
                for (int n = 0; n < 2; ++n) { g[bj][n] = *(const f32x4*)(gsrc + 32 * bj + 8 * fq + 4 * n); if (kind == 0) g[bj][n] = g[bj][n] * C2; }
            const int j64 = 4 * half + wc;
#pragma unroll
            for (int ai = 0; ai < 2; ++ai)
#pragma unroll
                for (int m = 0; m < 4; ++m) {
                    const int row = rowb + ai * HALF + m * 16;
                    float ss = 0.f;
#pragma unroll
                    for (int bj = 0; bj < 2; ++bj)
#pragma unroll
                        for (int n = 0; n < 2; ++n) { const f32x4 x = acc[ai][bj][m][n]; ss += (x[0] * x[0] + x[1] * x[1]) + (x[2] * x[2] + x[3] * x[3]); }
                    ss += __shfl_xor(ss, 16); ss += __shfl_xor(ss, 32);
                    const float rs = rsqrtf(ss * (1.0f / 64.0f) + EPS);
#pragma unroll
                    for (int bj = 0; bj < 2; ++bj) {
                        const f32x4 v0 = acc[ai][bj][m][0] * rs * g[bj][0], v1 = acc[ai][bj][m][1] * rs * g[bj][1];
                        const int d = 32 * bj + 8 * fq;
                        if (kind == 0) {
                            if (row < MP) { *(u32x4*)(Qp + (size_t)row * DH + 64 * j64 + d) = pack8(v0, v1); }
                            else { float* p = QS + (size_t)(row - MP) * DH + 64 * j64 + d; *(f32x4*)p = v0; *(f32x4*)(p + 4) = v1; }
                        } else {
                            if (wmask & 1) { float* p = row < MP ? out + O_KP + (size_t)row * DH + 64 * j64 + d : out + O_KS + (size_t)(row - MP) * DH + 64 * j64 + d;
                                *(f32x4*)p = v0; *(f32x4*)(p + 4) = v1; }
                            if (row < MP) { *(u32x4*)(Kp + (size_t)row * DH + 64 * j64 + d) = pack8(v0, v1); }
                            else { float* p = KS + (size_t)(row - MP) * DH + 64 * j64 + d; *(f32x4*)p = v0; *(f32x4*)(p + 4) = v1; }
                        }
                    }
                }
        } else {
#pragma unroll
            for (int ai = 0; ai < 2; ++ai)
#pragma unroll
                for (int m = 0; m < 4; ++m) {
                    const int row = rowb + ai * HALF + m * 16;
#pragma unroll
                    for (int bj = 0; bj < 2; ++bj) {
                        f32x4 v0 = acc[ai][bj][m][0], v1 = acc[ai][bj][m][1];
                        const int col = 256 * half + cc + 32 * bj;
                        if (kind == 2) {
                            if (wmask & 1) { float* p = row < MP ? out + O_VP + (size_t)row * DH + col : out + O_VS + (size_t)(row - MP) * DH + col;
                                *(f32x4*)p = v0; *(f32x4*)(p + 4) = v1; }
                            if (row < MP) { *(u32x4*)(Vp + (size_t)row * DH + col) = pack8(v0, v1); }
                            else { float* p = VS + (size_t)(row - MP) * DH + col; *(f32x4*)p = v0; *(f32x4*)(p + 4) = v1; }
                        } else {
                            bf16_t* dst = kind == 3 ? GA : (kind == 4 ? U : GS);
                            if (kind != 4) {
#pragma unroll
                                for (int e = 0; e < 4; ++e) { v0[e] = silu_f(v0[e]); v1[e] = silu_f(v1[e]); }
                            }
                            *(u32x4*)(dst + (size_t)row * DH + col) = pack8(v0, v1);
                        }
                    }
                }
        }
    }
};


__device__ __forceinline__ float bflo(unsigned w) { return __uint_as_float(w << 16); }
__device__ __forceinline__ float bfhi(unsigned w) { return __uint_as_float(w & 0xffff0000u); }
struct EpiGlu {
    static constexpr bool PERM = true, AFTER_DRAIN = false;
    const bf16_t* Z; const bf16_t* GS; const float* bglu; bf16_t* A2;
    __device__ __forceinline__ void operator()(const f32x4 (&acc)[2][2][4][2], const Unit& u, int wr, int wc, int fr, int fq) const {
        const int rowb = u.pm * BM + wr * 64 + fr, colb = u.pn * BM + wc * 32 + 8 * fq;
        f32x4 bv[2][2];
#pragma unroll
        for (int bj = 0; bj < 2; ++bj)
#pragma unroll
            for (int n = 0; n < 2; ++n) bv[bj][n] = *(const f32x4*)(bglu + colb + bj * HALF + 4 * n);
#pragma unroll
        for (int ai = 0; ai < 2; ++ai)
#pragma unroll
            for (int m = 0; m < 4; ++m) {
                const size_t row = (size_t)(rowb + ai * HALF + m * 16);
#pragma unroll
                for (int bj = 0; bj < 2; ++bj) {
                    const int col = colb + bj * HALF;
                    const u32x4 zz = *(const u32x4*)(Z + row * DH + col), gg = *(const u32x4*)(GS + row * DH + col);
                    const f32x4 t0 = acc[ai][bj][m][0] + bv[bj][0], t1 = acc[ai][bj][m][1] + bv[bj][1];
                    f32x4 o0, o1;
                    o0[0] = bflo(zz.x) * sigmoid_f(t0[0]) * bflo(gg.x); o0[1] = bfhi(zz.x) * sigmoid_f(t0[1]) * bfhi(gg.x); o0[2] = bflo(zz.y) * sigmoid_f(t0[2]) * bflo(gg.y); o0[3] = bfhi(zz.y) * sigmoid_f(t0[3]) * bfhi(gg.y);
                    o1[0] = bflo(zz.z) * sigmoid_f(t1[0]) * bflo(gg.z); o1[1] = bfhi(zz.z) * sigmoid_f(t1[1]) * bfhi(gg.z); o1[2] = bflo(zz.w) * sigmoid_f(t1[2]) * bflo(gg.w); o1[3] = bfhi(zz.w) * sigmoid_f(t1[3]) * bfhi(gg.w);
                    *(u32x4*)(A2 + row * DM + DH + col) = pack8(o0, o1);
                }
            }
    }
};
struct EpiOut {
    static constexpr bool PERM = true, AFTER_DRAIN = false;
    const float* xp; const float* xs; float* out; int wmask;
    __device__ __forceinline__ void operator()(const f32x4 (&acc)[2][2][4][2], const Unit& u, int wr, int wc, int fr, int fq) const {
        const int rowb = u.pm * BM + wr * 64 + fr, colb = u.pn * BM + wc * 32 + 8 * fq;
#pragma unroll
        for (int ai = 0; ai < 2; ++ai)
#pragma unroll
            for (int m = 0; m < 4; ++m) {
                const int row = rowb + ai * HALF + m * 16;
                const bool pr = row < MP;
                if (!(wmask & (pr ? 16 : 8))) continue;
                const float* xr = pr ? xp + (size_t)row * DM : xs + (size_t)(row - MP) * DM;
                float* yr = pr ? out + O_YP + (size_t)row * DM : out + O_YS + (size_t)(row - MP) * DM;
#pragma unroll
                for (int bj = 0; bj < 2; ++bj) {
                    const int col = colb + bj * HALF;
                    const f32x4 x0 = *(const f32x4*)(xr + col), x1 = *(const f32x4*)(xr + col + 4);
                    *(f32x4*)(yr + col) = x0 + acc[ai][bj][m][0]; *(f32x4*)(yr + col + 4) = x1 + acc[ai][bj][m][1];
                }
            }
    }
};

template <class Epi, class Sched, bool ALIGN_EPI = false, bool SP2 = false>
__device__ __forceinline__ void gemm_phase(PG8_LAS unsigned char* lds, const Gemm g, const Sched& S, const Epi& E) {
    int tid_ = threadIdx.x; asm volatile("" : "+v"(tid_));
    const int tid = tid_, wid = __builtin_amdgcn_readfirstlane(tid >> 6), lane = tid & 63, wr = wid >> 2, wc = wid & 3, fr = lane & 15, fq = lane >> 4;
    const int K = g.K, nt = K / BK;
    unsigned voffA[2], voffB[2];
#pragma unroll
    for (int i = 0; i < 2; ++i) { int R, C; stage_rc(tid * 16 + i * 8192, R, C); const int Rb = Epi::PERM ? ((R & ~31) + perm32(R & 31)) : R;
        voffA[i] = (unsigned)(R * K + C) * 2u; voffB[i] = (unsigned)(Rb * K + C) * 2u; }
    const size_t kstep = (size_t)(BK * 2);
    const size_t hstep = (size_t)HALF * K * 2;
    const size_t tstep = 2 * hstep;
    const unsigned ldsw = (unsigned)wid * 1024u;
    const int aoff = lds_byte(wr * 64 + fr, fq * 8), boff = lds_byte(wc * 32 + fr, fq * 8);
#define PG8_SA(b, h) (((b) * 2 + (h)) * HTB)
#define PG8_SB(b, h) ((4 + (b) * 2 + (h)) * HTB)
#define PG8_STAGE(bufoff, gbase, voff) do { _Pragma("unroll") for (int _i = 0; _i < 2; ++_i) \
        __builtin_amdgcn_global_load_lds((const unsigned*)((const char*)(gbase) + (voff)[_i]), (PG8_LAS unsigned*)(lds + (bufoff) + ldsw + _i * 8192), 16, 0, 0); } while (0)
#define PG8_LDA(dst, b, h) do { _Pragma("unroll") for (int m = 0; m < 4; ++m) _Pragma("unroll") for (int k = 0; k < 2; ++k) dst[m][k] = *(const PG8_LAS bf16x8*)(lds + PG8_SA(b, h) + aoff + m * 2048 + k * 1024); } while (0)
#define PG8_LDB(dst, b, h) do { _Pragma("unroll") for (int n = 0; n < 2; ++n) _Pragma("unroll") for (int k = 0; k < 2; ++k) dst[n][k] = *(const PG8_LAS bf16x8*)(lds + PG8_SB(b, h) + boff + n * 2048 + k * 1024); } while (0)
#define PG8_MMA(ai, bj, At, Bt) do { __builtin_amdgcn_s_setprio(1); _Pragma("unroll") for (int m = 0; m < 4; ++m) _Pragma("unroll") for (int n = 0; n < 2; ++n) _Pragma("unroll") for (int k = 0; k < 2; ++k) \
        acc[ai][bj][m][n] = __builtin_amdgcn_mfma_f32_16x16x32_bf16(Bt[n][k], At[m][k], acc[ai][bj][m][n], 0, 0, 0); __builtin_amdgcn_s_setprio(0); } while (0)
#define PG8_WAIT_V(n) asm volatile("s_waitcnt vmcnt(" #n ")" ::: "memory")
#define PG8_WAIT_L(n) asm volatile("s_waitcnt lgkmcnt(" #n ")" ::: "memory")
#define PG8_BAR __builtin_amdgcn_s_barrier()
#define PG8_SCHED __builtin_amdgcn_sched_barrier(0)
    Unit cur, nxt; int ui = 0;
    if (!S.next(0, cur)) return;
    f32x4 acc[2][2][4][2];
#pragma unroll
    for (int a = 0; a < 2; ++a)
#pragma unroll
        for (int b = 0; b < 2; ++b)
#pragma unroll
            for (int m = 0; m < 4; ++m)
#pragma unroll
                for (int n = 0; n < 2; ++n) acc[a][b][m][n] = (f32x4){0.f, 0.f, 0.f, 0.f};
    bf16x8 At[4][2], B0[2][2], B1[2][2];
    const char* cA = (const char*)g.A + (size_t)cur.pm * tstep; const char* cB = (const char*)g.Bt + (size_t)cur.pn * tstep;
    S.a_ready(cur);
    if constexpr (SP2) {
        PG8_STAGE(PG8_SB(0, 0), cB, voffB); PG8_STAGE(PG8_SB(0, 1), cB + hstep, voffB); PG8_STAGE(PG8_SA(0, 0), cA, voffA); PG8_STAGE(PG8_SA(0, 1), cA + hstep, voffA);
        if (wr == 1) PG8_BAR;
        PG8_WAIT_V(2); PG8_BAR;
        PG8_STAGE(PG8_SB(1, 0), cB + kstep, voffB); PG8_STAGE(PG8_SA(1, 0), cA + kstep, voffA); PG8_STAGE(PG8_SB(1, 1), cB + hstep + kstep, voffB);
        PG8_WAIT_V(6); PG8_BAR;
    } else {
        PG8_STAGE(PG8_SB(0, 0), cB, voffB); PG8_STAGE(PG8_SA(0, 0), cA, voffA); PG8_STAGE(PG8_SB(0, 1), cB + hstep, voffB); PG8_STAGE(PG8_SA(0, 1), cA + hstep, voffA);
        if (wr == 1) PG8_BAR;
        PG8_WAIT_V(4); PG8_BAR;
        PG8_STAGE(PG8_SB(1, 0), cB + kstep, voffB); PG8_STAGE(PG8_SA(1, 0), cA + kstep, voffA); PG8_STAGE(PG8_SB(1, 1), cB + hstep + kstep, voffB);
        PG8_WAIT_V(6); PG8_BAR;
    }
    for (;;) {
        const bool has_next = S.next(ui + 1, nxt);
        const char* nA = has_next ? (const char*)g.A + (size_t)nxt.pm * tstep : cA; const char* nB = has_next ? (const char*)g.Bt + (size_t)nxt.pn * tstep : cB;
        for (int t = 0; t < nt; t += 2) {
            const bool last = (t == nt - 2);
            const char* a1 = cA + (size_t)(t + 1) * kstep;
            const char* a2 = last ? nA : cA + (size_t)(t + 2) * kstep; const char* b2 = last ? nB : cB + (size_t)(t + 2) * kstep;
            const char* a3 = a2 + kstep; const char* b3 = b2 + kstep;
            if (last && has_next) S.a_ready(nxt);
            if constexpr (SP2) {
            PG8_LDB(B0, 0, 0); PG8_LDB(B1, 0, 1); PG8_SCHED; PG8_LDA(At, 0, 0); PG8_STAGE(PG8_SA(1, 1), a1 + hstep, voffA);
            PG8_WAIT_V(8); PG8_WAIT_L(0); PG8_BAR; PG8_MMA(0, 0, At, B0); PG8_MMA(0, 1, At, B1); PG8_BAR; PG8_SCHED;
            PG8_LDA(At, 0, 1); PG8_STAGE(PG8_SB(0, 0), b2, voffB); PG8_STAGE(PG8_SB(0, 1), b2 + hstep, voffB); PG8_STAGE(PG8_SA(0, 0), a2, voffA);
            PG8_WAIT_V(8); PG8_WAIT_L(0); PG8_BAR; PG8_MMA(1, 0, At, B0); PG8_MMA(1, 1, At, B1); PG8_BAR; PG8_SCHED;
            PG8_LDB(B0, 1, 0); PG8_LDB(B1, 1, 1); PG8_SCHED; PG8_LDA(At, 1, 0); PG8_STAGE(PG8_SA(0, 1), a2 + hstep, voffA);
            PG8_WAIT_V(8); PG8_WAIT_L(0); PG8_BAR; PG8_MMA(0, 0, At, B0); PG8_MMA(0, 1, At, B1); PG8_BAR; PG8_SCHED;
            PG8_LDA(At, 1, 1); PG8_STAGE(PG8_SB(1, 0), b3, voffB); PG8_STAGE(PG8_SB(1, 1), b3 + hstep, voffB); PG8_STAGE(PG8_SA(1, 0), a3, voffA);
            PG8_WAIT_V(8); PG8_WAIT_L(0); PG8_BAR; PG8_MMA(1, 0, At, B0); PG8_MMA(1, 1, At, B1); PG8_BAR; PG8_SCHED;
            } else {
            PG8_LDB(B0, 0, 0); PG8_SCHED; PG8_LDA(At, 0, 0); PG8_STAGE(PG8_SA(1, 1), a1 + hstep, voffA);
            PG8_WAIT_L(8); PG8_BAR; PG8_WAIT_L(0); PG8_MMA(0, 0, At, B0); PG8_BAR; PG8_SCHED;
            PG8_LDB(B1, 0, 1); PG8_STAGE(PG8_SB(0, 0), b2, voffB);
            PG8_BAR; PG8_WAIT_L(0); PG8_MMA(0, 1, At, B1); PG8_BAR;
            PG8_LDA(At, 0, 1); PG8_STAGE(PG8_SA(0, 0), a2, voffA);
            PG8_BAR; PG8_WAIT_L(0); PG8_MMA(1, 0, At, B0); PG8_BAR; PG8_SCHED;
            PG8_STAGE(PG8_SB(0, 1), b2 + hstep, voffB);
            PG8_WAIT_V(6); PG8_BAR; PG8_MMA(1, 1, At, B1); PG8_BAR;
            PG8_LDB(B0, 1, 0); PG8_SCHED; PG8_LDA(At, 1, 0); PG8_STAGE(PG8_SA(0, 1), a2 + hstep, voffA);
            PG8_WAIT_L(8); PG8_BAR; PG8_WAIT_L(0); PG8_MMA(0, 0, At, B0); PG8_BAR; PG8_SCHED;
            PG8_LDB(B1, 1, 1); PG8_STAGE(PG8_SB(1, 0), b3, voffB);
            PG8_BAR; PG8_WAIT_L(0); PG8_MMA(0, 1, At, B1); PG8_BAR;
            PG8_LDA(At, 1, 1); PG8_STAGE(PG8_SA(1, 0), a3, voffA);
            PG8_BAR; PG8_WAIT_L(0); PG8_MMA(1, 0, At, B0); PG8_BAR; PG8_SCHED;
            PG8_STAGE(PG8_SB(1, 1), b3 + hstep, voffB);
            PG8_WAIT_V(6); PG8_BAR; PG8_MMA(1, 1, At, B1); PG8_BAR;
            }
        }
        if constexpr (ALIGN_EPI) { if (wr == 0) PG8_BAR; }
        if constexpr (!Epi::AFTER_DRAIN) { E(acc, cur, wr, wc, fr, fq); S.done(cur); }
        if (!has_next) break;
#pragma unroll
        for (int a = 0; a < 2; ++a)
#pragma unroll
            for (int b = 0; b < 2; ++b)
#pragma unroll
                for (int m = 0; m < 4; ++m)
#pragma unroll
                    for (int n = 0; n < 2; ++n) acc[a][b][m][n] = (f32x4){0.f, 0.f, 0.f, 0.f};
        cur = nxt; cA = nA; cB = nB; ++ui;
        if constexpr (ALIGN_EPI) { if (wr == 1) PG8_BAR; }
    }
    PG8_WAIT_V(0);
    if constexpr (!ALIGN_EPI) { if (wr == 0) PG8_BAR; }
    PG8_BAR;
    if constexpr (Epi::AFTER_DRAIN) { E.fused(acc, cur, wr, wc, fr, fq, lds, wid, lane); S.done(cur); }
#undef PG8_SA
#undef PG8_SB
#undef PG8_STAGE
#undef PG8_LDA
#undef PG8_LDB
#undef PG8_MMA
#undef PG8_WAIT_V
#undef PG8_WAIT_L
#undef PG8_BAR
#undef PG8_SCHED
}
}

#include <hip/hip_bf16.h>
#include <cmath>
namespace attn_body {
using bf16=__hip_bfloat16;
using bf16x8=__attribute__((ext_vector_type(8)))short;
using s16x4=__attribute__((ext_vector_type(4)))short;
using f32x16=__attribute__((ext_vector_type(16)))float;
using u32x4=__attribute__((ext_vector_type(4)))unsigned;
constexpr int BATCH=2,NHEAD=8,SEQ=8192,D=64,DV=128,QKP=512,VP=512,OP=1024;
constexpr int NW=8,QBLK=32,QB=QBLK*NW,KVBLK=64,NQB=SEQ/QB;
constexpr int ATTN_UNIT_ROWS=QB;
__device__ __forceinline__ int crow(int r,int hi){return (r&3)+8*(r>>2)+4*hi;}
#define SBAR() __builtin_amdgcn_sched_barrier(0)
typedef const __attribute__((address_space(3))) float* lds_cfp;
__device__ __forceinline__ void cmask(f32x16&p0,f32x16&p1,int jb,int qrel,int hi,lds_cfp bt){
  const float NEG=-INFINITY; const int kb=64*jb+4*hi;
  #pragma unroll
  for(int r=0;r<16;++r){const int d0=qrel-(kb+(r&3)+8*(r>>2)), d1=d0-32;
    const float b0=bt[d0<0?0:(d0>127?127:d0)], b1=bt[d1<0?0:(d1>127?127:d1)];
    p0[r]=d0<0?NEG:p0[r]+b0; p1[r]=d1<0?NEG:p1[r]+b1;}
}

constexpr int NSLOT=3, SLOTB=8192, SLOTV=16384;
constexpr int LDS_K=0, LDS_V=NSLOT*SLOTB, LDS_WS=LDS_V+NSLOT*SLOTV, LDS_OST=LDS_WS+NW*64*4, LDS_BYTES=LDS_OST+NW*4096;
constexpr float C2_=0.125f*1.4426950408889634f;
__device__ __forceinline__ void glds16(const void*gsrc,unsigned lds_dst){unsigned keep;
  asm volatile("s_mov_b32 %0, m0\n\ts_mov_b32 m0, %2\n\ts_nop 0\n\tglobal_load_lds_dwordx4 %1, off\n\ts_mov_b32 m0, %0":"=&s"(keep):"v"(gsrc),"s"(lds_dst):"memory");}
__device__ __forceinline__ float max3f(float a,float b,float c){float r;asm("v_max3_f32 %0, %1, %2, %3":"=v"(r):"v"(a),"v"(b),"v"(c));return r;}
__device__ __forceinline__ float max2f(float a,float b){float r;asm("v_max_f32_e32 %0, %1, %2":"=v"(r):"v"(a),"v"(b));return r;}
__device__ __forceinline__ float fadd_s(float a,float b){float r;asm("v_add_f32_e32 %0, %1, %2":"=v"(r):"v"(a),"v"(b));return r;}
__device__ __forceinline__ float fsub_s(float a,float b){float r;asm("v_sub_f32_e32 %0, %1, %2":"=v"(r):"v"(a),"v"(b));return r;}
typedef float f32x2_t __attribute__((ext_vector_type(2))); typedef __bf16 bf16x2_t __attribute__((ext_vector_type(2)));
__device__ __forceinline__ unsigned cvtpk_s(float lo,float hi){f32x2_t v={lo,hi};bf16x2_t b=__builtin_convertvector(v,bf16x2_t);return __builtin_bit_cast(unsigned,b);}
#define WAIT_BAR(N) asm volatile("s_waitcnt vmcnt(" #N ") lgkmcnt(0)\n\ts_barrier":::"memory")

__device__ __forceinline__ void qkt(f32x16&p0,f32x16&p1,const char*Kslot,const bf16x8*qr,const f32x16&negm,int r32,int hi){
  const char*kb=Kslot+hi*1024+r32*16;
  #pragma unroll
  for(int d0=0;d0<4;++d0){
    const bf16x8 b0=*reinterpret_cast<const bf16x8*>(kb+d0*2048);
    const bf16x8 b1=*reinterpret_cast<const bf16x8*>(kb+d0*2048+512);
    if(d0==0){p0=__builtin_amdgcn_mfma_f32_32x32x16_bf16(b0,qr[0],negm,0,0,0);p1=__builtin_amdgcn_mfma_f32_32x32x16_bf16(b1,qr[0],negm,0,0,0);}
    else{p0=__builtin_amdgcn_mfma_f32_32x32x16_bf16(b0,qr[d0],p0,0,0,0);p1=__builtin_amdgcn_mfma_f32_32x32x16_bf16(b1,qr[d0],p1,0,0,0);}}
}
typedef __attribute__((address_space(3))) const char* lds_cptr;
typedef short v4i16_t __attribute__((ext_vector_type(4)));
__device__ __forceinline__ void kload8(bf16x8*kf,lds_cptr kp){
  kf[0]=*(const __attribute__((address_space(3))) bf16x8*)(kp);      kf[1]=*(const __attribute__((address_space(3))) bf16x8*)(kp+512);
  kf[2]=*(const __attribute__((address_space(3))) bf16x8*)(kp+2048); kf[3]=*(const __attribute__((address_space(3))) bf16x8*)(kp+2560);
  kf[4]=*(const __attribute__((address_space(3))) bf16x8*)(kp+4096); kf[5]=*(const __attribute__((address_space(3))) bf16x8*)(kp+4608);
  kf[6]=*(const __attribute__((address_space(3))) bf16x8*)(kp+6144); kf[7]=*(const __attribute__((address_space(3))) bf16x8*)(kp+6656);
}
__device__ __forceinline__ void kload2(bf16x8*kf,lds_cptr kp,int j){ kf[2*j]=*(const __attribute__((address_space(3))) bf16x8*)(kp+j*2048); kf[2*j+1]=*(const __attribute__((address_space(3))) bf16x8*)(kp+j*2048+512); }
__device__ __forceinline__ s16x4 vtr(lds_cptr p){ return __builtin_bit_cast(s16x4,__builtin_amdgcn_ds_read_tr16_b64_v4i16((__attribute__((address_space(3))) v4i16_t*)p)); }
__device__ __forceinline__ float rowmax(const f32x16&p0,const f32x16&p1){
  float a=max3f(p0[0],p0[1],p1[0]),b=max3f(p0[2],p0[3],p1[1]);a=max3f(a,p1[2],p1[3]);
  #pragma unroll
  for(int r=4;r<16;r+=4){a=max3f(a,p0[r],p0[r+1]);b=max3f(b,p0[r+2],p0[r+3]);a=max3f(a,p1[r],p1[r+1]);b=max3f(b,p1[r+2],p1[r+3]);}
  const float m=max2f(a,b);
  auto rr=__builtin_amdgcn_permlane32_swap(__float_as_uint(m),__float_as_uint(m),false,false);
  return max2f(__uint_as_float(rr[0]),__uint_as_float(rr[1]));
}
__device__ __forceinline__ void pv(f32x16*o,int vb,bf16x8 pa0,bf16x8 pa1,bf16x8 pa2,bf16x8 pa3){
  #pragma unroll
  for(int d0=0;d0<4;++d0){s16x4 lo[4],hi[4];
    #pragma unroll
    for(int ks=0;ks<4;++ks){
      asm volatile("ds_read_b64_tr_b16 %0,%1 offset:%c2":"=&v"(lo[ks]):"v"(vb),"i"(d0*4096+ks*1024):"memory");
      asm volatile("ds_read_b64_tr_b16 %0,%1 offset:%c2":"=&v"(hi[ks]):"v"(vb),"i"(d0*4096+ks*1024+512):"memory");}
    asm volatile("s_waitcnt lgkmcnt(0)":::"memory");SBAR();
    #define PK(k) (bf16x8){lo[k][0],lo[k][1],lo[k][2],lo[k][3],hi[k][0],hi[k][1],hi[k][2],hi[k][3]}
    o[d0]=__builtin_amdgcn_mfma_f32_32x32x16_bf16(pa0,PK(0),o[d0],0,0,0);
    o[d0]=__builtin_amdgcn_mfma_f32_32x32x16_bf16(pa1,PK(1),o[d0],0,0,0);
    o[d0]=__builtin_amdgcn_mfma_f32_32x32x16_bf16(pa2,PK(2),o[d0],0,0,0);
    o[d0]=__builtin_amdgcn_mfma_f32_32x32x16_bf16(pa3,PK(3),o[d0],0,0,0);
    #undef PK
  }
}

#ifndef ATTN_STORE16
#define ATTN_STORE16(p,v) (*(u32x4*)(p)=(v))
#endif
template<int THRL> __device__ __forceinline__ void attn_unit(int b,int h,int qb,const bf16*Q,const bf16*__restrict__ K,const bf16*__restrict__ V,bf16*O,char*shm,lds_cfp btab){
  const lds_cfp bt=btab+(h>>1)*128;
  int tid_=threadIdx.x; asm volatile("":"+v"(tid_));
  const int tid=tid_,lane=tid&63,r32=lane&31,hi=lane>>5; const int wid=__builtin_amdgcn_readfirstlane(tid>>6);
  const long rowbase=(long)b*SEQ; const int q0=qb*QB;
  const bf16*Qw=Q+(rowbase+q0+wid*QBLK)*QKP+h*D;
  const bf16*Kh=K+rowbase*QKP+h*D,*Vh=V+rowbase*VP+(h>>1)*DV;
  const unsigned lds0=(unsigned)(uintptr_t)shm;
  float*wsf=(float*)(shm+LDS_WS)+wid*64;
  const bf16*ksrc=Kh+(long)lane*QKP+wid*8;
  const bf16*vsrc=Vh+(long)(16*(wid&3)+(lane>>2))*VP+(wid>>2)*32+(lane&3)*8;
  const unsigned kdst=lds0+LDS_K+wid*1024, vdst=lds0+LDS_V+wid*1024;
  #define DMA_K(t,slot) glds16(ksrc+(long)(t)*KVBLK*QKP,(unsigned)__builtin_amdgcn_readfirstlane(kdst+(slot)))
  #define DMA_V(t,slot) do{ glds16(vsrc+(long)(t)*KVBLK*VP,(unsigned)__builtin_amdgcn_readfirstlane(vdst+2*(slot))); glds16(vsrc+(long)(t)*KVBLK*VP+64,(unsigned)__builtin_amdgcn_readfirstlane(vdst+2*(slot)+8192)); }while(0)
  const int vb0=(int)(lds0+LDS_V)+((lane>>4)&1)*32+(lane&3)*8+(4*hi+((lane&15)>>2))*64;
  const char*Kbase=shm+LDS_K; bf16x8 kf[8];
  const lds_cptr shm3=(lds_cptr)shm; const lds_cptr kp0=shm3+LDS_K+hi*1024+r32*16; const lds_cptr vp0=shm3+LDS_V+((lane>>4)&1)*32+(lane&3)*8+(4*hi+((lane&15)>>2))*64;
  const int NT=(q0+QB)/KVBLK;
  DMA_K(0,0);DMA_V(0,0);DMA_K(1,SLOTB);
  bf16x8 qr[4];
  #pragma unroll
  for(int d0=0;d0<4;++d0)qr[d0]=*reinterpret_cast<const bf16x8*>(&Qw[(long)r32*QKP+d0*16+hi*8]);
  float mhat=0.f,l_reg=0.f;f32x16 o[4];o[0]=f32x16{};o[1]=f32x16{};o[2]=f32x16{};o[3]=f32x16{};const f32x16 zero16=f32x16{};
  const int qrel=wid*QBLK+r32;
  #define CMASK(P0,P1,t) do{int jb_=(t)-(NT-4); if(jb_>=-2)cmask(P0,P1,jb_,qrel,hi,bt);}while(0)
  bool resc=false;
  #define START(P0,P1) do{ const float rm=rowmax(P0,P1); resc=false; mhat=rm; \
    _Pragma("unroll") for(int r=0;r<16;++r)P0[r]=__builtin_amdgcn_exp2f(fsub_s(P0[r],mhat)); }while(0)
  #define RESC() do{ if(resc){ asm volatile("s_waitcnt lgkmcnt(0)":::"memory"); \
      _Pragma("unroll") for(int d_=0;d_<4;++d_) _Pragma("unroll") for(int r=0;r<16;++r)o[d_][r]*=wsf[crow(r,hi)]; } }while(0)
  f32x16 pA0,pA1,pB0,pB1;
  int sl_prev=0,sl_cur=0,sl_next=SLOTB;
  #define ROT() do{sl_prev=sl_cur;sl_cur=sl_next;sl_next=(sl_next==(NSLOT-1)*SLOTB)?0:sl_next+SLOTB;}while(0)
  DMA_K(2,2*SLOTB);
  WAIT_BAR(4);
  qkt(pA0,pA1,Kbase,qr,zero16,r32,hi);asm volatile("s_nop 15\n\ts_nop 7":"+v"(pA0),"+v"(pA1));CMASK(pA0,pA1,0);
  START(pA0,pA1);
  _Pragma("unroll") for(int r=0;r<16;++r)pA1[r]=__builtin_amdgcn_exp2f(fsub_s(pA1[r],mhat));
  WAIT_BAR(0);
  DMA_K(3,0);DMA_V(1,SLOTB);
  ROT();
  kload8(kf,kp0+sl_cur);
  WAIT_BAR(3);
  s16x4 vlo[4],vhi[4]; u32x4 pw0,pw1,pw2,pw3;
  #define PKW(P,B) cvtpk_s(P[B],P[B+1])
  #define PAF(k) __builtin_bit_cast(bf16x8,pw##k)
  #define VFR(j) (bf16x8){vlo[(j)&3][0],vlo[(j)&3][1],vlo[(j)&3][2],vlo[(j)&3][3],vhi[(j)&3][0],vhi[(j)&3][1],vhi[(j)&3][2],vhi[(j)&3][3]}
  #define PIN(x) asm volatile("":"+v"(x))
  #define MX3(a,b,c) __builtin_fmaxf(__builtin_fmaxf((a),(b)),(c))
  #define GAPA(MF,A0,A1,A2,A3,W0,W1,PW) do{ MF; sacc+=A0; sacc+=A1; sacc+=A2; sacc+=A3; PIN(sacc); W0; W1; PIN(PW); SBAR(); }while(0)
  #define EX(v) __builtin_amdgcn_exp2f(v)
  #define GAPB(MF,RD,X,B) do{ MF; RD; X[B]=EX(X[B]-mhat); X[B+1]=EX(X[B+1]-mhat); PIN(X); SBAR(); }while(0)
  #define VRD(j) do{ vlo[(j)&3]=vtr(vp_+(((j)&3)*4096+((j)>>2)*1024)); vhi[(j)&3]=vtr(vp_+(((j)&3)*4096+((j)>>2)*1024+512)); }while(0)
  #define KRD(G,j) do{ if(G){ kload2(kf,kp0+sl_next,j); SBAR(); } }while(0)
  #define STEP(C0,C1,P0,P1,t,GK,GV,GL) do{ SBAR(); \
    const lds_cptr vp_=vp0+2*sl_prev; \
    float sacc=(P0[0]+P0[1]); \
    GAPA(C0=__builtin_amdgcn_mfma_f32_32x32x16_bf16(kf[0],qr[0],zero16,0,0,0), P0[2],P0[3],P0[4],P0[5],     pw0[0]=PKW(P0,0), pw0[1]=PKW(P0,2), pw0); \
    GAPA(C1=__builtin_amdgcn_mfma_f32_32x32x16_bf16(kf[1],qr[0],zero16,0,0,0), P0[6],P0[7],P0[8],P0[9],     pw0[2]=PKW(P0,4), pw0[3]=PKW(P0,6), pw0); \
    GAPA(C0=__builtin_amdgcn_mfma_f32_32x32x16_bf16(kf[2],qr[1],C0,0,0,0),   P0[10],P0[11],P0[12],P0[13], pw1[0]=PKW(P0,8), pw1[1]=PKW(P0,10), pw1); \
    GAPA(C1=__builtin_amdgcn_mfma_f32_32x32x16_bf16(kf[3],qr[1],C1,0,0,0),   P0[14],P0[15],P1[0],P1[1],   pw1[2]=PKW(P0,12),pw1[3]=PKW(P0,14), pw1); \
    GAPA(C0=__builtin_amdgcn_mfma_f32_32x32x16_bf16(kf[4],qr[2],C0,0,0,0),   P1[2],P1[3],P1[4],P1[5],     pw2[0]=PKW(P1,0), pw2[1]=PKW(P1,2), pw2); \
    VRD(0); SBAR(); GAPA(C1=__builtin_amdgcn_mfma_f32_32x32x16_bf16(kf[5],qr[2],C1,0,0,0),   P1[6],P1[7],P1[8],P1[9],     pw2[2]=PKW(P1,4), pw2[3]=PKW(P1,6), pw2); \
    VRD(1); SBAR(); GAPA(C0=__builtin_amdgcn_mfma_f32_32x32x16_bf16(kf[6],qr[3],C0,0,0,0),   P1[10],P1[11],P1[12],P1[13], pw3[0]=PKW(P1,8), pw3[1]=PKW(P1,10), pw3); \
    VRD(2); SBAR(); GAPA(C1=__builtin_amdgcn_mfma_f32_32x32x16_bf16(kf[7],qr[3],C1,0,0,0),   P1[14],P1[15],0.f,0.f,       pw3[2]=PKW(P1,12),pw3[3]=PKW(P1,14), pw3); \
    l_reg+=sacc; \
    if(GK){DMA_K((t)+3,sl_cur);} if(GV){DMA_V((t)+1,sl_next);} \
    CMASK(C0,C1,t); \
    { float a=MX3(C0[0],C0[1],C1[0]),b=MX3(C0[2],C0[3],C1[1]); a=MX3(a,C1[2],C1[3]); \
      _Pragma("unroll") for(int r=4;r<16;r+=4){a=MX3(a,C0[r],C0[r+1]);b=MX3(b,C0[r+2],C0[r+3]);a=MX3(a,C1[r],C1[r+1]);b=MX3(b,C1[r+2],C1[r+3]);} \
      float rm=__builtin_fmaxf(a,b); { auto rr=__builtin_amdgcn_permlane32_swap(__float_as_uint(rm),__float_as_uint(rm),false,false); rm=__builtin_fmaxf(__uint_as_float(rr[0]),__uint_as_float(rr[1])); } \
      resc=false; rm-=mhat; \
      if(__builtin_expect(__any(rm>(float)THRL),0)){ const float dl=__builtin_fmaxf(rm,0.f); mhat+=dl; \
        const float f=__builtin_amdgcn_exp2f(-dl); l_reg*=f; if(hi==0)wsf[r32]=f; resc=true; } } \
    SBAR(); \
    GAPB(o[0]=__builtin_amdgcn_mfma_f32_32x32x16_bf16(PAF(0),VFR(0),o[0],0,0,0), VRD(3), C0,0); \
    GAPB(o[1]=__builtin_amdgcn_mfma_f32_32x32x16_bf16(PAF(0),VFR(1),o[1],0,0,0), VRD(4), C0,2); \
    KRD(GL,0); GAPB(o[2]=__builtin_amdgcn_mfma_f32_32x32x16_bf16(PAF(0),VFR(2),o[2],0,0,0), VRD(5), C0,4); \
    KRD(GL,1); GAPB(o[3]=__builtin_amdgcn_mfma_f32_32x32x16_bf16(PAF(0),VFR(3),o[3],0,0,0), VRD(6), C0,6); \
    KRD(GL,2); GAPB(o[0]=__builtin_amdgcn_mfma_f32_32x32x16_bf16(PAF(1),VFR(4),o[0],0,0,0), VRD(7), C0,8); \
    KRD(GL,3); GAPB(o[1]=__builtin_amdgcn_mfma_f32_32x32x16_bf16(PAF(1),VFR(5),o[1],0,0,0), VRD(8), C0,10); \
    GAPB(o[2]=__builtin_amdgcn_mfma_f32_32x32x16_bf16(PAF(1),VFR(6),o[2],0,0,0), VRD(9), C0,12); \
    GAPB(o[3]=__builtin_amdgcn_mfma_f32_32x32x16_bf16(PAF(1),VFR(7),o[3],0,0,0), VRD(10), C0,14); \
    GAPB(o[0]=__builtin_amdgcn_mfma_f32_32x32x16_bf16(PAF(2),VFR(8),o[0],0,0,0), VRD(11), C1,0); \
    GAPB(o[1]=__builtin_amdgcn_mfma_f32_32x32x16_bf16(PAF(2),VFR(9),o[1],0,0,0), VRD(12), C1,2); \
    GAPB(o[2]=__builtin_amdgcn_mfma_f32_32x32x16_bf16(PAF(2),VFR(10),o[2],0,0,0), VRD(13), C1,4); \
    GAPB(o[3]=__builtin_amdgcn_mfma_f32_32x32x16_bf16(PAF(2),VFR(11),o[3],0,0,0), VRD(14), C1,6); \
    GAPB(o[0]=__builtin_amdgcn_mfma_f32_32x32x16_bf16(PAF(3),VFR(12),o[0],0,0,0), VRD(15), C1,8); \
    GAPB(o[1]=__builtin_amdgcn_mfma_f32_32x32x16_bf16(PAF(3),VFR(13),o[1],0,0,0), (void)0, C1,10); \
    GAPB(o[2]=__builtin_amdgcn_mfma_f32_32x32x16_bf16(PAF(3),VFR(14),o[2],0,0,0), (void)0, C1,12); \
    GAPB(o[3]=__builtin_amdgcn_mfma_f32_32x32x16_bf16(PAF(3),VFR(15),o[3],0,0,0), (void)0, C1,14); \
    }while(0)
  int t=1;
  #undef CMASK
  #define CMASK(P0,P1,t) do{}while(0)
  for(;t+7<NT;t+=2){
    STEP(pB0,pB1,pA0,pA1,t,true,true,true);     WAIT_BAR(3); RESC(); ROT();
    STEP(pA0,pA1,pB0,pB1,t+1,true,true,true);   WAIT_BAR(3); RESC(); ROT();
  }
  #undef CMASK
  #define CMASK(P0,P1,t) do{int jb_=(t)-(NT-4); if(jb_>=-2)cmask(P0,P1,jb_,qrel,hi,bt);}while(0)
  #define ENDW(tt) do{ if((tt)+3<NT){WAIT_BAR(3);} else if((tt)+2<NT){WAIT_BAR(2);} else {WAIT_BAR(0);} }while(0)
  for(;t+1<NT;t+=2){
    STEP(pB0,pB1,pA0,pA1,t,(t+3<NT),(t+1<NT),(t+1<NT));       ENDW(t);   RESC(); ROT();
    STEP(pA0,pA1,pB0,pB1,t+1,(t+4<NT),(t+2<NT),(t+2<NT));     ENDW(t+1); RESC(); ROT();
  }
  STEP(pB0,pB1,pA0,pA1,NT-1,false,false,false); RESC();
  { float sacc=pB0[0]+pB0[1]; _Pragma("unroll") for(int r=2;r<16;++r)sacc+=pB0[r]; _Pragma("unroll") for(int r=0;r<16;++r)sacc+=pB1[r]; l_reg+=sacc;
    pw0=(u32x4){PKW(pB0,0),PKW(pB0,2),PKW(pB0,4),PKW(pB0,6)};pw1=(u32x4){PKW(pB0,8),PKW(pB0,10),PKW(pB0,12),PKW(pB0,14)};pw2=(u32x4){PKW(pB1,0),PKW(pB1,2),PKW(pB1,4),PKW(pB1,6)};pw3=(u32x4){PKW(pB1,8),PKW(pB1,10),PKW(pB1,12),PKW(pB1,14)};
    SBAR(); pv(o,vb0+2*sl_cur,PAF(0),PAF(1),PAF(2),PAF(3)); }
  #undef PKW
  #undef PAF
  #undef VFR
  #undef PIN
  #undef MX3
  #undef GAPA
  #undef GAPB
  #undef EX
  #undef VRD
  #undef KRD
  #undef STEP
  #undef ENDW
  {auto rr=__builtin_amdgcn_permlane32_swap(__float_as_uint(l_reg),__float_as_uint(l_reg),false,false);l_reg=__uint_as_float(rr[0])+__uint_as_float(rr[1]);}
  if(hi==0)wsf[32+r32]=l_reg;asm volatile("s_waitcnt lgkmcnt(0)":::"memory");
  float rli[16];
  #pragma unroll
  for(int r=0;r<16;++r)rli[r]=__builtin_amdgcn_rcpf(wsf[32+crow(r,hi)]);
  bf16*Ow=O+(rowbase+q0+wid*QBLK)*OP+h*DV;
  { bf16*stg=(bf16*)(shm+LDS_OST)+wid*2048;
    #pragma unroll
    for(int ps=0;ps<2;++ps){
      #pragma unroll
      for(int r=0;r<16;++r){const int orow=crow(r,hi);
        #pragma unroll
        for(int d0=0;d0<2;++d0)stg[orow*64+d0*32+r32]=__float2bfloat16(o[2*ps+d0][r]*rli[r]);}
      asm volatile("s_waitcnt lgkmcnt(0)":::"memory");
      #pragma unroll
      for(int i=0;i<4;++i){const int row=i*8+(lane>>3),ch=lane&7; const u32x4 v=*(const u32x4*)(stg+row*64+ch*8); ATTN_STORE16(Ow+(long)row*OP+ps*64+ch*8,v);}
      asm volatile("s_waitcnt lgkmcnt(0)":::"memory"); } }
  asm volatile("s_waitcnt lgkmcnt(0)\n\ts_barrier":::"memory");
  #undef DMA_K
  #undef DMA_V
  #undef CMASK
  #undef START
  #undef RESC
  #undef ROT
}
constexpr int ATTN_LDS_BYTES=LDS_BYTES;
struct AttnTensors { const bf16* Q; const bf16* K; const bf16* V; bf16* O; };
struct AttnUnit { int bh; int qb; };
struct StaticOrder {
  int vcu;
  __device__ __forceinline__ explicit StaticOrder(int grid,int block):vcu((block%8)*(grid/8)+block/8){}
  __device__ __forceinline__ bool next(int i,AttnUnit&u)const{ if(i>=2)return false; const int s=vcu&15; u.bh=vcu>>4; u.qb=(i==0)?s:31-s; return true; }
  __device__ __forceinline__ void a_ready(const AttnUnit&)const{}
  __device__ __forceinline__ void done(const AttnUnit&)const{}
};
template<class Sched,int THRL=8> __device__ __forceinline__ void attn_phase(char*lds,const AttnTensors&T,const Sched&S,lds_cfp btab){
  AttnUnit u;
  for(int i=0;S.next(i,u);++i){ S.a_ready(u); attn_unit<THRL>(u.bh/NHEAD,u.bh%NHEAD,u.qb,T.Q,T.K,T.V,T.O,lds,btab); S.done(u); }
}
#undef SBAR
#undef WAIT_BAR
}

constexpr int NWAVES = 8;
constexpr size_t MiB = 1u << 20;
constexpr size_t WS_CTL = 0, CTL_ZERO_BYTES = 1 * MiB;
constexpr size_t WS_WIN = 2 * MiB, WS_WOUT = 8 * MiB, WS_WGLU = 10 * MiB, WS_TAB = 11 * MiB, WS_E = 12 * MiB, WS_QS = 14 * MiB, WS_PART = 16 * MiB;
constexpr size_t WS_XN = 32 * MiB, WS_Q = 66 * MiB, WS_K = 98 * MiB, WS_V = 130 * MiB, WS_GA = 162 * MiB, WS_U = 179 * MiB, WS_GS = 196 * MiB, WS_Z = 213 * MiB, WS_A2 = 230 * MiB, WS_END = 264 * MiB;
constexpr int TB_LAM = 0, TB_BIAS = 64  , TB_END = 64 + 512;
constexpr int CW_BAR = 4096;

constexpr int RING_OFF = 0, RING_BYTES = 131072;
constexpr int LDSCTL_OFF = RING_BYTES, MISC_OFF = LDSCTL_OFF + 320;
constexpr int LDS_BYTES = 147456;

#define GAS __attribute__((address_space(1)))
#define LAS __attribute__((address_space(3)))
typedef unsigned short bf16;
typedef unsigned v4u __attribute__((ext_vector_type(4)));
typedef float f32x4 __attribute__((ext_vector_type(4)));
typedef short bf16x8 __attribute__((ext_vector_type(8)));
typedef GAS unsigned gu32;
typedef GAS unsigned long long gu64;
#define RLX_AGENT __ATOMIC_RELAXED, __HIP_MEMORY_SCOPE_AGENT
#define LDS_WAIT() asm volatile("s_waitcnt lgkmcnt(0)" ::: "memory")
#define VM_WAIT() asm volatile("s_waitcnt vmcnt(0)" ::: "memory")
__device__ __forceinline__ unsigned long long rt() { return __builtin_amdgcn_s_memrealtime(); }
__device__ __forceinline__ unsigned f2bf(float f) { unsigned u = __builtin_bit_cast(unsigned, f); return (u + 0x7fffu + ((u >> 16) & 1u)) >> 16; }
__device__ __forceinline__ unsigned pk2(float lo, float hi) { return f2bf(lo) | (f2bf(hi) << 16); }

#define XB_TMO      128
#define XB_XCNT(j)  (256  + 64 * (j))
#define XB_XSUB(j)  (1280 + 64 * (j))
#define XB_XGEN(j)  (2304 + 64 * (j))
#define XB_TOP      3328
#define XB_TOPGEN   3392
#define XCD_BAR_WORDS 3456
#define XB_SPIN_CAP (1u << 18)

__device__ __forceinline__ unsigned xb_ld(unsigned* p)              { return __hip_atomic_load(p, __ATOMIC_RELAXED, __HIP_MEMORY_SCOPE_AGENT); }
__device__ __forceinline__ unsigned xb_add(unsigned* p, unsigned v) { return __hip_atomic_fetch_add(p, v, __ATOMIC_RELAXED, __HIP_MEMORY_SCOPE_AGENT); }
__device__ __forceinline__ unsigned xb_xcc_id() { return (unsigned)__builtin_amdgcn_s_getreg((3 << 11) | 20) & 0xFu; }
#define XB_SPIN(cond, bar) do { unsigned _sp = 0; while (cond) { __builtin_amdgcn_s_sleep(1); \
    if ((++_sp & 255u) == 0u) { if (xb_ld(&(bar)[XB_TMO])) break; if (_sp > XB_SPIN_CAP) { atomicAdd(&(bar)[XB_TMO], 1u); break; } } } } while (0)

struct XcdBarrier {
    unsigned* bar; unsigned x;
    volatile LAS unsigned* st;
};

__device__ __forceinline__ XcdBarrier xcd_barrier_post(unsigned* bar, volatile LAS unsigned* st) {
    XcdBarrier b; b.bar = bar; b.x = xb_xcc_id(); b.st = st;
    if (threadIdx.x == 0) (void)xb_add(&bar[XB_XCNT(b.x)], 1u);
    return b;
}
__device__ __forceinline__ void xcd_barrier_complete(unsigned* bar, unsigned x, unsigned& nloc, unsigned& nx) {
    const unsigned G = gridDim.x * gridDim.y * gridDim.z;
    unsigned sum, cnt, mine, sp = 0u;
    for (;;) {
        sum = 0u; cnt = 0u; mine = 0u;
#pragma unroll
        for (unsigned j = 0; j < 16; ++j) { const unsigned c = xb_ld(&bar[XB_XCNT(j)]); sum += c; cnt += (c > 0u) ? 1u : 0u; mine = (j == x) ? c : mine; }
        if (sum == G) break;
        __builtin_amdgcn_s_sleep(1);
        if ((++sp & 255u) == 0u) { if (xb_ld(&bar[XB_TMO])) break; if (sp > XB_SPIN_CAP) { atomicAdd(&bar[XB_TMO], 1u); break; } }
    }
    nloc = mine > 0u ? mine : 1u; nx = cnt > 0u ? cnt : 1u;
}

__device__ __forceinline__ void xcd_barrier(const XcdBarrier& b) {
    asm volatile("s_waitcnt vmcnt(0)" ::: "memory");
    __syncthreads();
    if (threadIdx.x == 0) {
        unsigned* bar = b.bar;
        __builtin_amdgcn_s_waitcnt(0);
        unsigned nloc = b.st[0], nx = b.st[1];
        if (nloc == 0u) { xcd_barrier_complete(bar, b.x, nloc, nx); b.st[0] = nloc; b.st[1] = nx; }
        const unsigned old = xb_add(&bar[XB_XSUB(b.x)], 1u);
        const unsigned gen = old / nloc;
        if (old + 1u == (gen + 1u) * nloc) {
            __builtin_amdgcn_fence(__ATOMIC_RELEASE, "agent");
            asm volatile("s_waitcnt vmcnt(0)" ::: "memory");
            const unsigned og = xb_add(&bar[XB_TOP], 1u);
            const unsigned tg = og / nx;
            if (og + 1u == (tg + 1u) * nx) xb_add(&bar[XB_TOPGEN], 1u);
            else XB_SPIN(xb_ld(&bar[XB_TOPGEN]) == tg, bar);
            __builtin_amdgcn_fence(__ATOMIC_ACQUIRE, "agent");
            xb_add(&bar[XB_XGEN(b.x)], 1u);
            asm volatile("s_waitcnt vmcnt(0)" ::: "memory");
        } else {
            XB_SPIN(xb_ld(&bar[XB_XGEN(b.x)]) == gen, bar);
            __builtin_amdgcn_fence(__ATOMIC_ACQUIRE, "agent");
            asm volatile("s_waitcnt vmcnt(0)" ::: "memory");
        }
    }
    __syncthreads();
}

template <int CTRL> __device__ __forceinline__ float dpp_mov(float x) { return __builtin_bit_cast(float, __builtin_amdgcn_mov_dpp(__builtin_bit_cast(int, x), CTRL, 0xf, 0xf, true)); }
__device__ __forceinline__ float wave_sum(float v) {
    v += dpp_mov<0xB1>(v); v += dpp_mov<0x4E>(v); v += dpp_mov<0x141>(v); v += dpp_mov<0x128>(v);
    auto s = __builtin_amdgcn_permlane16_swap(__float_as_uint(v), __float_as_uint(v), false, false);
    v = __uint_as_float(s[0]) + __uint_as_float(s[1]);
    auto t = __builtin_amdgcn_permlane32_swap(__float_as_uint(v), __float_as_uint(v), false, false);
    return __uint_as_float(t[0]) + __uint_as_float(t[1]);
}
__device__ __forceinline__ void p0_transpose_item(const float* W, int K, int N, bf16* WT, bool permute, LAS float* scr, int item, int lane) {
    const int nblk = N / 32, kb = item / nblk, nb = item % nblk, k0 = 64 * kb, n0 = 32 * nb;
    int d0 = n0; if (permute) { const int a = n0 & 255; d0 = (n0 & ~255) + 128 * ((a >> 5) & 1) + 32 * (a >> 6); }
    float tv[32];
#pragma unroll
    for (int i = 0; i < 32; ++i) { const int kk = 2 * i + (lane >> 5); tv[i] = W[(size_t)(k0 + kk) * N + n0 + (lane & 31)]; }
#pragma unroll
    for (int i = 0; i < 32; ++i) { const int kk = 2 * i + (lane >> 5); scr[kk * 33 + (lane & 31)] = tv[i]; }
    LDS_WAIT(); asm volatile("" ::: "memory");
    const int c = lane & 7;
#pragma unroll
    for (int j = 0; j < 4; ++j) { const int n = (lane >> 3) + 8 * j; const LAS float* s = scr + (8 * c) * 33 + n;
        v4u o; o.x = pk2(s[0 * 33], s[1 * 33]); o.y = pk2(s[2 * 33], s[3 * 33]); o.z = pk2(s[4 * 33], s[5 * 33]); o.w = pk2(s[6 * 33], s[7 * 33]);
        *(GAS v4u*)(WT + (size_t)(d0 + n) * K + k0 + 8 * c) = o; }
    LDS_WAIT(); asm volatile("" ::: "memory");
}
__device__ __forceinline__ void rms_rows2_to_bf16(const float* xa, const float* xb, const float* g, bf16* oa, bf16* ob, int lane) {
    const GAS f32x4* pa = (const GAS f32x4*)xa + lane; const GAS f32x4* pb = (const GAS f32x4*)xb + lane; const GAS f32x4* gr = (const GAS f32x4*)g + lane;
    f32x4 va[4], vb[4], gg[4]; float sa = 0.f, sb = 0.f;
#pragma unroll
    for (int j = 0; j < 4; ++j) { va[j] = pa[64 * j]; vb[j] = pb[64 * j]; gg[j] = gr[64 * j]; }
#pragma unroll
    for (int j = 0; j < 4; ++j) { sa += (va[j].x * va[j].x + va[j].y * va[j].y) + (va[j].z * va[j].z + va[j].w * va[j].w); sb += (vb[j].x * vb[j].x + vb[j].y * vb[j].y) + (vb[j].z * vb[j].z + vb[j].w * vb[j].w); }
    const float ra = rsqrtf(wave_sum(sa) * (1.f / DM) + EPS), rb = rsqrtf(wave_sum(sb) * (1.f / DM) + EPS);
    GAS unsigned long long* qa = (GAS unsigned long long*)oa + lane; GAS unsigned long long* qb = (GAS unsigned long long*)ob + lane;
#pragma unroll
    for (int j = 0; j < 4; ++j) { const f32x4 ya = va[j] * ra * gg[j], yb = vb[j] * rb * gg[j];
        qa[64 * j] = (unsigned long long)pk2(ya.x, ya.y) | ((unsigned long long)pk2(ya.z, ya.w) << 32);
        qb[64 * j] = (unsigned long long)pk2(yb.x, yb.y) | ((unsigned long long)pk2(yb.z, yb.w) << 32); }
}
__device__ __forceinline__ int t5_bucket(int n) {
    if (n < 16) return n;
    int b = 16;
    b += (n >= 19); b += (n >= 21); b += (n >= 24); b += (n >= 27); b += (n >= 31); b += (n >= 35); b += (n >= 40); b += (n >= 46);
    b += (n >= 52); b += (n >= 59); b += (n >= 67); b += (n >= 77); b += (n >= 87); b += (n >= 99); b += (n >= 113);
    return b;
}

typedef float f32x16 __attribute__((ext_vector_type(16)));
typedef float f32x2 __attribute__((ext_vector_type(2)));
typedef unsigned u32x2 __attribute__((ext_vector_type(2)));
typedef unsigned u32x4 __attribute__((ext_vector_type(4)));
__device__ __forceinline__ float bf_lo(unsigned w) { return __uint_as_float(w << 16); }
__device__ __forceinline__ float bf_hi(unsigned w) { return __uint_as_float(w & 0xffff0000u); }
__device__ __forceinline__ unsigned pkbf(float lo, float hi) { return pg8::cvt_pk_bf16(lo, hi); }
__device__ __forceinline__ float ex2(float x) { return __builtin_amdgcn_exp2f(x); }
template <int CTRL> __device__ __forceinline__ float dppf(float x) { return __builtin_bit_cast(float, __builtin_amdgcn_mov_dpp(__builtin_bit_cast(int, x), CTRL, 0xf, 0xf, true)); }
__device__ __forceinline__ float sum16(float v) { v += dppf<0xB1>(v); v += dppf<0x4E>(v); v += dppf<0x141>(v); v += dppf<0x128>(v); return v; }
__device__ __forceinline__ float bc_lo(float x) { auto r = __builtin_amdgcn_permlane32_swap(__float_as_uint(x), __float_as_uint(x), false, false); return __uint_as_float(r[0]); }
__device__ __forceinline__ float bc_hi(float x) { auto r = __builtin_amdgcn_permlane32_swap(__float_as_uint(x), __float_as_uint(x), false, false); return __uint_as_float(r[1]); }
__device__ __forceinline__ void cfma(float& xr, float& xi, float ar, float ai, float br, float bi) { xr = fmaf(ar, br, fmaf(-ai, bi, xr)); xi = fmaf(ar, bi, fmaf(ai, br, xi)); }
__device__ __forceinline__ float gelu_tanh_f(float x) { const float t = 1.5957691216057308f * (x + 0.044715f * x * x * x); return x * __builtin_amdgcn_rcpf(1.0f + __expf(-t)); }

constexpr size_t OFF_TP = 4096, OFF_TA256 = OFF_TP + 65536, OFF_TBF = OFF_TA256 + 16384, OFF_TBB = OFF_TBF + 262144, OFF_TCC = OFF_TBB + 131072, OFF_TEND = OFF_TCC + 131072;
static_assert(OFF_TEND <= (1u << 20), "tables fit");
constexpr size_t WS_KS = 15 * MiB, WS_VS = 13 * MiB;
constexpr size_t WS_PML = WS_PART + 8 * MiB;
constexpr int BT_LDS_OFF = 114688;
constexpr int HROW = 68;

template <bool FULL> __device__ __forceinline__ void ssm_scan_state(f32x16& xr, f32x16& xi, const float (&pw)[8], float& cr, float& ci, bool hi_half) {
#pragma unroll
    for (int i = 0; i < 4; ++i)
#pragma unroll
        for (int j = 1; j < 4; ++j) { float a = xr[4 * i + j], b = xi[4 * i + j]; cfma(a, b, pw[0], pw[1], xr[4 * i + j - 1], xi[4 * i + j - 1]); xr[4 * i + j] = a; xi[4 * i + j] = b; }
    float cinr[4], cini[4];
#pragma unroll
    for (int i = 0; i < 4; ++i) {
        float t0r = xr[4 * i + 3], t0i = xi[4 * i + 3]; cfma(t0r, t0i, pw[6], pw[7], cr, ci);
        const float sr = bc_lo(t0r), si = bc_lo(t0i);
        cinr[i] = hi_half ? sr : cr; cini[i] = hi_half ? si : ci;
        float t1r = xr[4 * i + 3], t1i = xi[4 * i + 3]; cfma(t1r, t1i, pw[6], pw[7], sr, si);
        cr = bc_hi(t1r); ci = bc_hi(t1i);
    }
    if (FULL) {
#pragma unroll
        for (int i = 0; i < 4; ++i)
#pragma unroll
            for (int j = 0; j < 4; ++j) { float a = xr[4 * i + j], b = xi[4 * i + j]; cfma(a, b, pw[2 * j], pw[2 * j + 1], cinr[i], cini[i]); xr[4 * i + j] = a; xi[4 * i + j] = b; }
    }
}

template <bool FULL> __device__ __forceinline__ void ssm_chunk(int b, int chunk, int g, const unsigned char* tab, const bf16* U, float* E, const float* dsk, bf16* Z, float* out, int wmask, LAS unsigned* Hs, int lane) {
    const int r = lane & 31, hh = lane >> 5;
    bf16x8 Bf[4];
#pragma unroll
    for (int X = 0; X < 4; ++X) Bf[X] = *(const bf16x8*)(tab + OFF_TBB + ((size_t)(g * 4 + X) * 64 + lane) * 16);
    float pwl[8], pwh[8];
    { const f32x4* p = (const f32x4*)(tab + OFF_TP + (size_t)(g * 64 + r) * 32); const f32x4 a = p[0], c = p[1]; pwl[0] = a.x; pwl[1] = a.y; pwl[2] = a.z; pwl[3] = a.w; pwl[4] = c.x; pwl[5] = c.y; pwl[6] = c.z; pwl[7] = c.w; }
    { const f32x4* p = (const f32x4*)(tab + OFF_TP + (size_t)(g * 64 + 32 + r) * 32); const f32x4 a = p[0], c = p[1]; pwh[0] = a.x; pwh[1] = a.y; pwh[2] = a.z; pwh[3] = a.w; pwh[4] = c.x; pwh[5] = c.y; pwh[6] = c.z; pwh[7] = c.w; }
    float clr = 0.f, cli = 0.f, chr = 0.f, chi = 0.f;
    bf16x8 Cf[4]; f32x4 dv = {0.f, 0.f, 0.f, 0.f};
    if (FULL) {
        const f32x2 al = *(const f32x2*)(tab + OFF_TA256 + (size_t)(g * 64 + r) * 8), ah = *(const f32x2*)(tab + OFF_TA256 + (size_t)(g * 64 + 32 + r) * 8);
        for (int j0 = 0; j0 < chunk; j0 += 8) {
            f32x2 el[8], eh[8];
#pragma unroll
            for (int jj = 0; jj < 8; ++jj) { const int j = (j0 + jj < chunk) ? j0 + jj : j0; const float* e = E + ((size_t)((b * 32 + j) * 32 + g) * 64) * 2; el[jj] = *(const f32x2*)(e + 2 * r); eh[jj] = *(const f32x2*)(e + 2 * (32 + r)); }
#pragma unroll
            for (int jj = 0; jj < 8; ++jj) if (j0 + jj < chunk) {
                float nr = el[jj].x, ni = el[jj].y; cfma(nr, ni, al.x, al.y, clr, cli); clr = nr; cli = ni;
                float mr = eh[jj].x, mi = eh[jj].y; cfma(mr, mi, ah.x, ah.y, chr, chi); chr = mr; chi = mi;
            }
        }
#pragma unroll
        for (int s = 0; s < 4; ++s) Cf[s] = *(const bf16x8*)(tab + OFF_TCC + ((size_t)(g * 4 + s) * 64 + lane) * 16);
        dv = *(const f32x4*)(dsk + g * 16 + 4 * (lane >> 4));
    }
    const size_t row_c = (size_t)b * SEQ + (size_t)chunk * 256;
    bf16x8 ufs[8];
#pragma unroll
    for (int tile = 0; tile < 8; ++tile) ufs[tile] = *(const bf16x8*)(U + (row_c + tile * 32 + r) * DH + 16 * g + 8 * hh);
#pragma unroll
    for (int tile = 0; tile < 8; ++tile) {
        const size_t row0 = row_c + tile * 32;
        const bf16x8 uf = ufs[tile];
        u32x2 uws[2];
        if (FULL) {
#pragma unroll
            for (int nb = 0; nb < 2; ++nb) uws[nb] = *(const u32x2*)(U + (row0 + 16 * nb + (lane & 15)) * DH + 16 * g + 4 * (lane >> 4));
        }
        const f32x16 zero = {};
        f32x16 X0 = __builtin_amdgcn_mfma_f32_32x32x16_bf16(uf, Bf[0], zero, 0, 0, 0);
        f32x16 X1 = __builtin_amdgcn_mfma_f32_32x32x16_bf16(uf, Bf[1], zero, 0, 0, 0);
        f32x16 X2 = __builtin_amdgcn_mfma_f32_32x32x16_bf16(uf, Bf[2], zero, 0, 0, 0);
        f32x16 X3 = __builtin_amdgcn_mfma_f32_32x32x16_bf16(uf, Bf[3], zero, 0, 0, 0);
        ssm_scan_state<FULL>(X0, X2, pwl, clr, cli, hh != 0);
        ssm_scan_state<FULL>(X1, X3, pwh, chr, chi, hh != 0);
        if (FULL) {
#pragma unroll
            for (int q = 0; q < 16; ++q) { const int t = (q & 3) + 8 * (q >> 2) + 4 * hh;
                Hs[t * HROW + r] = pkbf(X0[q], X2[q]); Hs[t * HROW + 32 + r] = pkbf(X1[q], X3[q]); }
            asm volatile("s_waitcnt lgkmcnt(0)" ::: "memory");
#pragma unroll
            for (int nb = 0; nb < 2; ++nb) {
                f32x4 acc = {0.f, 0.f, 0.f, 0.f};
#pragma unroll
                for (int s = 0; s < 4; ++s) { const bf16x8 hf = *(const LAS bf16x8*)(Hs + (16 * nb + (lane & 15)) * HROW + 16 * s + 4 * (lane >> 4));
                    acc = __builtin_amdgcn_mfma_f32_16x16x32_bf16(Cf[s], hf, acc, 0, 0, 0); }
                const size_t row = row0 + 16 * nb + (lane & 15); const int col = 16 * g + 4 * (lane >> 4);
                const u32x2 uw = uws[nb];
                const float y0 = acc[0] + dv[0] * bf_lo(uw.x), y1 = acc[1] + dv[1] * bf_hi(uw.x), y2 = acc[2] + dv[2] * bf_lo(uw.y), y3 = acc[3] + dv[3] * bf_hi(uw.y);
                u32x2 zw; zw.x = pkbf(gelu_tanh_f(y0), gelu_tanh_f(y1)); zw.y = pkbf(gelu_tanh_f(y2), gelu_tanh_f(y3));
                *(u32x2*)(Z + row * DH + col) = zw;
            }
            asm volatile("s_waitcnt lgkmcnt(0)" ::: "memory");
        }
    }
    if (!FULL) {
        if (hh == 0) { float* e = E + ((size_t)((b * 32 + chunk) * 32 + g) * 64) * 2; *(f32x2*)(e + 2 * r) = (f32x2){clr, cli}; *(f32x2*)(e + 2 * (32 + r)) = (f32x2){chr, chi}; }
    } else if (chunk == 31 && (wmask & 2) && hh == 0) {
        const int o = (b * 32 + g) * 64;
        out[O_SRP + o + r] = clr; out[O_SIP + o + r] = cli; out[O_SRP + o + 32 + r] = chr; out[O_SIP + o + 32 + r] = chi;
    }
}

__device__ __forceinline__ void ssm_sample_item(int b, int g, const unsigned char* tab, const bf16* U, const float* h0re, const float* h0im, const float* cre, const float* cim, const float* dsk,
                                                bf16* Z, float* out, int wmask, int p) {
    const f32x2 a1 = *(const f32x2*)(tab + OFF_TP + (size_t)(g * 64 + p) * 32);
    float bbr[16], bbi[16], cr[16], ci[16];
    { const f32x4* t = (const f32x4*)(tab + OFF_TBF + (size_t)(g * 64 + p) * 128);
#pragma unroll
      for (int k = 0; k < 4; ++k) { const f32x4 x = t[k], y = t[4 + k]; bbr[4 * k] = x.x; bbr[4 * k + 1] = x.y; bbr[4 * k + 2] = x.z; bbr[4 * k + 3] = x.w; bbi[4 * k] = y.x; bbi[4 * k + 1] = y.y; bbi[4 * k + 2] = y.z; bbi[4 * k + 3] = y.w; } }
#pragma unroll
    for (int c = 0; c < 16; ++c) { cr[c] = cre[(g * 16 + c) * 64 + p]; ci[c] = cim[(g * 16 + c) * 64 + p]; }
    float hr = h0re[(b * 32 + g) * 64 + p], hi = h0im[(b * 32 + g) * 64 + p];
    const float dd = dsk[g * 16 + (p & 15)];
    for (int t = 0; t < 4; ++t) {
        const size_t row = (size_t)MP + b * 4 + t;
        const u32x4 w0 = *(const u32x4*)(U + row * DH + 16 * g), w1 = *(const u32x4*)(U + row * DH + 16 * g + 8);
        float u[16];
        u[0] = bf_lo(w0.x); u[1] = bf_hi(w0.x); u[2] = bf_lo(w0.y); u[3] = bf_hi(w0.y); u[4] = bf_lo(w0.z); u[5] = bf_hi(w0.z); u[6] = bf_lo(w0.w); u[7] = bf_hi(w0.w);
        u[8] = bf_lo(w1.x); u[9] = bf_hi(w1.x); u[10] = bf_lo(w1.y); u[11] = bf_hi(w1.y); u[12] = bf_lo(w1.z); u[13] = bf_hi(w1.z); u[14] = bf_lo(w1.w); u[15] = bf_hi(w1.w);
        float ur = 0.f, ui = 0.f;
#pragma unroll
        for (int c = 0; c < 16; ++c) { ur = fmaf(bbr[c], u[c], ur); ui = fmaf(bbi[c], u[c], ui); }
        cfma(ur, ui, a1.x, a1.y, hr, hi); hr = ur; hi = ui;
        float yv = 0.f, uc = 0.f;
#pragma unroll
        for (int c = 0; c < 16; ++c) { const float s = wave_sum(cr[c] * hr - ci[c] * hi); if (p == c) { yv = s; uc = u[c]; } }
        if (p < 16) { const float z = gelu_tanh_f(yv + dd * uc); Z[row * DH + 16 * g + p] = (bf16)(pkbf(z, z) & 0xffffu); }
    }
    if (wmask & 4) { out[O_SRS + (b * 32 + g) * 64 + p] = hr; out[O_SIS + (b * 32 + g) * 64 + p] = hi; }
}

struct DecAcc { float m, l; f32x4 o0[4], o1[4]; };
template <int Q> __device__ __forceinline__ float quad_bc(float x) { return dppf<Q * 0x55>(x); }
__device__ __forceinline__ void dec_key(DecAcc& A, const f32x4 (&qv)[4], const f32x4 kv, const f32x4 v0, const f32x4 v1, bool near, int key, const float* bt, bool b0, bool b1, int qi_l) {
    float d[4];
#pragma unroll
    for (int qi = 0; qi < 4; ++qi) d[qi] = fmaf(kv.w, qv[qi].w, fmaf(kv.z, qv[qi].z, fmaf(kv.y, qv[qi].y, kv.x * qv[qi].x)));
    const float ka = b0 ? d[1] : d[0], sa = b0 ? d[0] : d[1], kb = b0 ? d[3] : d[2], sb = b0 ? d[2] : d[3];
    const float ra = ka + dppf<0xB1>(sa), rb = kb + dppf<0xB1>(sb);
    const float k2 = b1 ? rb : ra, s2 = b1 ? ra : rb;
    float s = k2 + dppf<0x4E>(s2);
    s += dppf<0x124>(s); s += dppf<0x128>(s);
    if (near) { const int dd = 128 + qi_l - key; s += bt[dd > 127 ? 127 : dd]; }
    if (__any(s > A.m + 8.0f)) {
        const float mn = fmaxf(A.m, s), a = ex2(A.m - mn); A.l *= a; A.m = mn;
        const float a0 = quad_bc<0>(a), a1 = quad_bc<1>(a), a2 = quad_bc<2>(a), a3 = quad_bc<3>(a);
        A.o0[0] = A.o0[0] * a0; A.o1[0] = A.o1[0] * a0; A.o0[1] = A.o0[1] * a1; A.o1[1] = A.o1[1] * a1; A.o0[2] = A.o0[2] * a2; A.o1[2] = A.o1[2] * a2; A.o0[3] = A.o0[3] * a3; A.o1[3] = A.o1[3] * a3;
    }
    const float p = ex2(s - A.m); A.l += p;
    const float p0 = quad_bc<0>(p), p1 = quad_bc<1>(p), p2 = quad_bc<2>(p), p3 = quad_bc<3>(p);
    A.o0[0] = A.o0[0] + v0 * p0; A.o1[0] = A.o1[0] + v1 * p0; A.o0[1] = A.o0[1] + v0 * p1; A.o1[1] = A.o1[1] + v1 * p1;
    A.o0[2] = A.o0[2] + v0 * p2; A.o1[2] = A.o1[2] + v1 * p2; A.o0[3] = A.o0[3] + v0 * p3; A.o1[3] = A.o1[3] + v1 * p3;
}
__device__ __forceinline__ void decode_item(int b, int h, int sp, const float* QS, const float* ck, const float* cv, const int* pt, const float* bt, float* PO, float* PML, int lane) {
    const int hh = lane >> 5, cg = (lane >> 4) & 1, i16 = lane & 15;
    f32x4 qv[4];
#pragma unroll
    for (int qi = 0; qi < 4; ++qi) qv[qi] = *(const f32x4*)(QS + (size_t)(b * 4 + qi) * DH + h * 128 + cg * 64 + 4 * i16);
    DecAcc A;
#pragma unroll
    for (int qi = 0; qi < 4; ++qi) { A.o0[qi] = (f32x4){0.f, 0.f, 0.f, 0.f}; A.o1[qi] = (f32x4){0.f, 0.f, 0.f, 0.f}; }
    A.m = -1e30f; A.l = 0.f;
    const bool b0 = (lane & 1) != 0, b1 = (lane & 2) != 0; const int qi_l = lane & 3;
    int pg[4];
#pragma unroll
    for (int i = 0; i < 4; ++i) pg[i] = __builtin_amdgcn_readfirstlane(pt[b * NPAGES + sp * 4 + i]);
    const size_t koff = (size_t)h * 128 + cg * 64 + 4 * i16 + (size_t)hh * 512, voff = (size_t)h * 128 + 4 * i16 + (size_t)hh * 512;
    f32x4 kA[2], vA[2], wA[2], kB[2], vB[2], wB[2], kC[2], vC[2], wC[2], kD[2], vD[2], wD[2];
#define DEC_LOAD(KQ, VA, VC, g) do { const int pgi_ = (g) >> 5; const int pgn_ = pgi_ == 0 ? pg[0] : pgi_ == 1 ? pg[1] : pgi_ == 2 ? pg[2] : pg[3]; \
        const float* kb_ = ck + (size_t)pgn_ * (PAGE * 512) + koff + (size_t)((g) & 31) * 2048; const float* vb_ = cv + (size_t)pgn_ * (PAGE * 512) + voff + (size_t)((g) & 31) * 2048; \
        _Pragma("unroll") for (int u = 0; u < 2; ++u) { KQ[u] = __builtin_nontemporal_load((const f32x4*)(kb_ + u * 1024)); VA[u] = __builtin_nontemporal_load((const f32x4*)(vb_ + u * 1024)); \
            VC[u] = __builtin_nontemporal_load((const f32x4*)(vb_ + u * 1024 + 64)); } } while (0)
#define DEC_MATH(KQ, VA, VC, g) do { const bool near_ = (sp == 3) && ((g) >> 5) == 3; const int it0_ = ((g) & 31) * 2; \
        _Pragma("unroll") for (int u = 0; u < 2; ++u) dec_key(A, qv, KQ[u], VA[u], VC[u], near_, 2 * (it0_ + u) + hh, bt, b0, b1, qi_l); } while (0)
    DEC_LOAD(kA, vA, wA, 0); DEC_LOAD(kB, vB, wB, 1); DEC_LOAD(kC, vC, wC, 2);
    for (int g = 0; g < 128; g += 4) {
        DEC_LOAD(kD, vD, wD, g + 3);
        DEC_MATH(kA, vA, wA, g);
        if (g + 4 < 128) DEC_LOAD(kA, vA, wA, g + 4);
        DEC_MATH(kB, vB, wB, g + 1);
        if (g + 5 < 128) DEC_LOAD(kB, vB, wB, g + 5);
        DEC_MATH(kC, vC, wC, g + 2);
        if (g + 6 < 128) DEC_LOAD(kC, vC, wC, g + 6);
        DEC_MATH(kD, vD, wD, g + 3);
    }
#undef DEC_LOAD
#undef DEC_MATH
    {
        const float mo = __shfl_xor(A.m, 32), lo = __shfl_xor(A.l, 32), mn = fmaxf(A.m, mo), a = ex2(A.m - mn), ao = ex2(mo - mn);
        A.l = A.l * a + lo * ao; A.m = mn;
        float aq[4], aoq[4];
        aq[0] = quad_bc<0>(a); aq[1] = quad_bc<1>(a); aq[2] = quad_bc<2>(a); aq[3] = quad_bc<3>(a);
        aoq[0] = quad_bc<0>(ao); aoq[1] = quad_bc<1>(ao); aoq[2] = quad_bc<2>(ao); aoq[3] = quad_bc<3>(ao);
#pragma unroll
        for (int qi = 0; qi < 4; ++qi)
#pragma unroll
            for (int e = 0; e < 4; ++e) { A.o0[qi][e] = A.o0[qi][e] * aq[qi] + __shfl_xor(A.o0[qi][e], 32) * aoq[qi]; A.o1[qi][e] = A.o1[qi][e] * aq[qi] + __shfl_xor(A.o1[qi][e], 32) * aoq[qi]; }
    }
    if (hh == 0) {
#pragma unroll
        for (int qi = 0; qi < 4; ++qi) { const size_t pi = (size_t)((((b * 4 + h) * 4 + sp) * 2 + cg) * 4 + qi);
            *(f32x4*)(PO + pi * 128 + 4 * i16) = A.o0[qi]; *(f32x4*)(PO + pi * 128 + 64 + 4 * i16) = A.o1[qi]; }
        if (i16 < 4) { const size_t pi = (size_t)((((b * 4 + h) * 4 + sp) * 2 + cg) * 4 + i16); PML[2 * pi] = A.m; PML[2 * pi + 1] = A.l; }
    }
}

__device__ __forceinline__ void combine_sample(int sr, int h, const float* QS, const float* KS, const float* VS, const float* PO, const float* PML, const float* bt, float lam, const float* subg,
                                               const bf16* GA, bf16* A2, int lane) {
    const int b = sr >> 2, qi = sr & 3;
    float oc[2][2];
#pragma unroll
    for (int c = 0; c < 2; ++c) {
        const float qd = QS[(size_t)sr * DH + h * 128 + c * 64 + lane];
        float sj[4];
#pragma unroll
        for (int j = 0; j < 4; ++j) { const float kd = KS[(size_t)(b * 4 + j) * DH + h * 128 + c * 64 + lane]; const float s = wave_sum(qd * kd); sj[j] = j <= qi ? s + bt[qi - j] : -1e30f; }
        float mp[4], lp[4]; float M = fmaxf(fmaxf(sj[0], sj[1]), fmaxf(sj[2], sj[3]));
#pragma unroll
        for (int sp = 0; sp < 4; ++sp) { const size_t pi = (size_t)((((b * 4 + h) * 4 + sp) * 2 + c) * 4 + qi); mp[sp] = PML[2 * pi]; lp[sp] = PML[2 * pi + 1]; M = fmaxf(M, mp[sp]); }
        float Lsum = 0.f, o0 = 0.f, o1 = 0.f;
#pragma unroll
        for (int sp = 0; sp < 4; ++sp) { const size_t pi = (size_t)((((b * 4 + h) * 4 + sp) * 2 + c) * 4 + qi); const float w = ex2(mp[sp] - M); Lsum += lp[sp] * w;
            const f32x2 po = *(const f32x2*)(PO + pi * 128 + 2 * lane); o0 += po.x * w; o1 += po.y * w; }
#pragma unroll
        for (int j = 0; j < 4; ++j) { const float w = j <= qi ? ex2(sj[j] - M) : 0.f; Lsum += w; const f32x2 vv = *(const f32x2*)(VS + (size_t)(b * 4 + j) * DH + h * 128 + 2 * lane); o0 += vv.x * w; o1 += vv.y * w; }
        const float inv = 1.0f / Lsum; oc[c][0] = o0 * inv; oc[c][1] = o1 * inv;
    }
    const float d0 = oc[0][0] - lam * oc[1][0], d1 = oc[0][1] - lam * oc[1][1];
    const float rs = rsqrtf(wave_sum(d0 * d0 + d1 * d1) * (1.0f / 128.0f) + EPS);
    const size_t row = (size_t)MP + sr;
    const unsigned gw = *(const unsigned*)(GA + row * DH + h * 128 + 2 * lane);
    const f32x2 sg = *(const f32x2*)(subg + 2 * lane);
    *(unsigned*)(A2 + row * DM + h * 128 + 2 * lane) = pkbf(d0 * rs * sg.x * 0.8f * bf_lo(gw), d1 * rs * sg.y * 0.8f * bf_hi(gw));
}
__device__ __forceinline__ void combine_prompt_row(size_t row, const bf16* Op, const bf16* GA, float lam, const f32x4 sg0, const f32x4 sg1, bf16* A2, int lane) {
    const int h = lane >> 4, e0 = 8 * (lane & 15);
    const u32x4 a = *(const u32x4*)(Op + row * DM + h * 256 + e0), bq = *(const u32x4*)(Op + row * DM + h * 256 + 128 + e0), gq = *(const u32x4*)(GA + row * DH + h * 128 + e0);
    float d[8];
    d[0] = bf_lo(a.x) - lam * bf_lo(bq.x); d[1] = bf_hi(a.x) - lam * bf_hi(bq.x); d[2] = bf_lo(a.y) - lam * bf_lo(bq.y); d[3] = bf_hi(a.y) - lam * bf_hi(bq.y);
    d[4] = bf_lo(a.z) - lam * bf_lo(bq.z); d[5] = bf_hi(a.z) - lam * bf_hi(bq.z); d[6] = bf_lo(a.w) - lam * bf_lo(bq.w); d[7] = bf_hi(a.w) - lam * bf_hi(bq.w);
    float ss = 0.f;
#pragma unroll
    for (int e = 0; e < 8; ++e) ss += d[e] * d[e];
    const float rs = rsqrtf(sum16(ss) * (1.0f / 128.0f) + EPS) * 0.8f;
    u32x4 o;
    o.x = pkbf(d[0] * rs * sg0.x * bf_lo(gq.x), d[1] * rs * sg0.y * bf_hi(gq.x)); o.y = pkbf(d[2] * rs * sg0.z * bf_lo(gq.y), d[3] * rs * sg0.w * bf_hi(gq.y));
    o.z = pkbf(d[4] * rs * sg1.x * bf_lo(gq.z), d[5] * rs * sg1.y * bf_hi(gq.z)); o.w = pkbf(d[6] * rs * sg1.z * bf_lo(gq.w), d[7] * rs * sg1.w * bf_hi(gq.w));
    *(u32x4*)(A2 + row * DM + h * 128 + e0) = o;
}

__device__ __forceinline__ const void* ldsarg(LAS unsigned char* L, int i) {
    const LAS unsigned* p = (const LAS unsigned*)(L + LDSCTL_OFF) + 2 * i;
    const unsigned lo = __builtin_amdgcn_readfirstlane(p[0]), hi = __builtin_amdgcn_readfirstlane(p[1]);
    return (const void*)(((unsigned long long)hi << 32) | lo);
}
constexpr int RED_ROW = 68;
template <int K> __device__ __forceinline__ f32x4 coop_tile(const bf16* W0, const bf16* W1, const bf16* X, LAS float* red, int wave, int lane) {
    constexpr int KS = K / 8, NI = KS / 64;
    const int r = lane & 31, hh = lane >> 5;
    const bf16* wa = W0 + (size_t)r * K + wave * KS + 8 * hh; const bf16* wb = W1 + (size_t)r * K + wave * KS + 8 * hh; const bf16* xa = X + (size_t)r * K + wave * KS + 8 * hh;
    bf16x8 a0[NI][4], a1[NI][4], bb[NI][4];
#pragma unroll
    for (int i = 0; i < NI; ++i)
#pragma unroll
        for (int s = 0; s < 4; ++s) { a0[i][s] = *(const bf16x8*)(wa + i * 64 + 16 * s); a1[i][s] = *(const bf16x8*)(wb + i * 64 + 16 * s); bb[i][s] = *(const bf16x8*)(xa + i * 64 + 16 * s); }
    __builtin_amdgcn_sched_barrier(0);
    f32x16 D0 = {}, D1 = {};
#pragma unroll
    for (int i = 0; i < NI; ++i)
#pragma unroll
        for (int s = 0; s < 4; ++s) { D0 = __builtin_amdgcn_mfma_f32_32x32x16_bf16(a0[i][s], bb[i][s], D0, 0, 0, 0); D1 = __builtin_amdgcn_mfma_f32_32x32x16_bf16(a1[i][s], bb[i][s], D1, 0, 0, 0); }
    LAS float* mine = red + (wave * 32 + r) * RED_ROW + 4 * hh;
#pragma unroll
    for (int q4 = 0; q4 < 4; ++q4) {
        *(LAS f32x4*)(mine + 8 * q4) = (f32x4){D0[4 * q4], D0[4 * q4 + 1], D0[4 * q4 + 2], D0[4 * q4 + 3]};
        *(LAS f32x4*)(mine + 32 + 8 * q4) = (f32x4){D1[4 * q4], D1[4 * q4 + 1], D1[4 * q4 + 2], D1[4 * q4 + 3]};
    }
    __syncthreads();
    const int token = (wave * 64 + lane) >> 4, col4 = lane & 15;
    f32x4 acc = {0.f, 0.f, 0.f, 0.f};
#pragma unroll
    for (int w = 0; w < 8; ++w) acc = acc + *(const LAS f32x4*)(red + (w * 32 + token) * RED_ROW + 4 * col4);
    __syncthreads();
    return acc;
}
__device__ __forceinline__ void sample_inproj_tile(int j, int mb, const bf16* WinT, const bf16* XN, const float* qg, const float* kg, float* QS, float* KS, float* VS, bf16* GA, bf16* U, bf16* GS, float* out, int wmask,
                                                   LAS float* red, int wave, int lane) {
    const int n0 = 64 * j, pn = n0 >> 8, wc = (n0 & 255) >> 6, R0 = 256 * pn + 32 * wc;
    f32x4 v = coop_tile<DM>(WinT + (size_t)R0 * DM, WinT + (size_t)(R0 + 128) * DM, XN + (size_t)(MP + 32 * mb) * DM, red, wave, lane);
    const int kind = j >> 3, srow = 32 * mb + ((wave * 64 + lane) >> 4), d = 4 * (lane & 15);
    const size_t o = (size_t)srow * DH + 64 * (j & 7) + d;
    if (kind <= 1) {
        const float ss = sum16((v.x * v.x + v.y * v.y) + (v.z * v.z + v.w * v.w));
        const float rs = rsqrtf(ss * (1.0f / 64.0f) + EPS) * (kind == 0 ? C2 : 1.0f);
        const f32x4 g = *(const f32x4*)((kind == 0 ? qg : kg) + d);
        v = v * rs * g;
        if (kind == 0) *(f32x4*)(QS + o) = v;
        else { *(f32x4*)(KS + o) = v; if (wmask & 1) *(f32x4*)(out + O_KS + o) = v; }
    } else if (kind == 2) { *(f32x4*)(VS + o) = v; if (wmask & 1) *(f32x4*)(out + O_VS + o) = v; }
    else {
        if (kind != 4) { v.x = pg8::silu_f(v.x); v.y = pg8::silu_f(v.y); v.z = pg8::silu_f(v.z); v.w = pg8::silu_f(v.w); }
        bf16* dst = kind == 3 ? GA : (kind == 4 ? U : GS);
        u32x2 w; w.x = pkbf(v.x, v.y); w.y = pkbf(v.z, v.w);
        *(u32x2*)(dst + (size_t)MP * DH + o) = w;
    }
}
__device__ __forceinline__ void sample_glu_tile(int j, int mb, const bf16* WgluT, const bf16* Z, const bf16* GS, const float* bglu, bf16* A2, LAS float* red, int wave, int lane) {
    const f32x4 v = coop_tile<DH>(WgluT + (size_t)(64 * j) * DH, WgluT + (size_t)(64 * j + 32) * DH, Z + (size_t)(MP + 32 * mb) * DH, red, wave, lane);
    const size_t row = (size_t)MP + 32 * mb + ((wave * 64 + lane) >> 4); const int col = 64 * j + 4 * (lane & 15);
    const f32x4 bv = *(const f32x4*)(bglu + col);
    const u32x2 zz = *(const u32x2*)(Z + row * DH + col), gg = *(const u32x2*)(GS + row * DH + col);
    const float o0 = bf_lo(zz.x) * pg8::sigmoid_f(v.x + bv.x) * bf_lo(gg.x), o1 = bf_hi(zz.x) * pg8::sigmoid_f(v.y + bv.y) * bf_hi(gg.x);
    const float o2 = bf_lo(zz.y) * pg8::sigmoid_f(v.z + bv.z) * bf_lo(gg.y), o3 = bf_hi(zz.y) * pg8::sigmoid_f(v.w + bv.w) * bf_hi(gg.y);
    u32x2 w; w.x = pkbf(o0, o1); w.y = pkbf(o2, o3);
    *(u32x2*)(A2 + row * DM + DH + col) = w;
}
__device__ __forceinline__ void sample_out_tile(int j, int mb, const bf16* WoutT, const bf16* A2, const float* xs, float* out, int wmask, LAS float* red, int wave, int lane) {
    const f32x4 v = coop_tile<DM>(WoutT + (size_t)(64 * j) * DM, WoutT + (size_t)(64 * j + 32) * DM, A2 + (size_t)(MP + 32 * mb) * DM, red, wave, lane);
    if (!(wmask & 8)) return;
    const size_t srow = (size_t)32 * mb + ((wave * 64 + lane) >> 4); const int col = 64 * j + 4 * (lane & 15);
    const f32x4 xv = *(const f32x4*)(xs + srow * DM + col);
    *(f32x4*)(out + O_YS + srow * DM + col) = xv + v;
}

__device__ __forceinline__ int opaque_lane() { int l = threadIdx.x & 63; asm volatile("" : "+v"(l)); return l; }
__device__ __forceinline__ unsigned char* opaque_ptr(unsigned char* p) { GAS unsigned char* g = (GAS unsigned char*)p; asm volatile("" : "+s"(g)); return (unsigned char*)g; }
#ifndef PROBE_SEG
#define PROBE_SEG 0
#endif
#define SEG_BEGIN(id) unsigned long long seg_t0_##id = 0; if (PROBE_SEG == (id)) { __syncthreads(); seg_t0_##id = __builtin_amdgcn_s_memrealtime(); }
#define SEG_END(id) if (PROBE_SEG == (id)) { __syncthreads(); const unsigned long long t1_ = __builtin_amdgcn_s_memrealtime(), d_ = 4ull * (t1_ - seg_t0_##id); while (__builtin_amdgcn_s_memrealtime() - t1_ < d_) __builtin_amdgcn_s_sleep(8); __syncthreads(); }
struct Args { const void* in[28]; float* out; unsigned char* ws; int wmask; int pad; };

__global__ void __launch_bounds__(NWAVES * 64, 2) hymba_fwd(Args args) {
    extern __shared__ __attribute__((aligned(16))) unsigned char lds[];
    LAS unsigned char* const L = (LAS unsigned char*)lds;
    volatile LAS unsigned* const MISC = (volatile LAS unsigned*)(L + MISC_OFF);
    const int tid = threadIdx.x, lane = tid & 63, wave = __builtin_amdgcn_readfirstlane(tid >> 6);
    const int G = gridDim.x; const int bx = blockIdx.x; const int vcu = (G % 8 == 0) ? (bx % 8) * (G / 8) + bx / 8 : bx;
    const int gw = vcu * NWAVES + wave, NGW = G * NWAVES;
    for (int u = tid; u < (LDS_BYTES - LDSCTL_OFF) / 4; u += NWAVES * 64) ((LAS unsigned*)(L + LDSCTL_OFF))[u] = 0u;
    __syncthreads();
#define LARG(i) (args.in[(i)])
#define IN_F(i) ((const float*)LARG(i))
#define WS_PTR opaque_ptr(args.ws)
#define OUT_PTR (args.out)
    XcdBarrier bar = xcd_barrier_post((unsigned*)((gu32*)(WS_PTR + WS_CTL) + CW_BAR), MISC + 8);

    {
        unsigned char* const ws = WS_PTR; unsigned char* const tab = ws + WS_TAB; float* const TAB = (float*)tab;
        const float* x_prompt = IN_F(0); const float* x_sample = IN_F(1); const float* norm_g = IN_F(7); const float* w_in = IN_F(8);
        const float* lq1 = IN_F(11); const float* lk1 = IN_F(12); const float* lq2 = IN_F(13); const float* lk2 = IN_F(14); const float* rel_bias = IN_F(16);
        const float* a_re = IN_F(17); const float* a_im = IN_F(18); const float* log_dt = IN_F(19); const float* b_re = IN_F(20); const float* b_im = IN_F(21); const float* c_re = IN_F(22); const float* c_im = IN_F(23);
        const float* w_glu = IN_F(25); const float* w_out = IN_F(27);
        bf16* const WinT = (bf16*)(ws + WS_WIN); bf16* const WoutT = (bf16*)(ws + WS_WOUT); bf16* const WgluT = (bf16*)(ws + WS_WGLU); bf16* const XN = (bf16*)(ws + WS_XN);
        LAS float* scr = (LAS float*)(L + RING_OFF + wave * 16384);
        SEG_BEGIN(1)
        constexpr int I_IN = (DM / 64) * (NIN / 32), I_OUT = (DM / 64) * (DM / 32), I_GLU = (DH / 64) * (DH / 32);
        constexpr int I_T = I_IN + I_OUT + I_GLU;
        for (int it = gw; it < I_T; it += NGW) {
            int r = it;
            if (r < I_IN) { p0_transpose_item(w_in, DM, NIN, WinT, true, scr, r, lane); continue; } r -= I_IN;
            if (r < I_OUT) { p0_transpose_item(w_out, DM, DM, WoutT, false, scr, r, lane); continue; } r -= I_OUT;
            p0_transpose_item(w_glu, DH, DH, WgluT, false, scr, r, lane);
        }
        for (int it = gw; it < MT / 2; it += NGW) {
            const int ra = it, rb = it + MT / 2;
            const float* xa = ra < MP ? x_prompt + (size_t)ra * DM : x_sample + (size_t)(ra - MP) * DM; const float* xb = rb < MP ? x_prompt + (size_t)rb * DM : x_sample + (size_t)(rb - MP) * DM;
            rms_rows2_to_bf16(xa, xb, norm_g, XN + (size_t)ra * DM, XN + (size_t)rb * DM, lane);
        }
        for (int it = NGW - 1 - gw; it < 2 + 32; it += NGW) {
            const int r = it;
            if (r == 0) {
                const float s1 = wave_sum(lq1[lane] * lk1[lane]), s2 = wave_sum(lq2[lane] * lk2[lane]);
                if (lane == 0) TAB[TB_LAM] = expf(s1) - expf(s2) + 0.2f;
            } else if (r == 1) {
                for (int i = lane; i < 512; i += 64) { const int h = i >> 7, d = i & 127; TAB[TB_BIAS + i] = (rel_bias[t5_bucket(d) * 4 + h] - rel_bias[31 * 4 + h]) * LOG2E; }
            } else {
                const int g = r - 2, p = lane;
                const float ar = a_re[g * 64 + p], ai = a_im[g * 64 + p], dt = expf(log_dt[g]);
                const float mag = expf(ar * dt), abr = mag * cosf(ai * dt), abi = mag * sinf(ai * dt);
                const float nr = abr - 1.0f, den = ar * ar + ai * ai;
                const float cfr = (nr * ar + abi * ai) / den, cfi = (abi * ar - nr * ai) / den;
                float pr[4], pi_[4]; pr[0] = abr; pi_[0] = abi;
                pr[1] = abr * abr - abi * abi; pi_[1] = 2.0f * abr * abi;
                pr[2] = pr[1] * abr - pi_[1] * abi; pi_[2] = pr[1] * abi + pi_[1] * abr;
                pr[3] = pr[1] * pr[1] - pi_[1] * pi_[1]; pi_[3] = 2.0f * pr[1] * pi_[1];
                float* tp = (float*)(tab + OFF_TP) + (size_t)(g * 64 + p) * 8;
#pragma unroll
                for (int k = 0; k < 4; ++k) { tp[2 * k] = pr[k]; tp[2 * k + 1] = pi_[k]; }
                float qr = pr[3], qi = pi_[3];
#pragma unroll
                for (int k = 0; k < 6; ++k) { const float t = qr * qr - qi * qi; qi = 2.0f * qr * qi; qr = t; }
                float* ta = (float*)(tab + OFF_TA256) + (size_t)(g * 64 + p) * 2; ta[0] = qr; ta[1] = qi;
                float bbr[16], bbi[16];
#pragma unroll
                for (int c = 0; c < 16; ++c) { const float br = b_re[(g * 64 + p) * 16 + c], bi = b_im[(g * 64 + p) * 16 + c]; bbr[c] = cfr * br - cfi * bi; bbi[c] = cfr * bi + cfi * br; }
                float* tb = (float*)(tab + OFF_TBF) + (size_t)(g * 64 + p) * 32;
#pragma unroll
                for (int c = 0; c < 16; ++c) { tb[c] = bbr[c]; tb[16 + c] = bbi[c]; }
                const int hi = p >> 5, rr = p & 31;
#pragma unroll
                for (int hh = 0; hh < 2; ++hh) {
                    v4u wr_, wi_;
                    wr_.x = pk2(bbr[8 * hh + 0], bbr[8 * hh + 1]); wr_.y = pk2(bbr[8 * hh + 2], bbr[8 * hh + 3]); wr_.z = pk2(bbr[8 * hh + 4], bbr[8 * hh + 5]); wr_.w = pk2(bbr[8 * hh + 6], bbr[8 * hh + 7]);
                    wi_.x = pk2(bbi[8 * hh + 0], bbi[8 * hh + 1]); wi_.y = pk2(bbi[8 * hh + 2], bbi[8 * hh + 3]); wi_.z = pk2(bbi[8 * hh + 4], bbi[8 * hh + 5]); wi_.w = pk2(bbi[8 * hh + 6], bbi[8 * hh + 7]);
                    *(v4u*)(tab + OFF_TBB + ((size_t)(g * 4 + 0 + hi) * 64 + rr + 32 * hh) * 16) = wr_;
                    *(v4u*)(tab + OFF_TBB + ((size_t)(g * 4 + 2 + hi) * 64 + rr + 32 * hh) * 16) = wi_;
                }
                const int cc = lane & 15, kq = lane >> 4;
#pragma unroll
                for (int s = 0; s < 4; ++s) {
                    float v[8];
#pragma unroll
                    for (int j = 0; j < 8; ++j) { const int k = 32 * s + 8 * kq + j, pp = k >> 1; v[j] = (k & 1) ? -c_im[(g * 16 + cc) * 64 + pp] : c_re[(g * 16 + cc) * 64 + pp]; }
                    v4u w; w.x = pk2(v[0], v[1]); w.y = pk2(v[2], v[3]); w.z = pk2(v[4], v[5]); w.w = pk2(v[6], v[7]);
                    *(v4u*)(tab + OFF_TCC + ((size_t)(g * 4 + s) * 64 + lane) * 16) = w;
                }
            }
        }
        SEG_END(1)
    }
    xcd_barrier(bar);

    {
        unsigned char* const ws = WS_PTR; float* const out = OUT_PTR; const int wmask = args.wmask;
        const float* q_norm_g = IN_F(9); const float* k_norm_g = IN_F(10);
        bf16* const WinT = (bf16*)(ws + WS_WIN); bf16* const XN = (bf16*)(ws + WS_XN); bf16* const Qp = (bf16*)(ws + WS_Q); bf16* const Kp = (bf16*)(ws + WS_Q + 16 * MiB); bf16* const Vp = (bf16*)(ws + WS_K);
        bf16* const GA = (bf16*)(ws + WS_GA); bf16* const U = (bf16*)(ws + WS_U); bf16* const GS = (bf16*)(ws + WS_GS);
        float* const QS = (float*)(ws + WS_QS); float* const KS = (float*)(ws + WS_KS); float* const VS = (float*)(ws + WS_VS);
        pg8::Gemm g{XN, WinT, MP, NIN, DM}; pg8::StaticOrder S; S.init(MP, NIN, G, bx);
        pg8::EpiInProj E1{out, Qp, Kp, Vp, GA, U, GS, QS, KS, VS, q_norm_g, k_norm_g, wmask};
        SEG_BEGIN(2)
        pg8::gemm_phase<pg8::EpiInProj, pg8::StaticOrder, true, true>(L + RING_OFF, g, S, E1);
        for (int it = vcu; it < 768; it += G) sample_inproj_tile(it % 48, it / 48, WinT, XN, q_norm_g, k_norm_g, QS, KS, VS, GA, U, GS, out, wmask, (LAS float*)(L + RING_OFF), wave, opaque_lane());
        SEG_END(2)
    }
    xcd_barrier(bar);

    {
        unsigned char* const ws = WS_PTR; unsigned char* const tab = ws + WS_TAB; float* const TAB = (float*)tab;
        bf16* const Qp = (bf16*)(ws + WS_Q); bf16* const Kp = (bf16*)(ws + WS_Q + 16 * MiB); bf16* const Vp = (bf16*)(ws + WS_K); bf16* const Op = (bf16*)(ws + WS_V);
        static_assert(attn_body::ATTN_LDS_BYTES <= BT_LDS_OFF && BT_LDS_OFF + 2048 <= RING_BYTES, "attention LDS map");
        LAS float* btab = (LAS float*)(L + RING_OFF + BT_LDS_OFF);
        for (int i = tid; i < 512; i += NWAVES * 64) btab[i] = TAB[TB_BIAS + i];
        __syncthreads();
        const attn_body::AttnTensors AT{(const attn_body::bf16*)Qp, (const attn_body::bf16*)Kp, (const attn_body::bf16*)Vp, (attn_body::bf16*)Op};
        const attn_body::StaticOrder S((int)G, (int)bx);
        const int kslot = vcu % 3;
        for (int i = 0; i < 3; ++i) {
            if (i == kslot) {
                unsigned char* const wsd = WS_PTR; const float* cache_k = IN_F(2); const float* cache_v = IN_F(3); const int* page_table = (const int*)LARG(6);
                float* const QS = (float*)(wsd + WS_QS); float* const PO = (float*)(wsd + WS_PART); float* const PML = (float*)(wsd + WS_PML); const float* TABd = (const float*)(wsd + WS_TAB);
                SEG_BEGIN(4)
                for (int it = gw; it < 2048; it += NGW) {
                    const int wg = it >> 3, wv = it & 7, b = wg >> 1, h = wv & 3, sp = (wg & 1) * 2 + (wv >> 2);
                    decode_item(b, h, sp, QS, cache_k, cache_v, page_table, TABd + TB_BIAS + h * 128, PO, PML, opaque_lane());
                }
                SEG_END(4)
            }
            attn_body::AttnUnit au;
            SEG_BEGIN(3)
            if (S.next(i, au)) attn_body::attn_unit<8>(au.bh / attn_body::NHEAD, au.bh % attn_body::NHEAD, au.qb, AT.Q, AT.K, AT.V, AT.O, (char*)lds + RING_OFF, (attn_body::lds_cfp)btab);
            SEG_END(3)
        }
        unsigned char* const wse = WS_PTR; unsigned char* const tabe = wse + WS_TAB;
        float* const out = OUT_PTR; const int wmask = args.wmask; const float* st_re = IN_F(4); const float* st_im = IN_F(5);
        const float* c_re = IN_F(22); const float* c_im = IN_F(23); const float* d_skip = IN_F(24);
        bf16* const U = (bf16*)(wse + WS_U); bf16* const Z = (bf16*)(wse + WS_Z); float* const E = (float*)(wse + WS_E);
        SEG_BEGIN(5)
        for (int it = gw; it < 4096; it += NGW) ssm_sample_item(it >> 5, it & 31, tabe, U, st_re, st_im, c_re, c_im, d_skip, Z, out, wmask, opaque_lane());
        for (int it = gw; it < 2048; it += NGW) ssm_chunk<false>(it >> 10, (it >> 5) & 31, it & 31, tabe, U, E, d_skip, Z, out, wmask, (LAS unsigned*)nullptr, opaque_lane());
        SEG_END(5)
    }
    xcd_barrier(bar);

    {
        unsigned char* const ws = WS_PTR; unsigned char* const tab = ws + WS_TAB; float* const TAB = (float*)tab; float* const out = OUT_PTR; const int wmask = args.wmask;
        const float* subln_g = IN_F(15); const float* d_skip = IN_F(24);
        bf16* const Op = (bf16*)(ws + WS_V); bf16* const GA = (bf16*)(ws + WS_GA); bf16* const U = (bf16*)(ws + WS_U); bf16* const Z = (bf16*)(ws + WS_Z); bf16* const A2 = (bf16*)(ws + WS_A2);
        float* const QS = (float*)(ws + WS_QS); float* const KS = (float*)(ws + WS_KS); float* const VS = (float*)(ws + WS_VS);
        float* const E = (float*)(ws + WS_E); float* const PO = (float*)(ws + WS_PART); float* const PML = (float*)(ws + WS_PML);
        SEG_BEGIN(6)
        const float lam = TAB[TB_LAM];
        LAS unsigned* Hs = (LAS unsigned*)(L + RING_OFF + wave * 16384);
        for (int it = gw; it < 2048; it += NGW) ssm_chunk<true>(it >> 10, (it >> 5) & 31, it & 31, tab, U, E, d_skip, Z, out, wmask, Hs, opaque_lane());
        for (int it = gw; it < 2048; it += NGW) combine_sample(it >> 2, it & 3, QS, KS, VS, PO, PML, TAB + TB_BIAS + (it & 3) * 128, lam, subln_g, GA, A2, opaque_lane());
        SEG_END(6)
    }
    xcd_barrier(bar);

    {
        unsigned char* const ws = WS_PTR; const float* b_glu = IN_F(26);
        bf16* const WgluT = (bf16*)(ws + WS_WGLU); bf16* const GS = (bf16*)(ws + WS_GS); bf16* const Z = (bf16*)(ws + WS_Z); bf16* const A2 = (bf16*)(ws + WS_A2);
        pg8::Gemm g{Z, WgluT, MP, DH, DH}; pg8::StaticOrder S; S.init(MP, DH, G, bx);
        pg8::EpiGlu E4{Z, GS, b_glu, A2};
        SEG_BEGIN(7)
        pg8::gemm_phase<pg8::EpiGlu, pg8::StaticOrder, true, true>(L + RING_OFF, g, S, E4);
        if (bx >= 128) {
            for (int it = bx - 128; it < 128; it += G - 128) sample_glu_tile(it & 7, it >> 3, WgluT, Z, GS, b_glu, A2, (LAS float*)(L + RING_OFF), wave, opaque_lane());
            const float* subln_g = IN_F(15); const float lam = ((const float*)(ws + WS_TAB))[TB_LAM]; bf16* const Op = (bf16*)(ws + WS_V); bf16* const GA = (bf16*)(ws + WS_GA);
            const int ln = opaque_lane(); const f32x4 sg0 = *(const f32x4*)(subln_g + 8 * (ln & 15)), sg1 = *(const f32x4*)(subln_g + 8 * (ln & 15) + 4);
            const int nw = (G - 128) * NWAVES;
            for (int row = (bx - 128) * NWAVES + wave; row < MP; row += nw) combine_prompt_row((size_t)row, Op, GA, lam, sg0, sg1, A2, ln);
        }
        SEG_END(7)
    }
    xcd_barrier(bar);

    {
        unsigned char* const ws = WS_PTR; float* const out = OUT_PTR; const int wmask = args.wmask;
        const float* x_prompt = IN_F(0); const float* x_sample = IN_F(1);
        bf16* const WoutT = (bf16*)(ws + WS_WOUT); bf16* const A2 = (bf16*)(ws + WS_A2);
        pg8::Gemm g{A2, WoutT, MP, DM, DM}; pg8::StaticOrder S; S.init(MP, DM, G, bx);
        pg8::EpiOut E5{x_prompt, x_sample, out, wmask};
        SEG_BEGIN(8)
        pg8::gemm_phase<pg8::EpiOut, pg8::StaticOrder, true, true>(L + RING_OFF, g, S, E5);
        for (int it = vcu; it < 256; it += G) sample_out_tile(it & 15, it >> 4, WoutT, A2, x_sample, out, wmask, (LAS float*)(L + RING_OFF), wave, opaque_lane());
        SEG_END(8)
    }
}

#ifndef MODE
#define MODE 1
#endif
#ifndef WMASK
#define WMASK 31
#endif
#if MODE != 1
#ifndef NV_STOP
#define NV_STOP 99
#endif
namespace nv {
constexpr size_t NV_BASE = 320ull << 20;
constexpr size_t NV_XN = NV_BASE, NV_H = NV_XN + (size_t)MT * DM * 4, NV_Q = NV_H + (size_t)MT * NIN * 4, NV_K = NV_Q + (size_t)MT * DH * 4, NV_V = NV_K + (size_t)MT * DH * 4,
                 NV_O = NV_V + (size_t)MT * DH * 4, NV_Y = NV_O + (size_t)MT * DM * 4, NV_Z = NV_Y + (size_t)MT * DH * 4, NV_T = NV_Z + (size_t)MT * DH * 4, NV_A2 = NV_T + (size_t)MT * DH * 4,
                 NV_END = NV_A2 + (size_t)MT * DM * 4;
__device__ __forceinline__ float wsum(float v) {
#pragma unroll
    for (int o = 1; o < 64; o <<= 1) v += __shfl_xor(v, o);
    return v;
}
__device__ __forceinline__ float wmax(float v) {
#pragma unroll
    for (int o = 1; o < 64; o <<= 1) v = fmaxf(v, __shfl_xor(v, o));
    return v;
}
__device__ __forceinline__ int bucket(int n) {
    if (n < 16) return n;
    int b = 16;
    b += (n >= 19); b += (n >= 21); b += (n >= 24); b += (n >= 27); b += (n >= 31); b += (n >= 35); b += (n >= 40); b += (n >= 46);
    b += (n >= 52); b += (n >= 59); b += (n >= 67); b += (n >= 77); b += (n >= 87); b += (n >= 99); b += (n >= 113);
    return b;
}
__global__ void k_rms(const float* xp, const float* xs, const float* g, float* XN) {
    const int row = blockIdx.x, lane = threadIdx.x;
    const float* x = row < MP ? xp + (size_t)row * DM : xs + (size_t)(row - MP) * DM;
    float s = 0.f;
    for (int i = lane; i < DM; i += 64) s += x[i] * x[i];
    const float rs = rsqrtf(wsum(s) / DM + EPS);
    for (int i = lane; i < DM; i += 64) XN[(size_t)row * DM + i] = x[i] * rs * g[i];
}
__global__ void k_gemm(const float* A, const float* B, float* C, const float* R, int M, int N, int K) {
    __shared__ float As[16][65], Bs[16][65];
    const int tx = threadIdx.x & 15, ty = threadIdx.x >> 4, m0 = blockIdx.y * 64, n0 = blockIdx.x * 64;
    float acc[4][4] = {};
    for (int k0 = 0; k0 < K; k0 += 16) {
        for (int i = threadIdx.x; i < 1024; i += 256) { const int r = i >> 4, c = i & 15; As[c][r] = A[(size_t)(m0 + r) * K + k0 + c]; }
        for (int i = threadIdx.x; i < 1024; i += 256) { const int r = i >> 6, c = i & 63; Bs[r][c] = B[(size_t)(k0 + r) * N + n0 + c]; }
        __syncthreads();
#pragma unroll
        for (int k = 0; k < 16; ++k) {
            float a[4], b[4];
#pragma unroll
            for (int i = 0; i < 4; ++i) { a[i] = As[k][ty * 4 + i]; b[i] = Bs[k][tx * 4 + i]; }
#pragma unroll
            for (int i = 0; i < 4; ++i)
#pragma unroll
                for (int j = 0; j < 4; ++j) acc[i][j] += a[i] * b[j];
        }
        __syncthreads();
    }
    for (int i = 0; i < 4; ++i)
        for (int j = 0; j < 4; ++j) { const size_t o = (size_t)(m0 + ty * 4 + i) * N + n0 + tx * 4 + j; C[o] = acc[i][j] + (R ? R[o] : 0.f); }
}
__global__ void k_post(const float* H, const float* qg, const float* kg, float* Q, float* Kn, float* Vn, float* out) {
    const int row = blockIdx.x / 24, j = blockIdx.x % 24, d = threadIdx.x;
    const float v = H[(size_t)row * NIN + j * 64 + d];
    if (j < 16) {
        const float rs = rsqrtf(wsum(v * v) / 64.f + EPS);
        if (j < 8) Q[(size_t)row * DH + j * 64 + d] = v * rs * qg[d] * 0.125f;
        else { const float k = v * rs * kg[d]; const int c = (j - 8) * 64 + d; Kn[(size_t)row * DH + c] = k;
               if (row < MP) out[O_KP + (size_t)row * DH + c] = k; else out[O_KS + (size_t)(row - MP) * DH + c] = k; }
    } else { const int c = (j - 16) * 64 + d; Vn[(size_t)row * DH + c] = v;
             if (row < MP) out[O_VP + (size_t)row * DH + c] = v; else out[O_VS + (size_t)(row - MP) * DH + c] = v; }
}
__global__ void k_attn(const float* Q, const float* Kn, const float* Vn, const float* ck, const float* cv, const int* pt, const float* rel_bias, float* O) {
    const int id = blockIdx.x, row = id >> 3, h = (id >> 1) & 3, c = id & 1, lane = threadIdx.x;
    float q[64];
#pragma unroll
    for (int d = 0; d < 64; ++d) q[d] = Q[(size_t)row * DH + h * 128 + c * 64 + d];
    int nkeys, qpos, b;
    const bool samp = row >= MP;
    if (!samp) { b = row / SEQ; qpos = row % SEQ; nkeys = qpos + 1; }
    else { b = (row - MP) >> 2; qpos = PAST + ((row - MP) & 3); nkeys = qpos + 1; }
    float m = -1e30f, l = 0.f, o0 = 0.f, o1 = 0.f;
    for (int t0 = 0; t0 < nkeys; t0 += 64) {
        const int kk = t0 + lane; const bool valid = kk < nkeys;
        const float* kp;
        if (!samp) kp = Kn + (size_t)(b * SEQ + (valid ? kk : 0)) * DH + h * 128 + c * 64;
        else if (kk < PAST) { const int pg = pt[b * NPAGES + (kk >> 7)]; kp = ck + ((size_t)(pg * PAGE + (kk & 127)) * 4 + h) * 128 + c * 64; }
        else kp = Kn + (size_t)(MP + b * 4 + (valid ? kk - PAST : 0)) * DH + h * 128 + c * 64;
        float s = 0.f;
#pragma unroll
        for (int d = 0; d < 64; ++d) s += q[d] * kp[d];
        s += rel_bias[bucket(valid ? qpos - kk : 0) * 4 + h];
        if (!valid) s = -1e30f;
        const float mn = fmaxf(m, wmax(s)), alpha = expf(m - mn), p = valid ? expf(s - mn) : 0.f;
        l = l * alpha + wsum(p); o0 *= alpha; o1 *= alpha; m = mn;
        const int cnt = min(64, nkeys - t0);
        for (int j = 0; j < cnt; ++j) {
            const float pj = __shfl(p, j); const int kj = t0 + j;
            const float* vp;
            if (!samp) vp = Vn + (size_t)(b * SEQ + kj) * DH + h * 128;
            else if (kj < PAST) { const int pg = pt[b * NPAGES + (kj >> 7)]; vp = cv + ((size_t)(pg * PAGE + (kj & 127)) * 4 + h) * 128; }
            else vp = Vn + (size_t)(MP + b * 4 + kj - PAST) * DH + h * 128;
            o0 += pj * vp[lane]; o1 += pj * vp[lane + 64];
        }
    }
    float* op = O + (size_t)row * DM + (h * 2 + c) * 128;
    op[lane] = o0 / l; op[lane + 64] = o1 / l;
}
__global__ void k_ssm(const float* H, int row0, int L, const float* h0re, const float* h0im, const float* are, const float* aim, const float* ldt,
                      const float* bre, const float* bim, const float* cre, const float* cim, const float* dsk, float* Y, float* ore, float* oim) {
    const int b = blockIdx.x >> 5, g = blockIdx.x & 31, p = threadIdx.x;
    const float ar = are[g * 64 + p], ai = aim[g * 64 + p], dt = expf(ldt[g]);
    const float mag = expf(ar * dt), abr = mag * cosf(ai * dt), abi = mag * sinf(ai * dt);
    const float nr = abr - 1.0f, den = ar * ar + ai * ai;
    const float cfr = (nr * ar + abi * ai) / den, cfi = (abi * ar - nr * ai) / den;
    float bbr[16], bbi[16], cr[16], ci[16];
#pragma unroll
    for (int c = 0; c < 16; ++c) { const float br = bre[(g * 64 + p) * 16 + c], bi = bim[(g * 64 + p) * 16 + c];
        bbr[c] = cfr * br - cfi * bi; bbi[c] = cfr * bi + cfi * br; cr[c] = cre[(g * 16 + c) * 64 + p]; ci[c] = cim[(g * 16 + c) * 64 + p]; }
    float hr = h0re ? h0re[(b * 32 + g) * 64 + p] : 0.f, hi = h0im ? h0im[(b * 32 + g) * 64 + p] : 0.f;
    for (int t = 0; t < L; ++t) {
        const size_t row = (size_t)row0 + (size_t)b * L + t;
        const float* u = H + row * NIN + 2048 + g * 16;
        float ur = 0.f, ui = 0.f;
#pragma unroll
        for (int c = 0; c < 16; ++c) { ur += bbr[c] * u[c]; ui += bbi[c] * u[c]; }
        const float nhr = abr * hr - abi * hi + ur, nhi = abr * hi + abi * hr + ui; hr = nhr; hi = nhi;
        float yv = 0.f;
#pragma unroll
        for (int c = 0; c < 16; ++c) { const float s = wsum(cr[c] * hr - ci[c] * hi); if (p == c) yv = s; }
        if (p < 16) Y[row * DH + g * 16 + p] = yv + dsk[g * 16 + p] * u[p];
    }
    ore[(b * 32 + g) * 64 + p] = hr; oim[(b * 32 + g) * 64 + p] = hi;
}
__device__ __forceinline__ float gelu_tanh(float x) { return 0.5f * x * (1.0f + tanhf(0.7978845608028654f * (x + 0.044715f * x * x * x))); }
__device__ __forceinline__ float silu(float x) { return x / (1.0f + expf(-x)); }
__global__ void k_fin1(const float* O, const float* H, const float* Y, const float* lq1, const float* lk1, const float* lq2, const float* lk2, const float* subg, float* A2, float* Z) {
    const int row = blockIdx.x, lane = threadIdx.x;
    const float lam = expf(wsum(lq1[lane] * lk1[lane])) - expf(wsum(lq2[lane] * lk2[lane])) + 0.2f;
    for (int h = 0; h < 4; ++h) {
        const float* o1 = O + (size_t)row * DM + (h * 2) * 128; const float* o2 = o1 + 128;
        const float a = o1[lane] - lam * o2[lane], bb = o1[lane + 64] - lam * o2[lane + 64];
        const float rs = rsqrtf(wsum(a * a + bb * bb) / 128.f + EPS);
        const float* ga = H + (size_t)row * NIN + 1536 + h * 128;
        A2[(size_t)row * DM + h * 128 + lane] = a * rs * subg[lane] * 0.8f * silu(ga[lane]);
        A2[(size_t)row * DM + h * 128 + lane + 64] = bb * rs * subg[lane + 64] * 0.8f * silu(ga[lane + 64]);
    }
    for (int i = lane; i < DH; i += 64) Z[(size_t)row * DH + i] = gelu_tanh(Y[(size_t)row * DH + i]);
}
__global__ void k_fin2(const float* Z, const float* T, const float* bglu, const float* H, float* A2) {
    const size_t i = (size_t)blockIdx.x * 256 + threadIdx.x; const size_t row = i / DH; const int j = (int)(i % DH);
    A2[row * DM + 512 + j] = Z[i] / (1.0f + expf(-(T[i] + bglu[j]))) * silu(H[row * NIN + 2560 + j]);
}
static void launch(void* const* d_in, float* out, unsigned char* ws, hipStream_t st) {
    const float* xp = (const float*)d_in[0]; const float* xs = (const float*)d_in[1];
    float *XN = (float*)(ws + NV_XN), *H = (float*)(ws + NV_H), *Q = (float*)(ws + NV_Q), *Kn = (float*)(ws + NV_K), *Vn = (float*)(ws + NV_V), *O = (float*)(ws + NV_O),
          *Y = (float*)(ws + NV_Y), *Z = (float*)(ws + NV_Z), *T = (float*)(ws + NV_T), *A2 = (float*)(ws + NV_A2);
#if NV_STOP >= 1
    k_rms<<<MT, 64, 0, st>>>(xp, xs, (const float*)d_in[7], XN);
#endif
#if NV_STOP >= 2
    k_gemm<<<dim3(NIN / 64, MT / 64), 256, 0, st>>>(XN, (const float*)d_in[8], H, nullptr, MT, NIN, DM);
#endif
#if NV_STOP >= 3
    k_post<<<MT * 24, 64, 0, st>>>(H, (const float*)d_in[9], (const float*)d_in[10], Q, Kn, Vn, out);
#endif
#if NV_STOP >= 4
    k_attn<<<MT * 8, 64, 0, st>>>(Q, Kn, Vn, (const float*)d_in[2], (const float*)d_in[3], (const int*)d_in[6], (const float*)d_in[16], O);
#endif
#if NV_STOP >= 5
    k_ssm<<<NB * 32, 64, 0, st>>>(H, 0, SEQ, nullptr, nullptr, (const float*)d_in[17], (const float*)d_in[18], (const float*)d_in[19], (const float*)d_in[20], (const float*)d_in[21],
                                 (const float*)d_in[22], (const float*)d_in[23], (const float*)d_in[24], Y, out + O_SRP, out + O_SIP);
#endif
#if NV_STOP >= 6
    k_ssm<<<128 * 32, 64, 0, st>>>(H, MP, 4, (const float*)d_in[4], (const float*)d_in[5], (const float*)d_in[17], (const float*)d_in[18], (const float*)d_in[19], (const float*)d_in[20], (const float*)d_in[21],
                                  (const float*)d_in[22], (const float*)d_in[23], (const float*)d_in[24], Y, out + O_SRS, out + O_SIS);
#endif
#if NV_STOP >= 7
    k_fin1<<<MT, 64, 0, st>>>(O, H, Y, (const float*)d_in[11], (const float*)d_in[12], (const float*)d_in[13], (const float*)d_in[14], (const float*)d_in[15], A2, Z);
#endif
#if NV_STOP >= 8
    k_gemm<<<dim3(DH / 64, MT / 64), 256, 0, st>>>(Z, (const float*)d_in[25], T, nullptr, MT, DH, DH);
#endif
#if NV_STOP >= 9
    k_fin2<<<MT * DH / 256, 256, 0, st>>>(Z, T, (const float*)d_in[26], H, A2);
#endif
#if NV_STOP >= 10
    k_gemm<<<dim3(DM / 64, MP / 64), 256, 0, st>>>(A2, (const float*)d_in[27], out + O_YP, xp, MP, DM, DM);
#endif
#if NV_STOP >= 11
    k_gemm<<<dim3(DM / 64, MS / 64), 256, 0, st>>>(A2 + (size_t)MP * DM, (const float*)d_in[27], out + O_YS, xs, MS, DM, DM);
#endif
}
}
#endif

extern "C" void kernel_launch(void* const* d_in, const int* in_sizes, int n_in, void* d_out, int out_size, void* d_ws, size_t ws_size, hipStream_t stream) {
    static int grid = 0;
    if (grid == 0) {
        if (n_in != 28 || out_size != (int)O_END || ws_size < (size_t)(1024ull << 20)) { fprintf(stderr, "kernel_launch: unexpected shapes (n_in %d out %d ws %zu)\n", n_in, out_size, ws_size); grid = -1; return; }
        int dev = 0, cus = 0, per_cu = 0;
        if (hipGetDevice(&dev) != hipSuccess || hipDeviceGetAttribute(&cus, hipDeviceAttributeMultiprocessorCount, dev) != hipSuccess) { grid = -1; return; }
        if (hipFuncSetAttribute((const void*)hymba_fwd, hipFuncAttributeMaxDynamicSharedMemorySize, LDS_BYTES) != hipSuccess) { fprintf(stderr, "kernel_launch: hipFuncSetAttribute failed\n"); grid = -1; return; }
        if (hipOccupancyMaxActiveBlocksPerMultiprocessor(&per_cu, (const void*)hymba_fwd, NWAVES * 64, LDS_BYTES) != hipSuccess || per_cu < 1)
            fprintf(stderr, "kernel_launch: occupancy query reports %d workgroups per CU\n", per_cu);
        (void)hipGetLastError();
        grid = cus;
    }
    if (grid < 0) return;
#if MODE != 1
    nv::launch(d_in, (float*)d_out, (unsigned char*)d_ws, stream);
#endif
#if MODE == 0
    return;
#endif
    if (hipMemsetAsync((char*)d_ws + WS_CTL, 0, CTL_ZERO_BYTES, stream) != hipSuccess) return;
    Args a{};
    for (int i = 0; i < 28; ++i) a.in[i] = d_in[i];
    a.out = (float*)d_out; a.ws = (unsigned char*)d_ws; a.wmask = (MODE == 1) ? 31 : WMASK;
    hipLaunchKernelGGL(hymba_fwd, dim3(grid), dim3(NWAVES * 64), LDS_BYTES, stream, a);
}
```
